# Optimizing an MI355X kernel written in HIP

```python
import math
import jax, jax.numpy as jnp
from jax import lax
import numpy as np

D_MODEL = 2048
BATCH = 2
SEQ = 4096
DEPTH = 2

CHUNK = 64
EPS = 1e-6
CONV_W = 4
GDN_HEADS = D_MODEL // 256
GDN_DK = 128
GDN_DV = 128
GDN_QK = GDN_HEADS * GDN_DK
GDN_VW = GDN_HEADS * GDN_DV
GDN_CONV_CH = 2 * GDN_QK + GDN_VW
HG_HEADS = D_MODEL // 256
HG_DK = 128
HG_DV = 128
HG_FW = HG_HEADS * HG_DK
HG_VW = HG_HEADS * HG_DV
LRU_WIDTH = D_MODEL
RG_BLOCKS = D_MODEL // 256
RG_BLOCK = LRU_WIDTH // RG_BLOCKS
RG_C = 8.0
D_FF = ((8 * D_MODEL // 3) + 255) // 256 * 256
N_EXPERTS = 8
TOP_K = 2
D_EXPERT = 7 * D_MODEL // 2
N_EVEN = (DEPTH + 1) // 2
N_ODD = DEPTH // 2
MIX_SPLITS = (GDN_QK, GDN_QK, GDN_VW, GDN_VW, GDN_HEADS, GDN_HEADS, HG_FW, HG_FW, HG_VW, HG_VW)
MIX_IN = sum(MIX_SPLITS)
MIX_SPLIT_IDX = tuple(int(s) for s in np.cumsum(MIX_SPLITS)[:-1])
MIX_OUT = GDN_VW + HG_VW

kernel_name = "hybrid_gdn_hgrn2_rglru_moe_block"

F32 = jnp.float32


def _rmsnorm(x, w):
    xf = x.astype(F32)
    y = xf * lax.rsqrt(jnp.mean(xf * xf, axis=-1, keepdims=True) + EPS)
    return (y * w.astype(F32)).astype(x.dtype)


def _gated_head_rmsnorm(o, w, z):
    o = o * lax.rsqrt(jnp.mean(o * o, axis=-1, keepdims=True) + EPS) * w.astype(F32)
    o = o * jax.nn.silu(z.astype(F32).reshape(o.shape))
    return o.reshape(o.shape[0], o.shape[1], -1)


def _l2norm(t):
    return t * lax.rsqrt(jnp.sum(t * t, axis=-1, keepdims=True) + EPS)


def _causal_dwconv(x, w):
    ch = x.shape[-1]
    return lax.conv_general_dilated(
        x, w[:, None, :].astype(x.dtype), window_strides=(1,),
        padding=[(w.shape[0] - 1, 0)], dimension_numbers=('NWC', 'WIO', 'NWC'),
        feature_group_count=ch)


def _to_chunks(t):
    b, s, h, d = t.shape
    return t.reshape(b, s // CHUNK, CHUNK, h, d).transpose(0, 3, 1, 2, 4)


def _from_chunks(t):
    b, h, n, c, d = t.shape
    return t.transpose(0, 2, 3, 1, 4).reshape(b, n * c, h, d)


def _gated_delta_rule(q, k, v, g, beta):
    bsz, s, h, dk = q.shape
    dv = v.shape[-1]
    q = _to_chunks(_l2norm(q) * (dk ** -0.5))
    k = _to_chunks(_l2norm(k))
    v = _to_chunks(v)
    g = _to_chunks(g[..., None])[..., 0]
    beta = _to_chunks(beta[..., None])[..., 0]
    gc = jnp.cumsum(g, axis=-1)
    incl = jnp.tril(jnp.ones((CHUNK, CHUNK), dtype=bool))
    strict = jnp.tril(jnp.ones((CHUNK, CHUNK), dtype=bool), -1)
    diff = gc[..., :, None] - gc[..., None, :]
    decay = jnp.where(incl, jnp.exp(jnp.where(incl, diff, 0.0)), 0.0)
    kk = jnp.einsum('bhncd,bhnsd->bhncs', k, k)
    lmat = jnp.where(strict, beta[..., None] * kk * decay, 0.0)
    amat = lmat + jnp.eye(CHUNK, dtype=F32)
    rhs = jnp.concatenate([v * beta[..., None], k * (beta * jnp.exp(gc))[..., None]], axis=-1)
    sol = lax.linalg.triangular_solve(amat, rhs, left_side=True, lower=True, unit_diagonal=True)
    u, w = sol[..., :dv], sol[..., dv:]
    qk = jnp.einsum('bhncd,bhnsd->bhncs', q, k) * decay
    q_dec = q * jnp.exp(gc)[..., None]
    k_dec = k * jnp.exp(gc[..., -1:] - gc)[..., None]
    g_last = jnp.exp(gc[..., -1])

    def step(state, inp):
        u_n, w_n, qk_n, qd_n, kd_n, gl_n = inp
        v_new = u_n - jnp.einsum('bhcd,bhde->bhce', w_n, state)
        o_n = jnp.einsum('bhcd,bhde->bhce', qd_n, state) + jnp.einsum('bhcs,bhse->bhce', qk_n, v_new)
        state = state * gl_n[..., None, None] + jnp.einsum('bhcd,bhce->bhde', kd_n, v_new)
        return state, o_n

    xs = (jnp.moveaxis(u, 2, 0), jnp.moveaxis(w, 2, 0), jnp.moveaxis(qk, 2, 0),
          jnp.moveaxis(q_dec, 2, 0), jnp.moveaxis(k_dec, 2, 0), jnp.moveaxis(g_last, 2, 0))
    _, o = lax.scan(step, jnp.zeros((bsz, h, dk, dv), F32), xs)
    return _from_chunks(jnp.moveaxis(o, 0, 2))


def _hgrn2(q, f_logit, i, lb):
    bsz, s, h, dk = q.shape
    dv = i.shape[-1]
    lb = lb.reshape(h, dk)
    forget = lb + (1.0 - lb) * jax.nn.sigmoid(f_logit)
    logf = _to_chunks(jnp.log(forget))
    k = _to_chunks(1.0 - forget)
    q = _to_chunks(q * (dk ** -0.5))
    v = _to_chunks(i)
    b = jnp.cumsum(logf, axis=3)
    b_ref = b[..., CHUNK // 2 - 1:CHUNK // 2, :]
    q_t = q * jnp.exp(b - b_ref)
    k_t = k * jnp.exp(b_ref - b)
    incl = jnp.tril(jnp.ones((CHUNK, CHUNK), dtype=bool))
    att = jnp.where(incl, jnp.einsum('bhncd,bhnsd->bhncs', q_t, k_t), 0.0)
    o_intra = jnp.einsum('bhncs,bhnse->bhnce', att, v)
    b_last = b[..., -1, :]
    d_state = jnp.einsum('bhncd,bhnce->bhnde', k * jnp.exp(b_last[..., None, :] - b), v)

    def step(state, inp):
        ds_n, bl_n = inp
        return state * jnp.exp(bl_n)[..., None] + ds_n, state

    _, s_prev = lax.scan(step, jnp.zeros((bsz, h, dk, dv), F32),
                         (jnp.moveaxis(d_state, 2, 0), jnp.moveaxis(b_last, 2, 0)))
    s_prev = jnp.moveaxis(s_prev, 0, 2)
    o_inter = jnp.einsum('bhncd,bhnde->bhnce', q * jnp.exp(b), s_prev)
    return _from_chunks(o_intra + o_inter)


def _ab_mixer(h, w_in, conv_w, a_log, dt_bias, gdn_nw, lb, hg_nw, w_out):
    bsz, s, _ = h.shape
    proj = h @ w_in
    a_q, a_k, a_v, a_z, a_b, a_a, b_q, b_f, b_i, b_g = jnp.split(proj, MIX_SPLIT_IDX, axis=-1)
    qkv = jax.nn.silu(_causal_dwconv(jnp.concatenate([a_q, a_k, a_v], axis=-1), conv_w)).astype(F32)
    q, k, v = jnp.split(qkv, [GDN_QK, 2 * GDN_QK], axis=-1)
    q = q.reshape(bsz, s, GDN_HEADS, GDN_DK)
    k = k.reshape(bsz, s, GDN_HEADS, GDN_DK)
    v = v.reshape(bsz, s, GDN_HEADS, GDN_DV)
    beta = jax.nn.sigmoid(a_b.astype(F32))
    g = -jnp.exp(a_log.astype(F32)) * jax.nn.softplus(a_a.astype(F32) + dt_bias.astype(F32))
    o_a = _gated_head_rmsnorm(_gated_delta_rule(q, k, v, g, beta), gdn_nw, a_z)
    hq = jax.nn.silu(b_q.astype(F32)).reshape(bsz, s, HG_HEADS, HG_DK)
    hf = b_f.astype(F32).reshape(bsz, s, HG_HEADS, HG_DK)
    hi = b_i.astype(F32).reshape(bsz, s, HG_HEADS, HG_DV)
    o_b = _gated_head_rmsnorm(_hgrn2(hq, hf, hi, lb), hg_nw, b_g)
    o = jnp.concatenate([o_a, o_b], axis=-1).astype(h.dtype)
    return o @ w_out


def _lin_combine(e1, e2):
    a1, b1 = e1
    a2, b2 = e2
    return a1 * a2, a2 * b1 + b2


def _rglru_block(h, w_in, conv_w, conv_b, wa, ba, wx, bx, lam, w_out):
    bsz, s, _ = h.shape
    y_br, x_br = jnp.split(h @ w_in, 2, axis=-1)
    y_br = jax.nn.gelu(y_br, approximate=True)
    xc = (_causal_dwconv(x_br, conv_w) + conv_b).astype(F32)
    xb = xc.reshape(bsz, s, RG_BLOCKS, RG_BLOCK)
    r = jax.nn.sigmoid(jnp.einsum('bsnc,ncd->bsnd', xb, wa.astype(F32)).reshape(bsz, s, LRU_WIDTH) + ba.astype(F32))
    gi = jax.nn.sigmoid(jnp.einsum('bsnc,ncd->bsnd', xb, wx.astype(F32)).reshape(bsz, s, LRU_WIDTH) + bx.astype(F32))
    log_a = -RG_C * r * jax.nn.softplus(-lam.astype(F32))
    a = jnp.exp(log_a)
    b = jnp.sqrt(jnp.maximum(-jnp.expm1(2.0 * log_a), 0.0)) * (gi * xc)
    _, hs = lax.associative_scan(_lin_combine, (a, b), axis=1)
    return (y_br * hs.astype(h.dtype)) @ w_out


def _swiglu(h, w_gu, w_d):
    g, u = jnp.split(h @ w_gu, 2, axis=-1)
    return (jax.nn.silu(g) * u) @ w_d


def _moe(h, router_w, gate_up_w, down_w):
    bsz, s, d = h.shape
    t = h.reshape(-1, d)
    logits = (t @ router_w).astype(F32)
    top_v, top_i = lax.top_k(logits, TOP_K)
    gates = jax.nn.softmax(top_v, axis=-1)
    comb = jnp.sum(jax.nn.one_hot(top_i, N_EXPERTS, dtype=F32) * gates[..., None], axis=1)
    out = jnp.zeros(t.shape, F32)
    for e in range(N_EXPERTS):
        out = out + comb[:, e:e + 1] * _swiglu(t, gate_up_w[e], down_w[e]).astype(F32)
    return out.astype(h.dtype).reshape(bsz, s, d)


def setup_inputs(seed: int = 0) -> dict:
    key = jax.random.key(seed)
    ks = jax.random.split(key, 26)

    def nrm(k, shape, scale):
        return jax.random.normal(k, shape, F32) * scale

    x = nrm(ks[0], (BATCH, SEQ, D_MODEL), 1.0)
    norm_w = 1.0 + nrm(ks[1], (DEPTH, 2, D_MODEL), 0.02)
    final_norm_w = 1.0 + nrm(ks[2], (D_MODEL,), 0.02)
    mix_in_w = nrm(ks[3], (N_EVEN, D_MODEL, MIX_IN), D_MODEL ** -0.5)
    gdn_conv_w = nrm(ks[4], (N_EVEN, CONV_W, GDN_CONV_CH), CONV_W ** -0.5)
    gdn_a_log = jnp.log(jax.random.uniform(ks[5], (N_EVEN, GDN_HEADS), F32, 1.0, 16.0))
    dt = jnp.exp(jax.random.uniform(ks[6], (N_EVEN, GDN_HEADS), F32, math.log(1e-3), math.log(1e-1)))
    gdn_dt_bias = dt + jnp.log(-jnp.expm1(-dt))
    gdn_norm_w = 1.0 + nrm(ks[7], (N_EVEN, GDN_DV), 0.02)
    hgrn_lb_logits = nrm(ks[8], (N_EVEN + 1, HG_FW), 0.1)
    hgrn_norm_w = 1.0 + nrm(ks[9], (N_EVEN, HG_DV), 0.02)
    mix_out_w = nrm(ks[10], (N_EVEN, MIX_OUT, D_MODEL), MIX_OUT ** -0.5)
    ffn_gate_up_w = nrm(ks[11], (N_EVEN, D_MODEL, 2 * D_FF), D_MODEL ** -0.5)
    ffn_down_w = nrm(ks[12], (N_EVEN, D_FF, D_MODEL), D_FF ** -0.5)
    rg_in_w = nrm(ks[13], (N_ODD, D_MODEL, 2 * LRU_WIDTH), D_MODEL ** -0.5)
    rg_conv_w = nrm(ks[14], (N_ODD, CONV_W, LRU_WIDTH), CONV_W ** -0.5)
    rg_conv_b = nrm(ks[15], (N_ODD, LRU_WIDTH), 0.01)
    rg_gate_a_w = nrm(ks[16], (N_ODD, RG_BLOCKS, RG_BLOCK, RG_BLOCK), RG_BLOCK ** -0.5)
    rg_gate_a_b = nrm(ks[17], (N_ODD, LRU_WIDTH), 0.01)
    rg_gate_x_w = nrm(ks[18], (N_ODD, RG_BLOCKS, RG_BLOCK, RG_BLOCK), RG_BLOCK ** -0.5)
    rg_gate_x_b = nrm(ks[19], (N_ODD, LRU_WIDTH), 0.01)
    a_c = jax.random.uniform(ks[20], (N_ODD, LRU_WIDTH), F32, 0.9, 0.999)
    a0 = a_c ** (1.0 / RG_C)
    rg_lambda = jnp.log(a0) - jnp.log1p(-a0)
    rg_out_w = nrm(ks[21], (N_ODD, LRU_WIDTH, D_MODEL), LRU_WIDTH ** -0.5)
    moe_router_w = nrm(ks[22], (N_ODD, D_MODEL, N_EXPERTS), D_MODEL ** -0.5)
    moe_gate_up_w = nrm(ks[23], (N_ODD, N_EXPERTS, D_MODEL, 2 * D_EXPERT), D_MODEL ** -0.5)
    moe_down_w = nrm(ks[24], (N_ODD, N_EXPERTS, D_EXPERT, D_MODEL), D_EXPERT ** -0.5)
    return {
        "x": x, "norm_w": norm_w, "final_norm_w": final_norm_w,
        "mix_in_w": mix_in_w, "gdn_conv_w": gdn_conv_w, "gdn_a_log": gdn_a_log,
        "gdn_dt_bias": gdn_dt_bias, "gdn_norm_w": gdn_norm_w, "hgrn_lb_logits": hgrn_lb_logits,
        "hgrn_norm_w": hgrn_norm_w, "mix_out_w": mix_out_w,
        "ffn_gate_up_w": ffn_gate_up_w, "ffn_down_w": ffn_down_w,
        "rg_in_w": rg_in_w, "rg_conv_w": rg_conv_w, "rg_conv_b": rg_conv_b,
        "rg_gate_a_w": rg_gate_a_w, "rg_gate_a_b": rg_gate_a_b,
        "rg_gate_x_w": rg_gate_x_w, "rg_gate_x_b": rg_gate_x_b,
        "rg_lambda": rg_lambda, "rg_out_w": rg_out_w,
        "moe_router_w": moe_router_w, "moe_gate_up_w": moe_gate_up_w, "moe_down_w": moe_down_w,
    }


def reference(x, norm_w, final_norm_w, mix_in_w, gdn_conv_w, gdn_a_log, gdn_dt_bias, gdn_norm_w,
              hgrn_lb_logits, hgrn_norm_w, mix_out_w, ffn_gate_up_w, ffn_down_w,
              rg_in_w, rg_conv_w, rg_conv_b, rg_gate_a_w, rg_gate_a_b, rg_gate_x_w, rg_gate_x_b,
              rg_lambda, rg_out_w, moe_router_w, moe_gate_up_w, moe_down_w):
    hgrn_lb = jnp.cumsum(jax.nn.softmax(hgrn_lb_logits.astype(F32), axis=0), axis=0)
    for layer in range(DEPTH):
        j = layer // 2
        h = _rmsnorm(x, norm_w[layer, 0])
        if layer % 2 == 0:
            x = x + _ab_mixer(h, mix_in_w[j], gdn_conv_w[j], gdn_a_log[j], gdn_dt_bias[j],
                              gdn_norm_w[j], hgrn_lb[j], hgrn_norm_w[j], mix_out_w[j])
            h = _rmsnorm(x, norm_w[layer, 1])
            x = x + _swiglu(h, ffn_gate_up_w[j], ffn_down_w[j])
        else:
            x = x + _rglru_block(h, rg_in_w[j], rg_conv_w[j], rg_conv_b[j], rg_gate_a_w[j],
                                 rg_gate_a_b[j], rg_gate_x_w[j], rg_gate_x_b[j], rg_lambda[j], rg_out_w[j])
            h = _rmsnorm(x, norm_w[layer, 1])
            x = x + _moe(h, moe_router_w[j], moe_gate_up_w[j], moe_down_w[j])
    return _rmsnorm(x, final_norm_w)
```

```cpp
#include <hip/hip_runtime.h>
#include <cstdio>
#include <cstdint>

#ifndef MK_SPLIT
#define MK_SPLIT 1
#endif

#define GAS __attribute__((address_space(1)))
#define LAS __attribute__((address_space(3)))
typedef unsigned short bf16;
typedef unsigned v4u __attribute__((ext_vector_type(4)));
typedef unsigned v2u __attribute__((ext_vector_type(2)));
typedef float f32x4 __attribute__((ext_vector_type(4)));
typedef float f32x2 __attribute__((ext_vector_type(2)));
typedef short bf16x8 __attribute__((ext_vector_type(8)));
#define RLX_AGENT __ATOMIC_RELAXED, __HIP_MEMORY_SCOPE_AGENT
#define LDS_WAIT() asm volatile("s_waitcnt lgkmcnt(0)" ::: "memory")
#define VM_WAIT() asm volatile("s_waitcnt vmcnt(0)" ::: "memory")

__device__ __forceinline__ unsigned f2bf(float f) { unsigned u = __builtin_bit_cast(unsigned, f); return (u + 0x7fffu + ((u >> 16) & 1u)) >> 16; }
__device__ __forceinline__ unsigned pk2(float lo, float hi) { return f2bf(lo) | (f2bf(hi) << 16); }
__device__ __forceinline__ float bf2f(unsigned short b) { return __builtin_bit_cast(float, ((unsigned)b) << 16); }
__device__ __forceinline__ float bflo(unsigned w) { return __builtin_bit_cast(float, w << 16); }
__device__ __forceinline__ float bfhi(unsigned w) { return __builtin_bit_cast(float, w & 0xffff0000u); }
__device__ __forceinline__ float sigmoidf_(float x) { return 1.0f / (1.0f + __expf(-x)); }
__device__ __forceinline__ float siluf_(float x) { return x / (1.0f + __expf(-x)); }
__device__ __forceinline__ float softplusf_(float x) { return x > 20.f ? x : log1pf(__expf(x)); }
__device__ __forceinline__ void lds_add(LAS unsigned* p, unsigned v) { (void)__hip_atomic_fetch_add(p, v, __ATOMIC_RELAXED, __HIP_MEMORY_SCOPE_WORKGROUP); }
__device__ __forceinline__ float wave_sum(float v) {
#pragma unroll
    for (int o = 1; o < 64; o <<= 1) v += __shfl_xor(v, o);
    return v;
}

constexpr int T = 8192, D = 2048, SEQ = 4096, NPROJ = 8192, FF = 5632, FE = 7168, NE = 8;
constexpr int MIXLD = 8208;
constexpr int PQ_AQ = 0, PQ_AK = 1024, PQ_AV = 2048, PQ_AZ = 3072, PQ_BQ = 4096, PQ_BF = 5120, PQ_BI = 6144, PQ_BG = 7168;
constexpr float EPS = 1e-6f;
constexpr int MOE_ROWS = 16384 + 8 * 256;

constexpr size_t al256(size_t x) { return (x + 255) & ~(size_t)255; }
constexpr size_t O_CTL = 0, CTL_BYTES = 1u << 20;
constexpr size_t O_WMI = CTL_BYTES;
constexpr size_t O_WMO = O_WMI + (size_t)NPROJ * D * 2;
constexpr size_t O_WFG = O_WMO + (size_t)D * D * 2;
constexpr size_t O_WFD = O_WFG + (size_t)2 * FF * D * 2;
constexpr size_t O_WRI = O_WFD + (size_t)D * FF * 2;
constexpr size_t O_WRG = O_WRI + (size_t)2 * D * D * 2;
constexpr size_t O_WRO = O_WRG + (size_t)16 * 256 * 256 * 2;
constexpr size_t O_WMG = O_WRO + (size_t)D * D * 2;
constexpr size_t O_WMD = O_WMG + (size_t)NE * 2 * FE * D * 2;
constexpr size_t O_XN = O_WMD + (size_t)NE * D * FE * 2;
constexpr size_t O_PROJ = O_XN + (size_t)T * D * 2;
constexpr size_t O_GB = O_PROJ + (size_t)T * NPROJ * 2;
constexpr size_t O_O = O_GB + (size_t)T * 16 * 4;
constexpr size_t O_X1 = O_O + (size_t)T * D * 2;
constexpr size_t O_X2 = O_X1 + (size_t)T * D * 4;
constexpr size_t O_X3 = O_X2 + (size_t)T * D * 4;
constexpr size_t O_ACT = O_X3 + (size_t)T * D * 4;
constexpr size_t O_Y = O_ACT + (size_t)T * FF * 2;
constexpr size_t O_XBR = O_Y + (size_t)T * D * 2;
constexpr size_t O_XC = O_XBR + (size_t)T * D * 2;
constexpr size_t O_AA = O_XC + (size_t)T * D * 2;
constexpr size_t O_BB = O_AA + (size_t)T * D * 4;
constexpr size_t O_YH = O_BB + (size_t)T * D * 4;
constexpr size_t O_SUMA = O_YH + (size_t)T * D * 2;
constexpr size_t O_SUMB = O_SUMA + (size_t)2 * 32 * D * 4;
constexpr size_t O_TOKE = O_SUMB + (size_t)2 * 32 * D * 4;
constexpr size_t O_TOKG = O_TOKE + (size_t)T * 4;
constexpr size_t O_POS = O_TOKG + (size_t)T * 8;
constexpr size_t O_WCNT = O_POS + (size_t)T * 8;
constexpr size_t O_EOFF = O_WCNT + 256 * 8 * 4;
constexpr size_t O_SPL = al256(O_EOFF + 64);
constexpr size_t O_HS = O_SPL + 2048 * 4;
constexpr size_t O_ACTM = O_HS + (size_t)MOE_ROWS * D * 2;
constexpr size_t O_YM = O_ACTM + (size_t)MOE_ROWS * FE * 2;
constexpr size_t O_QF = O_YM + (size_t)MOE_ROWS * D * 4;
constexpr size_t O_KF = O_QF + (size_t)T * 1024 * 4;
constexpr size_t O_VF = O_KF + (size_t)T * 1024 * 4;
constexpr size_t O_FH = O_VF + (size_t)T * 1024 * 4;
constexpr size_t O_QH = O_FH + (size_t)T * 1024 * 4;
constexpr size_t WS_END = O_QH + (size_t)T * 1024 * 4;

constexpr int CW_BAR = 4096;

constexpr int LDS_BYTES = 155648;
constexpr int MISC_OFF = 155648 - 256;

namespace pg8 {
constexpr int BM = 256, BK = 64, HALF = 128, HTB = HALF * BK * 2, STAGE_BYTES = 8 * HTB, NXCD = 8, WGM = 8;
__host__ __device__ __forceinline__ int lds_byte(int r, int c) { const int st = (r >> 4) * 2 + (c >> 5), rr = r & 15, cc = c & 31, ob = rr * 64 + cc * 2; return st * 1024 + (ob ^ (((ob >> 9) & 1) << 5)); }
__host__ __device__ __forceinline__ void stage_rc(int b, int& R, int& C) { const int st = b / 1024, sb = b % 1024, swz = sb ^ (((sb >> 9) & 1) << 5); R = (st >> 1) * 16 + swz / 64; C = (st & 1) * 32 + (swz % 64) / 2; }
__host__ __device__ __forceinline__ int perm32(int rho) { const int n = rho >> 4, i = rho & 15; return 8 * (i >> 2) + 4 * n + (i & 3); }

struct Unit { int pm, pn; long aoff, boff; };
struct Gemm { const bf16* A; const bf16* Bt; int lda, ldb, K; };

__device__ __forceinline__ bool std_order(int i, int G, int c, int nM, int nN, int& pm, int& pn) {
    const int nwg = nM * nN; const long L = (long)i * G + c; if (L >= nwg) return false;
    int wgid = (int)L; { const int q = nwg / NXCD, r = nwg % NXCD, xcd = wgid % NXCD, off = wgid / NXCD; wgid = (xcd < r ? xcd * (q + 1) : r * (q + 1) + (xcd - r) * q) + off; }
    const int nig = WGM * nN, gid = wgid / nig, fm = gid * WGM, gsz = (nM - fm) < WGM ? (nM - fm) : WGM;
    pm = fm + ((wgid % nig) % gsz); pn = (wgid % nig) / gsz; return true;
}
struct SchedStd {
    int nM, nN, G, c; long aT, bT;
    __device__ __forceinline__ bool next(int i, Unit& u) const { if (!std_order(i, G, c, nM, nN, u.pm, u.pn)) return false; u.aoff = (long)u.pm * aT; u.boff = (long)u.pn * bT; return true; }
};

template <class Epi, class Sched>
__device__ __forceinline__ void gemm_phase(LAS unsigned char* lds, const Gemm g, const Sched& S, const Epi& E) {
    const int tid = threadIdx.x, wid = __builtin_amdgcn_readfirstlane(tid >> 6), lane = tid & 63, wr = wid >> 2, wc = wid & 3, fr = lane & 15, fq = lane >> 4;
    const int K = g.K, nt = K / BK;
    unsigned voffA[2], voffB[2];
#pragma unroll
    for (int i = 0; i < 2; ++i) { int R, C; stage_rc(tid * 16 + i * 8192, R, C); const int Rb = Epi::PERM ? ((R & ~31) + perm32(R & 31)) : R;
        voffA[i] = (unsigned)(R * g.lda + C) * 2u; voffB[i] = (unsigned)(Rb * g.ldb + C) * 2u; }
    const size_t kstep = (size_t)(BK * 2);
    const size_t hstepA = (size_t)HALF * g.lda * 2, hstepB = (size_t)HALF * g.ldb * 2;
    const unsigned ldsw = (unsigned)wid * 1024u;
    const int aoff = lds_byte(wr * 64 + fr, fq * 8), boff = lds_byte(wc * 32 + fr, fq * 8);
#define PG8_SA(b, h) (((b) * 2 + (h)) * HTB)
#define PG8_SB(b, h) ((4 + (b) * 2 + (h)) * HTB)
#define PG8_STAGE(bufoff, gbase, voff) do { _Pragma("unroll") for (int _i = 0; _i < 2; ++_i) \
        __builtin_amdgcn_global_load_lds((const unsigned*)((const char*)(gbase) + (voff)[_i]), (LAS unsigned*)(lds + (bufoff) + ldsw + _i * 8192), 16, 0, 0); } while (0)
#define PG8_LDA(dst, b, h) do { _Pragma("unroll") for (int m = 0; m < 4; ++m) _Pragma("unroll") for (int k = 0; k < 2; ++k) dst[m][k] = *(const LAS bf16x8*)(lds + PG8_SA(b, h) + aoff + m * 2048 + k * 1024); } while (0)
#define PG8_LDB(dst, b, h) do { _Pragma("unroll") for (int n = 0; n < 2; ++n) _Pragma("unroll") for (int k = 0; k < 2; ++k) dst[n][k] = *(const LAS bf16x8*)(lds + PG8_SB(b, h) + boff + n * 2048 + k * 1024); } while (0)
#define PG8_MMA(ai, bj, At, Bt) do { __builtin_amdgcn_s_setprio(1); _Pragma("unroll") for (int m = 0; m < 4; ++m) _Pragma("unroll") for (int n = 0; n < 2; ++n) _Pragma("unroll") for (int k = 0; k < 2; ++k) \
        acc[ai][bj][m][n] = __builtin_amdgcn_mfma_f32_16x16x32_bf16(Bt[n][k], At[m][k], acc[ai][bj][m][n], 0, 0, 0); __builtin_amdgcn_s_setprio(0); } while (0)
#define PG8_WAIT_V(n) asm volatile("s_waitcnt vmcnt(" #n ")" ::: "memory")
#define PG8_WAIT_L(n) asm volatile("s_waitcnt lgkmcnt(" #n ")" ::: "memory")
#define PG8_BAR __builtin_amdgcn_s_barrier()
#define PG8_SCHED __builtin_amdgcn_sched_barrier(0)
    Unit cur, nxt; int ui = 0;
    if (!S.next(0, cur)) return;
    f32x4 acc[2][2][4][2];
#pragma unroll
    for (int a = 0; a < 2; ++a)
#pragma unroll
        for (int b = 0; b < 2; ++b)
#pragma unroll
            for (int m = 0; m < 4; ++m)
#pragma unroll
                for (int n = 0; n < 2; ++n) acc[a][b][m][n] = (f32x4){0.f, 0.f, 0.f, 0.f};
    bf16x8 At[4][2], B0[2][2], B1[2][2];
    const char* cA = (const char*)g.A + cur.aoff; const char* cB = (const char*)g.Bt + cur.boff;
    PG8_STAGE(PG8_SB(0, 0), cB, voffB); PG8_STAGE(PG8_SB(0, 1), cB + hstepB, voffB); PG8_STAGE(PG8_SA(0, 0), cA, voffA); PG8_STAGE(PG8_SA(0, 1), cA + hstepA, voffA);
    if (wr == 1) PG8_BAR;
    PG8_WAIT_V(2); PG8_BAR;
    PG8_STAGE(PG8_SB(1, 0), cB + kstep, voffB); PG8_STAGE(PG8_SA(1, 0), cA + kstep, voffA); PG8_STAGE(PG8_SB(1, 1), cB + hstepB + kstep, voffB);
    PG8_WAIT_V(6); PG8_BAR;
    for (;;) {
        const bool has_next = S.next(ui + 1, nxt);
        const char* nA = has_next ? (const char*)g.A + nxt.aoff : cA; const char* nB = has_next ? (const char*)g.Bt + nxt.boff : cB;
#pragma unroll 1
        for (int t = 0; t < nt; t += 2) {
            const bool last = (t == nt - 2);
            const char* a1 = cA + (size_t)(t + 1) * kstep;
            const char* a2 = last ? nA : cA + (size_t)(t + 2) * kstep; const char* b2 = last ? nB : cB + (size_t)(t + 2) * kstep;
            const char* a3 = a2 + kstep; const char* b3 = b2 + kstep;
            PG8_LDB(B0, 0, 0); PG8_LDB(B1, 0, 1); PG8_SCHED; PG8_LDA(At, 0, 0); PG8_STAGE(PG8_SA(1, 1), a1 + hstepA, voffA);
            PG8_WAIT_V(8); PG8_WAIT_L(0); PG8_BAR; PG8_MMA(0, 0, At, B0); PG8_MMA(0, 1, At, B1); PG8_BAR; PG8_SCHED;
            PG8_LDA(At, 0, 1); PG8_STAGE(PG8_SB(0, 0), b2, voffB); PG8_STAGE(PG8_SB(0, 1), b2 + hstepB, voffB); PG8_STAGE(PG8_SA(0, 0), a2, voffA);
            PG8_WAIT_V(8); PG8_WAIT_L(0); PG8_BAR; PG8_MMA(1, 0, At, B0); PG8_MMA(1, 1, At, B1); PG8_BAR; PG8_SCHED;
            PG8_LDB(B0, 1, 0); PG8_LDB(B1, 1, 1); PG8_SCHED; PG8_LDA(At, 1, 0); PG8_STAGE(PG8_SA(0, 1), a2 + hstepA, voffA);
            PG8_WAIT_V(8); PG8_WAIT_L(0); PG8_BAR; PG8_MMA(0, 0, At, B0); PG8_MMA(0, 1, At, B1); PG8_BAR; PG8_SCHED;
            PG8_LDA(At, 1, 1); PG8_STAGE(PG8_SB(1, 0), b3, voffB); PG8_STAGE(PG8_SB(1, 1), b3 + hstepB, voffB); PG8_STAGE(PG8_SA(1, 0), a3, voffA);
            PG8_WAIT_V(8); PG8_WAIT_L(0); PG8_BAR; PG8_MMA(1, 0, At, B0); PG8_MMA(1, 1, At, B1); PG8_BAR; PG8_SCHED;
        }
        if (wr == 0) PG8_BAR;
        E(acc, cur, wr, wc, fr, fq);
        if (!has_next) break;
#pragma unroll
        for (int a = 0; a < 2; ++a)
#pragma unroll
            for (int b = 0; b < 2; ++b)
#pragma unroll
                for (int m = 0; m < 4; ++m)
#pragma unroll
                    for (int n = 0; n < 2; ++n) acc[a][b][m][n] = (f32x4){0.f, 0.f, 0.f, 0.f};
        cur = nxt; cA = nA; cB = nB; ++ui;
        if (wr == 1) PG8_BAR;
    }
    PG8_WAIT_V(0);
    PG8_BAR;
#undef PG8_SA
#undef PG8_SB
#undef PG8_STAGE
#undef PG8_LDA
#undef PG8_LDB
#undef PG8_MMA
#undef PG8_WAIT_V
#undef PG8_WAIT_L
#undef PG8_BAR
#undef PG8_SCHED
}

struct EpiBf16 {
    static constexpr bool PERM = true;
    bf16* O; int ldc;
    __device__ __forceinline__ void operator()(const f32x4 (&acc)[2][2][4][2], const Unit& u, int wr, int wc, int fr, int fq) const {
        const int row0 = u.pm * BM + wr * 64 + fr, col0 = u.pn * BM + wc * 32 + 8 * fq;
#pragma unroll
        for (int ai = 0; ai < 2; ++ai)
#pragma unroll
            for (int m = 0; m < 4; ++m) { bf16* rowp = O + (size_t)(row0 + ai * HALF + m * 16) * ldc + col0;
#pragma unroll
                for (int bj = 0; bj < 2; ++bj) { const f32x4 v0 = acc[ai][bj][m][0], v1 = acc[ai][bj][m][1];
                    v4u w; w.x = pk2(v0[0], v0[1]); w.y = pk2(v0[2], v0[3]); w.z = pk2(v1[0], v1[1]); w.w = pk2(v1[2], v1[3]);
                    *(v4u*)(rowp + bj * HALF) = w; } }
    }
};
struct EpiSwiglu {
    static constexpr bool PERM = true;
    bf16* O; int ldc;
    __device__ __forceinline__ void operator()(const f32x4 (&acc)[2][2][4][2], const Unit& u, int wr, int wc, int fr, int fq) const {
        const int row0 = u.pm * BM + wr * 64 + fr, col0 = u.pn * HALF + wc * 32 + 8 * fq;
#pragma unroll
        for (int ai = 0; ai < 2; ++ai)
#pragma unroll
            for (int m = 0; m < 4; ++m) { bf16* rowp = O + (size_t)(row0 + ai * HALF + m * 16) * ldc + col0;
                float o[8];
#pragma unroll
                for (int n = 0; n < 2; ++n)
#pragma unroll
                    for (int j = 0; j < 4; ++j) { const float gt = acc[ai][0][m][n][j], up = acc[ai][1][m][n][j]; o[n * 4 + j] = gt * __builtin_amdgcn_rcpf(1.0f + __expf(-gt)) * up; }
                v4u w; w.x = pk2(o[0], o[1]); w.y = pk2(o[2], o[3]); w.z = pk2(o[4], o[5]); w.w = pk2(o[6], o[7]);
                *(v4u*)rowp = w; }
    }
};
struct EpiResF32 {
    static constexpr bool PERM = false;
    const float* base; float* out; int ldc;
    __device__ __forceinline__ void operator()(const f32x4 (&acc)[2][2][4][2], const Unit& u, int wr, int wc, int fr, int fq) const {
        const int row0 = u.pm * BM + wr * 64 + fr, col0 = u.pn * BM + wc * 32 + 4 * fq;
#pragma unroll
        for (int ai = 0; ai < 2; ++ai)
#pragma unroll
            for (int m = 0; m < 4; ++m) { const size_t off = (size_t)(row0 + ai * HALF + m * 16) * ldc + col0;
#pragma unroll
                for (int bj = 0; bj < 2; ++bj)
#pragma unroll
                    for (int n = 0; n < 2; ++n) { f32x4 v = acc[ai][bj][m][n]; if (base) v += *(const f32x4*)(base + off + bj * HALF + n * 16); *(f32x4*)(out + off + bj * HALF + n * 16) = v; } }
    }
};
struct EpiRgIn {
    static constexpr bool PERM = true;
    bf16* Y; bf16* XBR;
    __device__ __forceinline__ void operator()(const f32x4 (&acc)[2][2][4][2], const Unit& u, int wr, int wc, int fr, int fq) const {
        const bool isy = u.pn < 8; bf16* O = isy ? Y : XBR;
        const int row0 = u.pm * BM + wr * 64 + fr, col0 = (u.pn & 7) * BM + wc * 32 + 8 * fq;
#pragma unroll
        for (int ai = 0; ai < 2; ++ai)
#pragma unroll
            for (int m = 0; m < 4; ++m) { bf16* rowp = O + (size_t)(row0 + ai * HALF + m * 16) * D + col0;
#pragma unroll
                for (int bj = 0; bj < 2; ++bj) { float o[8];
#pragma unroll
                    for (int n = 0; n < 2; ++n)
#pragma unroll
                        for (int j = 0; j < 4; ++j) { float x = acc[ai][bj][m][n][j];
                            if (isy) { const float y2 = 1.5957691216f * (x + 0.044715f * x * x * x); x = x * __builtin_amdgcn_rcpf(1.0f + __expf(-y2)); }
                            o[n * 4 + j] = x; }
                    v4u w; w.x = pk2(o[0], o[1]); w.y = pk2(o[2], o[3]); w.z = pk2(o[4], o[5]); w.w = pk2(o[6], o[7]);
                    *(v4u*)(rowp + bj * HALF) = w; } }
    }
};
struct EpiGates {
    static constexpr bool PERM = false;
    const bf16* XC; const float* ba; const float* bx; const float* lam; float* AA; float* BB;
    __device__ __forceinline__ void operator()(const f32x4 (&acc)[2][2][4][2], const Unit& u, int wr, int wc, int fr, int fq) const {
        const int row0 = u.pm * BM + wr * 64 + fr, col0 = u.pn * HALF + wc * 32 + 4 * fq;
#pragma unroll
        for (int n = 0; n < 2; ++n) { const int col = col0 + n * 16;
            const f32x4 vba = *(const f32x4*)(ba + col), vbx = *(const f32x4*)(bx + col), sp = *(const f32x4*)(lam + col);
#pragma unroll
            for (int ai = 0; ai < 2; ++ai)
#pragma unroll
                for (int m = 0; m < 4; ++m) { const size_t off = (size_t)(row0 + ai * HALF + m * 16) * D + col;
                    const v2u xw = *(const v2u*)(XC + off); const float xc[4] = {bflo(xw.x), bfhi(xw.x), bflo(xw.y), bfhi(xw.y)};
                    f32x4 oa, ob;
#pragma unroll
                    for (int j = 0; j < 4; ++j) { const float r = sigmoidf_(acc[ai][0][m][n][j] + vba[j]), gi = sigmoidf_(acc[ai][1][m][n][j] + vbx[j]);
                        const float la = sp[j] * r, t2 = 2.0f * la; oa[j] = __expf(la);
                        const float em = (t2 > -0.01f) ? -t2 * (1.0f + 0.5f * t2 * (1.0f + 0.33333334f * t2)) : 1.0f - __expf(t2);
                        ob[j] = sqrtf(fmaxf(em, 0.f)) * (gi * xc[j]); }
                    *(f32x4*)(AA + off) = oa; *(f32x4*)(BB + off) = ob; asm volatile("" ::: "memory"); } }
    }
};
}

#define XB_TMO      128
#define XB_XCNT(j)  (256  + 64 * (j))
#define XB_XSUB(j)  (1280 + 64 * (j))
#define XB_XGEN(j)  (2304 + 64 * (j))
#define XB_TOP      3328
#define XB_TOPGEN   3392
#define XCD_BAR_WORDS 3456
#define XB_SPIN_CAP (1u << 22)
__device__ __forceinline__ unsigned xb_ld(unsigned* p)              { return __hip_atomic_load(p, __ATOMIC_RELAXED, __HIP_MEMORY_SCOPE_AGENT); }
__device__ __forceinline__ unsigned xb_add(unsigned* p, unsigned v) { return __hip_atomic_fetch_add(p, v, __ATOMIC_RELAXED, __HIP_MEMORY_SCOPE_AGENT); }
__device__ __forceinline__ unsigned xb_xcc_id() { return (unsigned)__builtin_amdgcn_s_getreg((3 << 11) | 20) & 0xFu; }
#define XB_SPIN(cond, bar) do { unsigned _sp = 0; while (cond) { __builtin_amdgcn_s_sleep(1); \
    if ((++_sp & 255u) == 0u) { if (xb_ld(&(bar)[XB_TMO])) break; if (_sp > XB_SPIN_CAP) { atomicAdd(&(bar)[XB_TMO], 1u); break; } } } } while (0)
struct XcdBarrier { unsigned* bar; unsigned x; volatile LAS unsigned* st; };
__device__ __forceinline__ XcdBarrier xcd_barrier_post(unsigned* bar, volatile LAS unsigned* st) {
    XcdBarrier b; b.bar = bar; b.x = xb_xcc_id(); b.st = st;
    if (threadIdx.x == 0) (void)xb_add(&bar[XB_XCNT(b.x)], 1u);
    return b;
}
__device__ __forceinline__ void xcd_barrier_complete(unsigned* bar, unsigned x, unsigned& nloc, unsigned& nx) {
    const unsigned G = gridDim.x * gridDim.y * gridDim.z;
    unsigned sum, cnt, mine, sp = 0u;
    for (;;) {
        sum = 0u; cnt = 0u; mine = 0u;
#pragma unroll
        for (unsigned j = 0; j < 16; ++j) { const unsigned c = xb_ld(&bar[XB_XCNT(j)]); sum += c; cnt += (c > 0u) ? 1u : 0u; mine = (j == x) ? c : mine; }
        if (sum == G) break;
        __builtin_amdgcn_s_sleep(1);
        if ((++sp & 255u) == 0u) { if (xb_ld(&bar[XB_TMO])) break; if (sp > XB_SPIN_CAP) { atomicAdd(&bar[XB_TMO], 1u); break; } }
    }
    nloc = mine > 0u ? mine : 1u; nx = cnt > 0u ? cnt : 1u;
}
__device__ __forceinline__ void xcd_barrier(const XcdBarrier& b) {
    asm volatile("s_waitcnt vmcnt(0)" ::: "memory");
    __syncthreads();
    if (threadIdx.x == 0) {
        unsigned* bar = b.bar;
        __builtin_amdgcn_s_waitcnt(0);
        unsigned nloc = b.st[0], nx = b.st[1];
        if (nloc == 0u) { xcd_barrier_complete(bar, b.x, nloc, nx); b.st[0] = nloc; b.st[1] = nx; }
        const unsigned old = xb_add(&bar[XB_XSUB(b.x)], 1u);
        const unsigned gen = old / nloc;
        if (old + 1u == (gen + 1u) * nloc) {
            __builtin_amdgcn_fence(__ATOMIC_RELEASE, "agent");
            asm volatile("s_waitcnt vmcnt(0)" ::: "memory");
            const unsigned og = xb_add(&bar[XB_TOP], 1u);
            const unsigned tg = og / nx;
            if (og + 1u == (tg + 1u) * nx) xb_add(&bar[XB_TOPGEN], 1u);
            else XB_SPIN(xb_ld(&bar[XB_TOPGEN]) == tg, bar);
            __builtin_amdgcn_fence(__ATOMIC_ACQUIRE, "agent");
            xb_add(&bar[XB_XGEN(b.x)], 1u);
            asm volatile("s_waitcnt vmcnt(0)" ::: "memory");
        } else {
            XB_SPIN(xb_ld(&bar[XB_XGEN(b.x)]) == gen, bar);
            __builtin_amdgcn_fence(__ATOMIC_ACQUIRE, "agent");
            asm volatile("s_waitcnt vmcnt(0)" ::: "memory");
        }
    }
    __syncthreads();
}

struct Frame {
    LAS unsigned char* lds;
    int tid, lane, wave, G, blk;
    unsigned char* ws;
    const float* in[25];
    float* out;
};
enum { I_X = 0, I_NORMW, I_FNW, I_MIXIN, I_GCONV, I_ALOG, I_DTB, I_GNW, I_LBL, I_HNW, I_MIXOUT, I_FGU, I_FD, I_RGIN, I_RGCW, I_RGCB, I_RGAW, I_RGAB, I_RGXW, I_RGXB, I_LAM, I_RGOUT, I_ROUTER, I_MGU, I_MD };

struct Job { const float* src; bf16* dst; int ld, K, n0, ncols, drow0, mode, nbatch; long sbs; int dbs; };
__device__ __forceinline__ void conv_item(const Job& jb, LAS float* scr, int item, int lane) {
    const int nblk = jb.ncols / 32, per = (jb.K / 64) * nblk, b = item / per, r = item % per, kb = r / nblk, nb = r % nblk, k0 = 64 * kb, n0l = 32 * nb;
    const float* sp = jb.src + (size_t)b * jb.sbs + (size_t)k0 * jb.ld + jb.n0 + n0l;
#pragma unroll 8
    for (int i = 0; i < 32; ++i) { const int kk = 2 * i + (lane >> 5); scr[kk * 33 + (lane & 31)] = sp[(size_t)kk * jb.ld + (lane & 31)]; }
    LDS_WAIT(); asm volatile("" ::: "memory");
    const int c = lane & 7;
#pragma unroll
    for (int j = 0; j < 4; ++j) { const int n = (lane >> 3) + 8 * j, nl = n0l + n; const LAS float* s = scr + (8 * c) * 33 + n;
        const int drow = jb.drow0 + b * jb.dbs + (jb.mode ? ((nl >> 7) * 256 + (nl & 127)) : nl);
        v4u o; o.x = pk2(s[0 * 33], s[1 * 33]); o.y = pk2(s[2 * 33], s[3 * 33]); o.z = pk2(s[4 * 33], s[5 * 33]); o.w = pk2(s[6 * 33], s[7 * 33]);
        *(v4u*)(jb.dst + (size_t)drow * jb.K + k0 + 8 * c) = o; }
    LDS_WAIT(); asm volatile("" ::: "memory");
}
constexpr int NJOBS = 13;
__device__ __forceinline__ Job get_job(const Frame& F, int j) {
    Job b; b.n0 = 0; b.drow0 = 0; b.mode = 0; b.nbatch = 1; b.sbs = 0; b.dbs = 0;
    unsigned char* ws = F.ws;
    switch (j) {
    case 0:  b.src = F.in[I_MIXIN]; b.dst = (bf16*)(ws + O_WMI); b.ld = MIXLD; b.K = D; b.ncols = 4096; break;
    case 1:  b.src = F.in[I_MIXIN]; b.dst = (bf16*)(ws + O_WMI); b.ld = MIXLD; b.K = D; b.n0 = 4112; b.ncols = 4096; b.drow0 = 4096; break;
    case 2:  b.src = F.in[I_MIXOUT]; b.dst = (bf16*)(ws + O_WMO); b.ld = D; b.K = D; b.ncols = D; break;
    case 3:  b.src = F.in[I_FGU]; b.dst = (bf16*)(ws + O_WFG); b.ld = 2 * FF; b.K = D; b.ncols = FF; b.mode = 1; break;
    case 4:  b.src = F.in[I_FGU]; b.dst = (bf16*)(ws + O_WFG); b.ld = 2 * FF; b.K = D; b.n0 = FF; b.ncols = FF; b.drow0 = 128; b.mode = 1; break;
    case 5:  b.src = F.in[I_FD]; b.dst = (bf16*)(ws + O_WFD); b.ld = D; b.K = FF; b.ncols = D; break;
    case 6:  b.src = F.in[I_RGIN]; b.dst = (bf16*)(ws + O_WRI); b.ld = 2 * D; b.K = D; b.ncols = 2 * D; break;
    case 7:  b.src = F.in[I_RGAW]; b.dst = (bf16*)(ws + O_WRG); b.ld = 256; b.K = 256; b.ncols = 256; b.mode = 1; b.nbatch = 8; b.sbs = 65536; b.dbs = 512; break;
    case 8:  b.src = F.in[I_RGXW]; b.dst = (bf16*)(ws + O_WRG); b.ld = 256; b.K = 256; b.ncols = 256; b.drow0 = 128; b.mode = 1; b.nbatch = 8; b.sbs = 65536; b.dbs = 512; break;
    case 9:  b.src = F.in[I_RGOUT]; b.dst = (bf16*)(ws + O_WRO); b.ld = D; b.K = D; b.ncols = D; break;
    case 10: b.src = F.in[I_MGU]; b.dst = (bf16*)(ws + O_WMG); b.ld = 2 * FE; b.K = D; b.ncols = FE; b.mode = 1; b.nbatch = 8; b.sbs = (long)D * 2 * FE; b.dbs = 2 * FE; break;
    case 11: b.src = F.in[I_MGU]; b.dst = (bf16*)(ws + O_WMG); b.ld = 2 * FE; b.K = D; b.n0 = FE; b.ncols = FE; b.drow0 = 128; b.mode = 1; b.nbatch = 8; b.sbs = (long)D * 2 * FE; b.dbs = 2 * FE; break;
    default: b.src = F.in[I_MD]; b.dst = (bf16*)(ws + O_WMD); b.ld = D; b.K = FE; b.ncols = D; b.nbatch = 8; b.sbs = (long)FE * D; b.dbs = D; break;
    }
    return b;
}
__device__ __forceinline__ void convert_jobs(const Frame& F, int j0, int j1, int gw, int ngw) {
    LAS float* scr = (LAS float*)(F.lds + F.wave * 16384);
    for (int j = j0; j < j1; ++j) { const Job jb = get_job(F, j); const int nitems = jb.nbatch * (jb.K / 64) * (jb.ncols / 32);
        for (int it = gw; it < nitems; it += ngw) conv_item(jb, scr, it, F.lane); }
}

__device__ __forceinline__ void rms_load(const float* xrow, const float* nw, int lane, f32x4 (&v)[8]) {
    float s = 0.f;
#pragma unroll
    for (int j = 0; j < 8; ++j) { v[j] = ((const f32x4*)xrow)[lane + 64 * j]; s += (v[j].x * v[j].x + v[j].y * v[j].y) + (v[j].z * v[j].z + v[j].w * v[j].w); }
    const float rstd = rsqrtf(wave_sum(s) * (1.0f / D) + EPS);
#pragma unroll
    for (int j = 0; j < 8; ++j) { const f32x4 w = ((const f32x4*)nw)[lane + 64 * j]; v[j] = v[j] * rstd * w; }
}
__device__ __forceinline__ void row_store_bf16(bf16* orow, int lane, const f32x4 (&v)[8]) {
#pragma unroll
    for (int j = 0; j < 8; ++j) { v2u w; w.x = pk2(v[j].x, v[j].y); w.y = pk2(v[j].z, v[j].w); ((v2u*)orow)[lane + 64 * j] = w; }
}

__device__ __forceinline__ void phase_prologue(const Frame& F) {
    const int gw = F.blk * 8 + F.wave, ngw = F.G * 8;
    convert_jobs(F, 0, NJOBS, gw, ngw);
    if (F.blk == 0) for (int i = F.tid; i < D; i += 512) ((float*)(F.ws + O_SPL))[i] = -8.0f * log1pf(__expf(-F.in[I_LAM][i]));
    __syncthreads();
    LAS float* w16 = (LAS float*)F.lds;
    const float* W = F.in[I_MIXIN];
    for (int idx = F.tid; idx < D * 16; idx += 512) { const int c = idx & 15, i = idx >> 4; w16[c * 2052 + i] = W[(size_t)i * MIXLD + 4096 + c]; }
    __syncthreads();
    const float* nw = F.in[I_NORMW];
    bf16* XN = (bf16*)(F.ws + O_XN); float* GB = (float*)(F.ws + O_GB);
    for (int m = gw; m < T; m += ngw) {
        f32x4 v[8]; rms_load(F.in[I_X] + (size_t)m * D, nw, F.lane, v);
        row_store_bf16(XN + (size_t)m * D, F.lane, v);
        float mine = 0.f;
#pragma unroll 1
        for (int c = 0; c < 16; ++c) { float a = 0.f;
#pragma unroll
            for (int j = 0; j < 8; ++j) { const f32x4 w = *(const LAS f32x4*)(w16 + c * 2052 + 4 * F.lane + 256 * j); a += (v[j].x * w.x + v[j].y * w.y) + (v[j].z * w.z + v[j].w * w.w); }
            a = wave_sum(a); if (F.lane == c) mine = a; }
        if (F.lane < 8) GB[(size_t)m * 16 + F.lane] = sigmoidf_(mine);
        else if (F.lane < 16) { const int h = F.lane - 8; GB[(size_t)m * 16 + F.lane] = -__expf(F.in[I_ALOG][h]) * softplusf_(mine + F.in[I_DTB][h]); }
    }
    __syncthreads();
}

__device__ __forceinline__ void phase_rms(const Frame& F, const float* X, const float* nw) {
    const int gw = F.blk * 8 + F.wave, ngw = F.G * 8; bf16* XN = (bf16*)(F.ws + O_XN);
    for (int m = gw; m < T; m += ngw) { f32x4 v[8]; rms_load(X + (size_t)m * D, nw, F.lane, v); row_store_bf16(XN + (size_t)m * D, F.lane, v); }
}

__device__ __forceinline__ void phase_mix_pre(const Frame& F) {
    const int gw = F.blk * 8 + F.wave, ngw = F.G * 8, lane = F.lane;
    const bf16* P = (const bf16*)(F.ws + O_PROJ);
    float* QF = (float*)(F.ws + O_QF); float* KF = (float*)(F.ws + O_KF); float* VF = (float*)(F.ws + O_VF); float* FH = (float*)(F.ws + O_FH); float* QH = (float*)(F.ws + O_QH);
    const float* cw = F.in[I_GCONV];
    const float* lbl = F.in[I_LBL];
    for (int it = gw; it < T * 8; it += ngw) {
        const int t = it >> 3, h = it & 7, s = t & (SEQ - 1), d = h * 128 + 2 * lane;
        float r[3][2];
#pragma unroll
        for (int mat = 0; mat < 3; ++mat) { float a0 = 0.f, a1 = 0.f;
#pragma unroll
            for (int j = 0; j < 4; ++j) { if (s - 3 + j >= 0) { const unsigned w = *(const unsigned*)(P + (size_t)(t - 3 + j) * NPROJ + mat * 1024 + d);
                    const f32x2 c = *(const f32x2*)(cw + j * 3072 + mat * 1024 + d); a0 += c.x * bflo(w); a1 += c.y * bfhi(w); } }
            r[mat][0] = siluf_(a0); r[mat][1] = siluf_(a1); }
        const float qs = wave_sum(r[0][0] * r[0][0] + r[0][1] * r[0][1]), ks = wave_sum(r[1][0] * r[1][0] + r[1][1] * r[1][1]);
        const float qn = rsqrtf(qs + EPS) * 0.08838834764831845f, kn = rsqrtf(ks + EPS);
        const size_t o = (size_t)t * 1024 + d;
        *(f32x2*)(QF + o) = (f32x2){r[0][0] * qn, r[0][1] * qn}; *(f32x2*)(KF + o) = (f32x2){r[1][0] * kn, r[1][1] * kn}; *(f32x2*)(VF + o) = (f32x2){r[2][0], r[2][1]};
        const unsigned wq = *(const unsigned*)(P + (size_t)t * NPROJ + PQ_BQ + d), wf = *(const unsigned*)(P + (size_t)t * NPROJ + PQ_BF + d);
        const f32x2 l0 = *(const f32x2*)(lbl + d), l1 = *(const f32x2*)(lbl + 1024 + d);
        const float lb0 = sigmoidf_(l0.x - l1.x), lb1 = sigmoidf_(l0.y - l1.y);
        *(f32x2*)(FH + o) = (f32x2){lb0 + (1.f - lb0) * sigmoidf_(bflo(wf)), lb1 + (1.f - lb1) * sigmoidf_(bfhi(wf))};
        *(f32x2*)(QH + o) = (f32x2){siluf_(bflo(wq)) * 0.08838834764831845f, siluf_(bfhi(wq)) * 0.08838834764831845f};
    }
}

__device__ __forceinline__ void phase_mix_scan_slow(const Frame& F) {
    if (F.blk >= 32) return;
    const int mixer = F.blk >> 4, b = (F.blk >> 3) & 1, h = F.blk & 7, tid = F.tid;
    LAS float* ks = (LAS float*)F.lds;
    LAS float* qs = ks + 8192; LAS float* vs = qs + 8192; LAS float* ot = vs + 8192;
    LAS float* red1 = ot + 8192; LAS float* red2 = red1 + 512; LAS float* ab = red2 + 512;
    const float* KSRC = (const float*)(F.ws + (mixer ? O_FH : O_KF)); const float* QSRC = (const float*)(F.ws + (mixer ? O_QH : O_QF)); const float* VSRC = (const float*)(F.ws + O_VF);
    const bf16* P = (const bf16*)(F.ws + O_PROJ); const float* GB = (const float*)(F.ws + O_GB);
    bf16* O = (bf16*)(F.ws + O_O);
    const float* nw = mixer ? F.in[I_HNW] : F.in[I_GNW];
    const int e = tid & 127, qd = tid >> 7;
    float S[32];
#pragma unroll
    for (int i = 0; i < 32; ++i) S[i] = 0.f;
    for (int n = 0; n < 64; ++n) {
        const int t0 = b * SEQ + n * 64;
        for (int idx = tid; idx < 64 * 32; idx += 512) { const int r = idx >> 5, c4 = (idx & 31) * 4; const size_t go = (size_t)(t0 + r) * 1024 + h * 128 + c4;
            *(LAS f32x4*)(ks + r * 128 + c4) = *(const f32x4*)(KSRC + go); *(LAS f32x4*)(qs + r * 128 + c4) = *(const f32x4*)(QSRC + go);
            f32x4 vv; if (mixer) { const v2u w = *(const v2u*)(P + (size_t)(t0 + r) * NPROJ + PQ_BI + h * 128 + c4); vv = (f32x4){bflo(w.x), bfhi(w.x), bflo(w.y), bfhi(w.y)}; } else vv = *(const f32x4*)(VSRC + go);
            *(LAS f32x4*)(vs + r * 128 + c4) = vv; }
        if (tid < 64) { ab[tid * 2] = __expf(GB[(size_t)(t0 + tid) * 16 + 8 + h]); ab[tid * 2 + 1] = GB[(size_t)(t0 + tid) * 16 + h]; }
        __syncthreads();
        for (int r = 0; r < 64; ++r) {
            const LAS float* kr = ks + r * 128 + qd * 32; const LAS float* qr = qs + r * 128 + qd * 32; const float ve = vs[r * 128 + e];
            float osum = 0.f;
            if (mixer == 0) {
                const float a = ab[r * 2], bt = ab[r * 2 + 1];
                float p = 0.f;
#pragma unroll
                for (int i = 0; i < 32; ++i) p += kr[i] * S[i];
                red1[qd * 128 + e] = p;
                __syncthreads();
                const float kS = (red1[e] + red1[128 + e]) + (red1[256 + e] + red1[384 + e]);
                const float c1 = bt * (ve - a * kS);
#pragma unroll
                for (int i = 0; i < 32; ++i) { S[i] = a * S[i] + kr[i] * c1; osum += qr[i] * S[i]; }
            } else {
#pragma unroll
                for (int i = 0; i < 32; ++i) { const float f = kr[i]; S[i] = f * S[i] + (1.f - f) * ve; osum += qr[i] * S[i]; }
            }
            red2[qd * 128 + e] = osum;
            __syncthreads();
            if (tid < 128) ot[r * 128 + e] = (red2[e] + red2[128 + e]) + (red2[256 + e] + red2[384 + e]);
        }
        __syncthreads();
        {
            const int r = tid >> 3, c0 = (tid & 7) * 16; float o[16]; float ss = 0.f;
#pragma unroll
            for (int i = 0; i < 16; ++i) { o[i] = ot[r * 128 + c0 + i]; ss += o[i] * o[i]; }
            ss += __shfl_xor(ss, 1); ss += __shfl_xor(ss, 2); ss += __shfl_xor(ss, 4);
            const float rstd = rsqrtf(ss * (1.0f / 128.0f) + EPS);
            const bf16* zp = P + (size_t)(t0 + r) * NPROJ + (mixer ? PQ_BG : PQ_AZ) + h * 128 + c0;
            const v4u z0 = *(const v4u*)zp, z1 = *(const v4u*)(zp + 8);
            const unsigned zw[8] = {z0.x, z0.y, z0.z, z0.w, z1.x, z1.y, z1.z, z1.w};
            unsigned ow[8];
#pragma unroll
            for (int i = 0; i < 8; ++i) { const float za = bflo(zw[i]), zb = bfhi(zw[i]);
                ow[i] = pk2(o[2 * i] * rstd * nw[c0 + 2 * i] * siluf_(za), o[2 * i + 1] * rstd * nw[c0 + 2 * i + 1] * siluf_(zb)); }
            bf16* op = O + (size_t)(t0 + r) * D + mixer * 1024 + h * 128 + c0;
            *(v4u*)op = (v4u){ow[0], ow[1], ow[2], ow[3]}; *(v4u*)(op + 8) = (v4u){ow[4], ow[5], ow[6], ow[7]};
        }
        __syncthreads();
    }
}

__device__ __forceinline__ void phase_lru_conv(const Frame& F) {
    const bf16* XBR = (const bf16*)(F.ws + O_XBR); bf16* XC = (bf16*)(F.ws + O_XC);
    const float* cw = F.in[I_RGCW]; const float* cb = F.in[I_RGCB];
    for (int idx = F.blk * 512 + F.tid; idx < T * 256; idx += F.G * 512) {
        const int t = idx >> 8, c0 = (idx & 255) * 8, s = t & (SEQ - 1);
        float a[8];
        { const f32x4 b0 = *(const f32x4*)(cb + c0), b1 = *(const f32x4*)(cb + c0 + 4); a[0] = b0.x; a[1] = b0.y; a[2] = b0.z; a[3] = b0.w; a[4] = b1.x; a[5] = b1.y; a[6] = b1.z; a[7] = b1.w; }
#pragma unroll
        for (int j = 0; j < 4; ++j) { if (s - 3 + j >= 0) { const v4u w = *(const v4u*)(XBR + (size_t)(t - 3 + j) * D + c0);
                const f32x4 k0 = *(const f32x4*)(cw + j * D + c0), k1 = *(const f32x4*)(cw + j * D + c0 + 4);
                a[0] += k0.x * bflo(w.x); a[1] += k0.y * bfhi(w.x); a[2] += k0.z * bflo(w.y); a[3] += k0.w * bfhi(w.y);
                a[4] += k1.x * bflo(w.z); a[5] += k1.y * bfhi(w.z); a[6] += k1.z * bflo(w.w); a[7] += k1.w * bfhi(w.w); } }
        *(v4u*)(XC + (size_t)t * D + c0) = (v4u){pk2(a[0], a[1]), pk2(a[2], a[3]), pk2(a[4], a[5]), pk2(a[6], a[7])};
    }
}
__device__ __forceinline__ void phase_lru_scan1(const Frame& F) {
    const float* AA = (const float*)(F.ws + O_AA); const float* BB = (const float*)(F.ws + O_BB);
    float* SA = (float*)(F.ws + O_SUMA); float* SB = (float*)(F.ws + O_SUMB);
    for (int gid = F.blk * 512 + F.tid; gid < 2 * 32 * D; gid += F.G * 512) {
        const int ch = gid & 2047, chunk = (gid >> 11) & 31, b = gid >> 16; const size_t base = (size_t)(b * SEQ + chunk * 128) * D + ch;
        float hh = 0.f, pp = 1.f;
#pragma unroll 8
        for (int i = 0; i < 128; ++i) { const float a = AA[base + (size_t)i * D], bb = BB[base + (size_t)i * D]; hh = a * hh + bb; pp *= a; }
        SA[gid] = pp; SB[gid] = hh;
    }
}
__device__ __forceinline__ void phase_lru_scan2(const Frame& F) {
    const float* AA = (const float*)(F.ws + O_AA); const float* BB = (const float*)(F.ws + O_BB);
    const float* SA = (const float*)(F.ws + O_SUMA); const float* SB = (const float*)(F.ws + O_SUMB);
    const bf16* Y = (const bf16*)(F.ws + O_Y); bf16* YH = (bf16*)(F.ws + O_YH);
    for (int gid = F.blk * 512 + F.tid; gid < 2 * 32 * D; gid += F.G * 512) {
        const int ch = gid & 2047, chunk = (gid >> 11) & 31, b = gid >> 16; const size_t base = (size_t)(b * SEQ + chunk * 128) * D + ch;
        float hh = 0.f;
        for (int c = 0; c < chunk; ++c) { const int g2 = (b * 32 + c) * D + ch; hh = SA[g2] * hh + SB[g2]; }
#pragma unroll 8
        for (int i = 0; i < 128; ++i) { const float a = AA[base + (size_t)i * D], bb = BB[base + (size_t)i * D]; hh = a * hh + bb;
            YH[base + (size_t)i * D] = (bf16)f2bf(bf2f(Y[base + (size_t)i * D]) * hh); }
    }
}

__device__ __forceinline__ void phase_route1(const Frame& F) {
    const int gw = F.blk * 8 + F.wave, ngw = F.G * 8, lane = F.lane;
    LAS float* rwt = (LAS float*)F.lds;
    LAS unsigned* cntL = (LAS unsigned*)(F.lds + 8 * 2052 * 4);
    const float* RW = F.in[I_ROUTER];
    for (int idx = F.tid; idx < D * 8; idx += 512) { const int e = idx & 7, i = idx >> 3; rwt[e * 2052 + i] = RW[idx]; }
    if (F.tid < 8) cntL[F.tid] = 0u;
    __syncthreads();
    const float* X3 = (const float*)(F.ws + O_X3); const float* nw = F.in[I_NORMW] + 3 * D;
    bf16* XN = (bf16*)(F.ws + O_XN); unsigned* TOKE = (unsigned*)(F.ws + O_TOKE); float* TOKG = (float*)(F.ws + O_TOKG);
    for (int m = gw; m < T; m += ngw) {
        f32x4 v[8]; rms_load(X3 + (size_t)m * D, nw, lane, v);
        row_store_bf16(XN + (size_t)m * D, lane, v);
        float v0 = -3.0e38f, v1 = -3.0e38f; int i0 = 0, i1 = 0;
#pragma unroll 1
        for (int e = 0; e < 8; ++e) { float a = 0.f;
#pragma unroll
            for (int j = 0; j < 8; ++j) { const f32x4 w = *(const LAS f32x4*)(rwt + e * 2052 + 4 * lane + 256 * j); a += (v[j].x * w.x + v[j].y * w.y) + (v[j].z * w.z + v[j].w * w.w); }
            a = wave_sum(a);
            if (a > v0) { v1 = v0; i1 = i0; v0 = a; i0 = e; } else if (a > v1) { v1 = a; i1 = e; } }
        if (lane == 0) { const float g0 = 1.0f / (1.0f + __expf(v1 - v0)); TOKE[m] = (unsigned)i0 | ((unsigned)i1 << 8); TOKG[2 * m] = g0; TOKG[2 * m + 1] = 1.0f - g0;
            lds_add(cntL + i0, 1u); lds_add(cntL + i1, 1u); }
    }
    __syncthreads();
    if (F.tid < 8) ((unsigned*)(F.ws + O_WCNT))[F.blk * 8 + F.tid] = cntL[F.tid];
}
__device__ __forceinline__ void phase_route2(const Frame& F) {
    LAS unsigned* tot = (LAS unsigned*)F.lds; LAS unsigned* pre = tot + 8; LAS unsigned* eoff = tot + 16; LAS unsigned* basep = tot + 32; LAS unsigned* lpos = tot + 64; LAS unsigned* ltok = tot + 128;
    const unsigned* WCNT = (const unsigned*)(F.ws + O_WCNT); const unsigned* TOKE = (const unsigned*)(F.ws + O_TOKE);
    if (F.tid < 16) tot[F.tid] = 0u;
    if (F.tid < 32) ltok[F.tid] = TOKE[F.blk * 8 + (F.tid & 7) + 2048 * (F.tid >> 3)];
    __syncthreads();
    for (int idx = F.tid; idx < F.G * 8; idx += 512) { const int w = idx >> 3, e = idx & 7; const unsigned v = WCNT[idx]; lds_add(tot + e, v); if (w < F.blk) lds_add(pre + e, v); }
    __syncthreads();
    if (F.tid == 0) {
        unsigned off = 0;
        for (int e = 0; e < 8; ++e) { eoff[e] = off; basep[e] = off + pre[e]; off += (tot[e] + 255u) & ~255u; }
        eoff[8] = off;
        for (int i = 0; i < 32; ++i) { const unsigned te = ltok[i]; const unsigned e0 = te & 255u, e1 = te >> 8;
            lpos[2 * i] = basep[e0]; basep[e0] += 1; lpos[2 * i + 1] = basep[e1]; basep[e1] += 1; }
    }
    __syncthreads();
    if (F.blk == 0 && F.tid < 9) ((unsigned*)(F.ws + O_EOFF))[F.tid] = eoff[F.tid];
    if (F.tid < 32) { const int m = F.blk * 8 + (F.tid & 7) + 2048 * (F.tid >> 3); ((unsigned*)(F.ws + O_POS))[2 * m] = lpos[2 * F.tid]; ((unsigned*)(F.ws + O_POS))[2 * m + 1] = lpos[2 * F.tid + 1]; }
    const bf16* XN = (const bf16*)(F.ws + O_XN); bf16* HS = (bf16*)(F.ws + O_HS);
    for (int k = 0; k < 4; ++k) { const int li = k * 8 + F.wave, m = F.blk * 8 + F.wave + 2048 * k; const v4u* src = (const v4u*)(XN + (size_t)m * D);
        v4u a[4];
#pragma unroll
        for (int j = 0; j < 4; ++j) a[j] = src[F.lane + 64 * j];
#pragma unroll
        for (int sl = 0; sl < 2; ++sl) { v4u* dst = (v4u*)(HS + (size_t)lpos[2 * li + sl] * D);
#pragma unroll
            for (int j = 0; j < 4; ++j) dst[F.lane + 64 * j] = a[j]; } }
    if (F.blk < 8) {
        const unsigned r0 = eoff[F.blk] + tot[F.blk], r1 = eoff[F.blk + 1];
        for (unsigned idx = r0 * 256 + F.tid; idx < r1 * 256; idx += 512) ((v4u*)HS)[idx] = (v4u){0u, 0u, 0u, 0u};
    }
    __syncthreads();
}
struct SchedMoe {
    int nN, G, c, nrt; long aT, bT, bE; unsigned eo[9];
    __device__ __forceinline__ bool next(int i, pg8::Unit& u) const {
        if (!pg8::std_order(i, G, c, nrt, nN, u.pm, u.pn)) return false;
        int e = 0;
#pragma unroll
        for (int k = 1; k < 8; ++k) e += ((unsigned)(u.pm * 256) >= eo[k]) ? 1 : 0;
        u.aoff = (long)u.pm * aT; u.boff = (long)e * bE + (long)u.pn * bT; return true;
    }
};
struct SchedGates {
    int G, c;
    __device__ __forceinline__ bool next(int i, pg8::Unit& u) const {
        if (!pg8::std_order(i, G, c, 32, 16, u.pm, u.pn)) return false;
        u.aoff = ((long)u.pm * 256 * D + (u.pn >> 1) * 256) * 2; u.boff = (long)u.pn * 256 * 256 * 2; return true;
    }
};
__device__ __forceinline__ void phase_combine(const Frame& F) {
    const int gw = F.blk * 8 + F.wave, ngw = F.G * 8, lane = F.lane;
    const float* X3 = (const float*)(F.ws + O_X3); const float* YM = (const float*)(F.ws + O_YM);
    const unsigned* POS = (const unsigned*)(F.ws + O_POS); const float* TOKG = (const float*)(F.ws + O_TOKG); const float* fnw = F.in[I_FNW];
    for (int m = gw; m < T; m += ngw) {
        const unsigned p0 = POS[2 * m], p1 = POS[2 * m + 1]; const float g0 = TOKG[2 * m], g1 = TOKG[2 * m + 1];
        f32x4 v[8]; float s = 0.f;
#pragma unroll
        for (int j = 0; j < 8; ++j) { const f32x4 x = ((const f32x4*)(X3 + (size_t)m * D))[lane + 64 * j], y0 = ((const f32x4*)(YM + (size_t)p0 * D))[lane + 64 * j], y1 = ((const f32x4*)(YM + (size_t)p1 * D))[lane + 64 * j];
            v[j] = x + g0 * y0 + g1 * y1; s += (v[j].x * v[j].x + v[j].y * v[j].y) + (v[j].z * v[j].z + v[j].w * v[j].w); }
        const float rstd = rsqrtf(wave_sum(s) * (1.0f / D) + EPS);
#pragma unroll
        for (int j = 0; j < 8; ++j) { const f32x4 w = ((const f32x4*)fnw)[lane + 64 * j]; ((f32x4*)(F.out + (size_t)m * D))[lane + 64 * j] = v[j] * rstd * w; }
    }
}

constexpr int NPHASES = 20;
struct Args { const float* in[25]; float* out; unsigned char* ws; int ph_lo, ph_hi; };
__global__ void __launch_bounds__(512, 2) mk_fwd(Args args) {
    extern __shared__ __attribute__((aligned(16))) unsigned char lds_raw[];
    Frame F;
    F.lds = (LAS unsigned char*)lds_raw;
    F.tid = threadIdx.x; F.lane = F.tid & 63; F.wave = __builtin_amdgcn_readfirstlane(F.tid >> 6); F.G = gridDim.x; F.blk = blockIdx.x;
    F.ws = args.ws; F.out = args.out;
#pragma unroll
    for (int i = 0; i < 25; ++i) F.in[i] = args.in[i];
    volatile LAS unsigned* MISC = (volatile LAS unsigned*)(F.lds + MISC_OFF);
    if (F.tid < 64) MISC[F.tid] = 0u;
    __syncthreads();
    const int lo = args.ph_lo, hi = args.ph_hi;
    XcdBarrier bar; bar.bar = (unsigned*)(F.ws + O_CTL) + CW_BAR; bar.x = 0; bar.st = nullptr;
    if (hi - lo > 1) bar = xcd_barrier_post((unsigned*)(F.ws + O_CTL) + CW_BAR, MISC + 8);
#ifdef ONLY_PHASE
#define IN(k) ((k) == ONLY_PHASE && lo <= (k) && (k) < hi)
#else
#define IN(k) (lo <= (k) && (k) < hi)
#endif
#define SEAM(k) do { if (IN(k) && IN((k) + 1)) xcd_barrier(bar); } while (0)
    unsigned char* ws = F.ws;
    bf16* XN = (bf16*)(ws + O_XN);

    if (IN(0)) { phase_prologue(F); } SEAM(0);
    if (IN(1)) {
        pg8::Gemm g{XN, (const bf16*)(ws + O_WMI), D, D, D}; pg8::SchedStd S{T / 256, NPROJ / 256, F.G, F.blk, (long)256 * D * 2, (long)256 * D * 2};
        pg8::EpiBf16 E{(bf16*)(ws + O_PROJ), NPROJ};
        pg8::gemm_phase(F.lds, g, S, E);
    } SEAM(1);
    if (IN(2)) { phase_mix_pre(F); } SEAM(2);
    if (IN(3)) { phase_mix_scan_slow(F); } SEAM(3);
    if (IN(4)) {
        pg8::Gemm g{(const bf16*)(ws + O_O), (const bf16*)(ws + O_WMO), D, D, D}; pg8::SchedStd S{T / 256, D / 256, F.G, F.blk, (long)256 * D * 2, (long)256 * D * 2};
        pg8::EpiResF32 E{F.in[I_X], (float*)(ws + O_X1), D};
        pg8::gemm_phase(F.lds, g, S, E);
    } SEAM(4);
    if (IN(5)) { phase_rms(F, (const float*)(ws + O_X1), F.in[I_NORMW] + D); } SEAM(5);
    if (IN(6)) {
        pg8::Gemm g{XN, (const bf16*)(ws + O_WFG), D, D, D}; pg8::SchedStd S{T / 256, 2 * FF / 256, F.G, F.blk, (long)256 * D * 2, (long)256 * D * 2};
        pg8::EpiSwiglu E{(bf16*)(ws + O_ACT), FF};
        pg8::gemm_phase(F.lds, g, S, E);
    } SEAM(6);
    if (IN(7)) {
        pg8::Gemm g{(const bf16*)(ws + O_ACT), (const bf16*)(ws + O_WFD), FF, FF, FF}; pg8::SchedStd S{T / 256, D / 256, F.G, F.blk, (long)256 * FF * 2, (long)256 * FF * 2};
        pg8::EpiResF32 E{(const float*)(ws + O_X1), (float*)(ws + O_X2), D};
        pg8::gemm_phase(F.lds, g, S, E);
    } SEAM(7);
    if (IN(8)) { phase_rms(F, (const float*)(ws + O_X2), F.in[I_NORMW] + 2 * D); } SEAM(8);
    if (IN(9)) {
        pg8::Gemm g{XN, (const bf16*)(ws + O_WRI), D, D, D}; pg8::SchedStd S{T / 256, 2 * D / 256, F.G, F.blk, (long)256 * D * 2, (long)256 * D * 2};
        pg8::EpiRgIn E{(bf16*)(ws + O_Y), (bf16*)(ws + O_XBR)};
        pg8::gemm_phase(F.lds, g, S, E);
    } SEAM(9);
    if (IN(10)) { phase_lru_conv(F); } SEAM(10);
    if (IN(11)) {
        pg8::Gemm g{(const bf16*)(ws + O_XC), (const bf16*)(ws + O_WRG), D, 256, 256}; SchedGates S{F.G, F.blk};
        pg8::EpiGates E{(const bf16*)(ws + O_XC), F.in[I_RGAB], F.in[I_RGXB], (const float*)(ws + O_SPL), (float*)(ws + O_AA), (float*)(ws + O_BB)};
        pg8::gemm_phase(F.lds, g, S, E);
    } SEAM(11);
    if (IN(12)) { phase_lru_scan1(F); } SEAM(12);
    if (IN(13)) { phase_lru_scan2(F); } SEAM(13);
    if (IN(14)) {
        pg8::Gemm g{(const bf16*)(ws + O_YH), (const bf16*)(ws + O_WRO), D, D, D}; pg8::SchedStd S{T / 256, D / 256, F.G, F.blk, (long)256 * D * 2, (long)256 * D * 2};
        pg8::EpiResF32 E{(const float*)(ws + O_X2), (float*)(ws + O_X3), D};
        pg8::gemm_phase(F.lds, g, S, E);
    } SEAM(14);
    if (IN(15)) { phase_route1(F); } SEAM(15);
    if (IN(16)) { phase_route2(F); } SEAM(16);
    if (IN(17)) {
        SchedMoe S; S.nN = 2 * FE / 256; S.G = F.G; S.c = F.blk; S.aT = (long)256 * D * 2; S.bT = (long)256 * D * 2; S.bE = (long)2 * FE * D * 2;
        const unsigned* eo = (const unsigned*)(ws + O_EOFF);
#pragma unroll
        for (int k = 0; k < 9; ++k) S.eo[k] = __builtin_amdgcn_readfirstlane(eo[k]);
        S.nrt = (int)(S.eo[8] >> 8);
        pg8::Gemm g{(const bf16*)(ws + O_HS), (const bf16*)(ws + O_WMG), D, D, D};
        pg8::EpiSwiglu E{(bf16*)(ws + O_ACTM), FE};
        pg8::gemm_phase(F.lds, g, S, E);
    } SEAM(17);
    if (IN(18)) {
        SchedMoe S; S.nN = D / 256; S.G = F.G; S.c = F.blk; S.aT = (long)256 * FE * 2; S.bT = (long)256 * FE * 2; S.bE = (long)D * FE * 2;
        const unsigned* eo = (const unsigned*)(ws + O_EOFF);
#pragma unroll
        for (int k = 0; k < 9; ++k) S.eo[k] = __builtin_amdgcn_readfirstlane(eo[k]);
        S.nrt = (int)(S.eo[8] >> 8);
        pg8::Gemm g{(const bf16*)(ws + O_ACTM), (const bf16*)(ws + O_WMD), FE, FE, FE};
        pg8::EpiResF32 E{nullptr, (float*)(ws + O_YM), D};
        pg8::gemm_phase(F.lds, g, S, E);
    } SEAM(18);
    if (IN(19)) { phase_combine(F); }
#undef IN
#undef SEAM
}

extern "C" void kernel_launch(void* const* d_in, const int* in_sizes, int n_in, void* d_out, int out_size, void* d_ws, size_t ws_size, hipStream_t stream) {
    static int grid = 0;
    if (grid == 0) {
        if (n_in != 25 || out_size != T * D || ws_size < WS_END) { fprintf(stderr, "kernel_launch: unexpected shapes (n_in %d out %d ws %zu need %zu)\n", n_in, out_size, ws_size, (size_t)WS_END); grid = -1; return; }
        int dev = 0, cus = 0, per_cu = 0;
        if (hipGetDevice(&dev) != hipSuccess || hipDeviceGetAttribute(&cus, hipDeviceAttributeMultiprocessorCount, dev) != hipSuccess) { grid = -1; return; }
        if (hipFuncSetAttribute((const void*)mk_fwd, hipFuncAttributeMaxDynamicSharedMemorySize, LDS_BYTES) != hipSuccess) { fprintf(stderr, "kernel_launch: hipFuncSetAttribute failed\n"); grid = -1; return; }
        if (hipOccupancyMaxActiveBlocksPerMultiprocessor(&per_cu, (const void*)mk_fwd, 512, LDS_BYTES) != hipSuccess || per_cu < 1) fprintf(stderr, "kernel_launch: occupancy query reports %d\n", per_cu);
        (void)hipGetLastError();
        grid = cus > 256 ? 256 : cus;
    }
    if (grid < 0) return;
    (void)hipMemsetAsync((char*)d_ws + O_CTL, 0, CTL_BYTES, stream);
    Args a{};
    for (int i = 0; i < 25; ++i) a.in[i] = (const float*)d_in[i];
    a.out = (float*)d_out; a.ws = (unsigned char*)d_ws;
#if MK_SPLIT
    for (int p = 0; p < NPHASES; ++p) { a.ph_lo = p; a.ph_hi = p + 1; hipLaunchKernelGGL(mk_fwd, dim3(grid), dim3(512), LDS_BYTES, stream, a); }
#else
    a.ph_lo = 0; a.ph_hi = NPHASES; hipLaunchKernelGGL(mk_fwd, dim3(grid), dim3(512), LDS_BYTES, stream, a);
#endif
}
```

```cpp
#include <hip/hip_runtime.h>
#include <cstdio>
#include <cstdint>

#ifndef MK_SPLIT
#define MK_SPLIT 0
#endif

#define GAS __attribute__((address_space(1)))
#define LAS __attribute__((address_space(3)))
typedef unsigned short bf16;
typedef unsigned v4u __attribute__((ext_vector_type(4)));
typedef unsigned v2u __attribute__((ext_vector_type(2)));
typedef float f32x4 __attribute__((ext_vector_type(4)));
typedef float f32x2 __attribute__((ext_vector_type(2)));
typedef short bf16x8 __attribute__((ext_vector_type(8)));
#define RLX_AGENT __ATOMIC_RELAXED, __HIP_MEMORY_SCOPE_AGENT
#define LDS_WAIT() asm volatile("s_waitcnt lgkmcnt(0)" ::: "memory")
#define VM_WAIT() asm volatile("s_waitcnt vmcnt(0)" ::: "memory")

__device__ __forceinline__ unsigned f2bf(float f) { unsigned u = __builtin_bit_cast(unsigned, f); return (u + 0x7fffu + ((u >> 16) & 1u)) >> 16; }
__device__ __forceinline__ unsigned pk2(float lo, float hi) { return f2bf(lo) | (f2bf(hi) << 16); }
__device__ __forceinline__ float bf2f(unsigned short b) { return __builtin_bit_cast(float, ((unsigned)b) << 16); }
__device__ __forceinline__ float bflo(unsigned w) { return __builtin_bit_cast(float, w << 16); }
__device__ __forceinline__ float bfhi(unsigned w) { return __builtin_bit_cast(float, w & 0xffff0000u); }
__device__ __forceinline__ float sigmoidf_(float x) { return 1.0f / (1.0f + __expf(-x)); }
__device__ __forceinline__ float siluf_(float x) { return x / (1.0f + __expf(-x)); }
__device__ __forceinline__ float softplusf_(float x) { return x > 20.f ? x : log1pf(__expf(x)); }
__device__ __forceinline__ void lds_add(LAS unsigned* p, unsigned v) { (void)__hip_atomic_fetch_add(p, v, __ATOMIC_RELAXED, __HIP_MEMORY_SCOPE_WORKGROUP); }
__device__ __forceinline__ float wave_sum(float v) {
#pragma unroll
    for (int o = 1; o < 64; o <<= 1) v += __shfl_xor(v, o);
    return v;
}

constexpr int T = 8192, D = 2048, SEQ = 4096, NPROJ = 8192, FF = 5632, FE = 7168, NE = 8;
constexpr int MIXLD = 8208;
constexpr int PQ_AQ = 0, PQ_AK = 1024, PQ_AV = 2048, PQ_AZ = 3072, PQ_BQ = 4096, PQ_BF = 5120, PQ_BI = 6144, PQ_BG = 7168;
constexpr float EPS = 1e-6f;
constexpr int MOE_ROWS = 16384 + 8 * 256;

constexpr size_t al256(size_t x) { return (x + 255) & ~(size_t)255; }
constexpr size_t O_CTL = 0, CTL_BYTES = 1u << 20;
constexpr size_t O_WMI = CTL_BYTES;
constexpr size_t O_WMO = O_WMI + (size_t)NPROJ * D * 2;
constexpr size_t O_WFG = O_WMO + (size_t)D * D * 2;
constexpr size_t O_WFD = O_WFG + (size_t)2 * FF * D * 2;
constexpr size_t O_WRI = O_WFD + (size_t)D * FF * 2;
constexpr size_t O_WRG = O_WRI + (size_t)2 * D * D * 2;
constexpr size_t O_WRO = O_WRG + (size_t)16 * 256 * 256 * 2;
constexpr size_t O_WMG = O_WRO + (size_t)D * D * 2;
constexpr size_t O_WMD = O_WMG + (size_t)NE * 2 * FE * D * 2;
constexpr size_t O_XN = O_WMD + (size_t)NE * D * FE * 2;
constexpr size_t O_PROJ = O_XN + (size_t)T * D * 2;
constexpr size_t O_GB = O_PROJ + (size_t)T * NPROJ * 2;
constexpr size_t O_O = O_GB + (size_t)T * 16 * 4;
constexpr size_t O_X1 = O_O + (size_t)T * D * 2;
constexpr size_t O_X2 = O_X1 + (size_t)T * D * 4;
constexpr size_t O_X3 = O_X2 + (size_t)T * D * 4;
constexpr size_t O_ACT = O_X3 + (size_t)T * D * 4;
constexpr size_t O_Y = O_ACT + (size_t)T * FF * 2;
constexpr size_t O_XBR = O_Y + (size_t)T * D * 2;
constexpr size_t O_XC = O_XBR + (size_t)T * D * 2;
constexpr size_t O_AA = O_XC + (size_t)T * D * 2;
constexpr size_t O_BB = O_AA + (size_t)T * D * 4;
constexpr size_t O_YH = O_BB + (size_t)T * D * 4;
constexpr size_t O_SUMA = O_YH + (size_t)T * D * 2;
constexpr size_t O_SUMB = O_SUMA + (size_t)2 * 32 * D * 4;
constexpr size_t O_TOKE = O_SUMB + (size_t)2 * 32 * D * 4;
constexpr size_t O_TOKG = O_TOKE + (size_t)T * 4;
constexpr size_t O_POS = O_TOKG + (size_t)T * 8;
constexpr size_t O_WCNT = O_POS + (size_t)T * 8;
constexpr size_t O_EOFF = O_WCNT + 256 * 8 * 4;
constexpr size_t O_SPL = al256(O_EOFF + 64);
constexpr size_t O_HS = O_SPL + 2048 * 4;
constexpr size_t O_ACTM = O_HS + (size_t)MOE_ROWS * D * 2;
constexpr size_t O_YM = O_ACTM + (size_t)MOE_ROWS * FE * 2;
constexpr size_t O_QF = O_YM + (size_t)MOE_ROWS * D * 4;
constexpr size_t O_KF = O_QF + (size_t)T * 1024 * 4;
constexpr size_t O_VF = O_KF + (size_t)T * 1024 * 4;
constexpr size_t O_FH = O_VF + (size_t)T * 1024 * 4;
constexpr size_t O_QH = O_FH + (size_t)T * 1024 * 4;
constexpr size_t WS_END = O_QH + (size_t)T * 1024 * 4;

constexpr int CW_BAR = 4096;

constexpr int LDS_BYTES = 155648;
constexpr int MISC_OFF = 155648 - 256;

namespace pg8 {
constexpr int BM = 256, BK = 64, HALF = 128, HTB = HALF * BK * 2, STAGE_BYTES = 8 * HTB, NXCD = 8, WGM = 8;
__host__ __device__ __forceinline__ int lds_byte(int r, int c) { const int st = (r >> 4) * 2 + (c >> 5), rr = r & 15, cc = c & 31, ob = rr * 64 + cc * 2; return st * 1024 + (ob ^ (((ob >> 9) & 1) << 5)); }
__host__ __device__ __forceinline__ void stage_rc(int b, int& R, int& C) { const int st = b / 1024, sb = b % 1024, swz = sb ^ (((sb >> 9) & 1) << 5); R = (st >> 1) * 16 + swz / 64; C = (st & 1) * 32 + (swz % 64) / 2; }
__host__ __device__ __forceinline__ int perm32(int rho) { const int n = rho >> 4, i = rho & 15; return 8 * (i >> 2) + 4 * n + (i & 3); }

struct Unit { int pm, pn; long aoff, boff; };
struct Gemm { const bf16* A; const bf16* Bt; int lda, ldb, K; };

__device__ __forceinline__ bool std_order(int i, int G, int c, int nM, int nN, int& pm, int& pn) {
    const int nwg = nM * nN; const long L = (long)i * G + c; if (L >= nwg) return false;
    int wgid = (int)L; { const int q = nwg / NXCD, r = nwg % NXCD, xcd = wgid % NXCD, off = wgid / NXCD; wgid = (xcd < r ? xcd * (q + 1) : r * (q + 1) + (xcd - r) * q) + off; }
    const int nig = WGM * nN, gid = wgid / nig, fm = gid * WGM, gsz = (nM - fm) < WGM ? (nM - fm) : WGM;
    pm = fm + ((wgid % nig) % gsz); pn = (wgid % nig) / gsz; return true;
}
struct SchedStd {
    int nM, nN, G, c; long aT, bT;
    __device__ __forceinline__ bool next(int i, Unit& u) const { if (!std_order(i, G, c, nM, nN, u.pm, u.pn)) return false; u.aoff = (long)u.pm * aT; u.boff = (long)u.pn * bT; return true; }
};

template <class Epi, class Sched>
__device__ __forceinline__ void gemm_phase(LAS unsigned char* lds, const Gemm g, const Sched& S, const Epi& E) {
    const int tid = threadIdx.x, wid = __builtin_amdgcn_readfirstlane(tid >> 6), lane = tid & 63, wr = wid >> 2, wc = wid & 3, fr = lane & 15, fq = lane >> 4;
    const int K = g.K, nt = K / BK;
    unsigned voffA[2], voffB[2];
#pragma unroll
    for (int i = 0; i < 2; ++i) { int R, C; stage_rc(tid * 16 + i * 8192, R, C); const int Rb = Epi::PERM ? ((R & ~31) + perm32(R & 31)) : R;
        voffA[i] = (unsigned)(R * g.lda + C) * 2u; voffB[i] = (unsigned)(Rb * g.ldb + C) * 2u; }
    const size_t kstep = (size_t)(BK * 2);
    const size_t hstepA = (size_t)HALF * g.lda * 2, hstepB = (size_t)HALF * g.ldb * 2;
    const unsigned ldsw = (unsigned)wid * 1024u;
    const int aoff = lds_byte(wr * 64 + fr, fq * 8), boff = lds_byte(wc * 32 + fr, fq * 8);
#define PG8_SA(b, h) (((b) * 2 + (h)) * HTB)
#define PG8_SB(b, h) ((4 + (b) * 2 + (h)) * HTB)
#define PG8_STAGE(bufoff, gbase, voff) do { _Pragma("unroll") for (int _i = 0; _i < 2; ++_i) \
        __builtin_amdgcn_global_load_lds((const unsigned*)((const char*)(gbase) + (voff)[_i]), (LAS unsigned*)(lds + (bufoff) + ldsw + _i * 8192), 16, 0, 0); } while (0)
#define PG8_LDA(dst, b, h) do { _Pragma("unroll") for (int m = 0; m < 4; ++m) _Pragma("unroll") for (int k = 0; k < 2; ++k) dst[m][k] = *(const LAS bf16x8*)(lds + PG8_SA(b, h) + aoff + m * 2048 + k * 1024); } while (0)
#define PG8_LDB(dst, b, h) do { _Pragma("unroll") for (int n = 0; n < 2; ++n) _Pragma("unroll") for (int k = 0; k < 2; ++k) dst[n][k] = *(const LAS bf16x8*)(lds + PG8_SB(b, h) + boff + n * 2048 + k * 1024); } while (0)
#define PG8_MMA(ai, bj, At, Bt) do { __builtin_amdgcn_s_setprio(1); _Pragma("unroll") for (int m = 0; m < 4; ++m) _Pragma("unroll") for (int n = 0; n < 2; ++n) _Pragma("unroll") for (int k = 0; k < 2; ++k) \
        acc[ai][bj][m][n] = __builtin_amdgcn_mfma_f32_16x16x32_bf16(Bt[n][k], At[m][k], acc[ai][bj][m][n], 0, 0, 0); __builtin_amdgcn_s_setprio(0); } while (0)
#define PG8_WAIT_V(n) asm volatile("s_waitcnt vmcnt(" #n ")" ::: "memory")
#define PG8_WAIT_L(n) asm volatile("s_waitcnt lgkmcnt(" #n ")" ::: "memory")
#define PG8_BAR __builtin_amdgcn_s_barrier()
#define PG8_SCHED __builtin_amdgcn_sched_barrier(0)
    Unit cur, nxt; int ui = 0;
    if (!S.next(0, cur)) return;
    f32x4 acc[2][2][4][2];
#pragma unroll
    for (int a = 0; a < 2; ++a)
#pragma unroll
        for (int b = 0; b < 2; ++b)
#pragma unroll
            for (int m = 0; m < 4; ++m)
#pragma unroll
                for (int n = 0; n < 2; ++n) acc[a][b][m][n] = (f32x4){0.f, 0.f, 0.f, 0.f};
    bf16x8 At[4][2], B0[2][2], B1[2][2];
    const char* cA = (const char*)g.A + cur.aoff; const char* cB = (const char*)g.Bt + cur.boff;
    PG8_STAGE(PG8_SB(0, 0), cB, voffB); PG8_STAGE(PG8_SB(0, 1), cB + hstepB, voffB); PG8_STAGE(PG8_SA(0, 0), cA, voffA); PG8_STAGE(PG8_SA(0, 1), cA + hstepA, voffA);
    if (wr == 1) PG8_BAR;
    PG8_WAIT_V(2); PG8_BAR;
    PG8_STAGE(PG8_SB(1, 0), cB + kstep, voffB); PG8_STAGE(PG8_SA(1, 0), cA + kstep, voffA); PG8_STAGE(PG8_SB(1, 1), cB + hstepB + kstep, voffB);
    PG8_WAIT_V(6); PG8_BAR;
    for (;;) {
        const bool has_next = S.next(ui + 1, nxt);
        const char* nA = has_next ? (const char*)g.A + nxt.aoff : cA; const char* nB = has_next ? (const char*)g.Bt + nxt.boff : cB;
#pragma unroll 1
        for (int t = 0; t < nt; t += 2) {
            const bool last = (t == nt - 2);
            const char* a1 = cA + (size_t)(t + 1) * kstep;
            const char* a2 = last ? nA : cA + (size_t)(t + 2) * kstep; const char* b2 = last ? nB : cB + (size_t)(t + 2) * kstep;
            const char* a3 = a2 + kstep; const char* b3 = b2 + kstep;
            PG8_LDB(B0, 0, 0); PG8_LDB(B1, 0, 1); PG8_SCHED; PG8_LDA(At, 0, 0); PG8_STAGE(PG8_SA(1, 1), a1 + hstepA, voffA);
            PG8_WAIT_V(8); PG8_WAIT_L(0); PG8_BAR; PG8_MMA(0, 0, At, B0); PG8_MMA(0, 1, At, B1); PG8_BAR; PG8_SCHED;
            PG8_LDA(At, 0, 1); PG8_STAGE(PG8_SB(0, 0), b2, voffB); PG8_STAGE(PG8_SB(0, 1), b2 + hstepB, voffB); PG8_STAGE(PG8_SA(0, 0), a2, voffA);
            PG8_WAIT_V(8); PG8_WAIT_L(0); PG8_BAR; PG8_MMA(1, 0, At, B0); PG8_MMA(1, 1, At, B1); PG8_BAR; PG8_SCHED;
            PG8_LDB(B0, 1, 0); PG8_LDB(B1, 1, 1); PG8_SCHED; PG8_LDA(At, 1, 0); PG8_STAGE(PG8_SA(0, 1), a2 + hstepA, voffA);
            PG8_WAIT_V(8); PG8_WAIT_L(0); PG8_BAR; PG8_MMA(0, 0, At, B0); PG8_MMA(0, 1, At, B1); PG8_BAR; PG8_SCHED;
            PG8_LDA(At, 1, 1); PG8_STAGE(PG8_SB(1, 0), b3, voffB); PG8_STAGE(PG8_SB(1, 1), b3 + hstepB, voffB); PG8_STAGE(PG8_SA(1, 0), a3, voffA);
            PG8_WAIT_V(8); PG8_WAIT_L(0); PG8_BAR; PG8_MMA(1, 0, At, B0); PG8_MMA(1, 1, At, B1); PG8_BAR; PG8_SCHED;
        }
        if (wr == 0) PG8_BAR;
        E(acc, cur, wr, wc, fr, fq);
        if (!has_next) break;
#pragma unroll
        for (int a = 0; a < 2; ++a)
#pragma unroll
            for (int b = 0; b < 2; ++b)
#pragma unroll
                for (int m = 0; m < 4; ++m)
#pragma unroll
                    for (int n = 0; n < 2; ++n) acc[a][b][m][n] = (f32x4){0.f, 0.f, 0.f, 0.f};
        cur = nxt; cA = nA; cB = nB; ++ui;
        if (wr == 1) PG8_BAR;
    }
    PG8_WAIT_V(0);
    PG8_BAR;
#undef PG8_SA
#undef PG8_SB
#undef PG8_STAGE
#undef PG8_LDA
#undef PG8_LDB
#undef PG8_MMA
#undef PG8_WAIT_V
#undef PG8_WAIT_L
#undef PG8_BAR
#undef PG8_SCHED
}

struct EpiBf16 {
    static constexpr bool PERM = true;
    bf16* O; int ldc;
    __device__ __forceinline__ void operator()(const f32x4 (&acc)[2][2][4][2], const Unit& u, int wr, int wc, int fr, int fq) const {
        const int row0 = u.pm * BM + wr * 64 + fr, col0 = u.pn * BM + wc * 32 + 8 * fq;
#pragma unroll
        for (int ai = 0; ai < 2; ++ai)
#pragma unroll
            for (int m = 0; m < 4; ++m) { bf16* rowp = O + (size_t)(row0 + ai * HALF + m * 16) * ldc + col0;
#pragma unroll
                for (int bj = 0; bj < 2; ++bj) { const f32x4 v0 = acc[ai][bj][m][0], v1 = acc[ai][bj][m][1];
                    v4u w; w.x = pk2(v0[0], v0[1]); w.y = pk2(v0[2], v0[3]); w.z = pk2(v1[0], v1[1]); w.w = pk2(v1[2], v1[3]);
                    *(v4u*)(rowp + bj * HALF) = w; } }
    }
};
struct EpiSwiglu {
    static constexpr bool PERM = true;
    bf16* O; int ldc;
    __device__ __forceinline__ void operator()(const f32x4 (&acc)[2][2][4][2], const Unit& u, int wr, int wc, int fr, int fq) const {
        const int row0 = u.pm * BM + wr * 64 + fr, col0 = u.pn * HALF + wc * 32 + 8 * fq;
#pragma unroll
        for (int ai = 0; ai < 2; ++ai)
#pragma unroll
            for (int m = 0; m < 4; ++m) { bf16* rowp = O + (size_t)(row0 + ai * HALF + m * 16) * ldc + col0;
                float o[8];
#pragma unroll
                for (int n = 0; n < 2; ++n)
#pragma unroll
                    for (int j = 0; j < 4; ++j) { const float gt = acc[ai][0][m][n][j], up = acc[ai][1][m][n][j]; o[n * 4 + j] = gt * __builtin_amdgcn_rcpf(1.0f + __expf(-gt)) * up; }
                v4u w; w.x = pk2(o[0], o[1]); w.y = pk2(o[2], o[3]); w.z = pk2(o[4], o[5]); w.w = pk2(o[6], o[7]);
                *(v4u*)rowp = w; }
    }
};
struct EpiResF32 {
    static constexpr bool PERM = false;
    const float* base; float* out; int ldc;
    __device__ __forceinline__ void operator()(const f32x4 (&acc)[2][2][4][2], const Unit& u, int wr, int wc, int fr, int fq) const {
        const int row0 = u.pm * BM + wr * 64 + fr, col0 = u.pn * BM + wc * 32 + 4 * fq;
#pragma unroll
        for (int ai = 0; ai < 2; ++ai)
#pragma unroll
            for (int m = 0; m < 4; ++m) { const size_t off = (size_t)(row0 + ai * HALF + m * 16) * ldc + col0;
#pragma unroll
                for (int bj = 0; bj < 2; ++bj)
#pragma unroll
                    for (int n = 0; n < 2; ++n) { f32x4 v = acc[ai][bj][m][n]; if (base) v += *(const f32x4*)(base + off + bj * HALF + n * 16); *(f32x4*)(out + off + bj * HALF + n * 16) = v; } }
    }
};
struct EpiRgIn {
    static constexpr bool PERM = true;
    bf16* Y; bf16* XBR;
    __device__ __forceinline__ void operator()(const f32x4 (&acc)[2][2][4][2], const Unit& u, int wr, int wc, int fr, int fq) const {
        const bool isy = u.pn < 8; bf16* O = isy ? Y : XBR;
        const int row0 = u.pm * BM + wr * 64 + fr, col0 = (u.pn & 7) * BM + wc * 32 + 8 * fq;
#pragma unroll
        for (int ai = 0; ai < 2; ++ai)
#pragma unroll
            for (int m = 0; m < 4; ++m) { bf16* rowp = O + (size_t)(row0 + ai * HALF + m * 16) * D + col0;
#pragma unroll
                for (int bj = 0; bj < 2; ++bj) { float o[8];
#pragma unroll
                    for (int n = 0; n < 2; ++n)
#pragma unroll
                        for (int j = 0; j < 4; ++j) { float x = acc[ai][bj][m][n][j];
                            if (isy) { const float y2 = 1.5957691216f * (x + 0.044715f * x * x * x); x = x * __builtin_amdgcn_rcpf(1.0f + __expf(-y2)); }
                            o[n * 4 + j] = x; }
                    v4u w; w.x = pk2(o[0], o[1]); w.y = pk2(o[2], o[3]); w.z = pk2(o[4], o[5]); w.w = pk2(o[6], o[7]);
                    *(v4u*)(rowp + bj * HALF) = w; } }
    }
};
struct EpiGates {
    static constexpr bool PERM = false;
    const bf16* XC; const float* ba; const float* bx; const float* lam; float* AA; float* BB;
    __device__ __forceinline__ void operator()(const f32x4 (&acc)[2][2][4][2], const Unit& u, int wr, int wc, int fr, int fq) const {
        const int row0 = u.pm * BM + wr * 64 + fr, col0 = u.pn * HALF + wc * 32 + 4 * fq;
#pragma unroll
        for (int n = 0; n < 2; ++n) { const int col = col0 + n * 16;
            const f32x4 vba = *(const f32x4*)(ba + col), vbx = *(const f32x4*)(bx + col), sp = *(const f32x4*)(lam + col);
#pragma unroll
            for (int ai = 0; ai < 2; ++ai)
#pragma unroll
                for (int m = 0; m < 4; ++m) { const size_t off = (size_t)(row0 + ai * HALF + m * 16) * D + col;
                    const v2u xw = *(const v2u*)(XC + off); const float xc[4] = {bflo(xw.x), bfhi(xw.x), bflo(xw.y), bfhi(xw.y)};
                    f32x4 oa, ob;
#pragma unroll
                    for (int j = 0; j < 4; ++j) { const float r = sigmoidf_(acc[ai][0][m][n][j] + vba[j]), gi = sigmoidf_(acc[ai][1][m][n][j] + vbx[j]);
                        const float la = sp[j] * r, t2 = 2.0f * la; oa[j] = __expf(la);
                        const float em = (t2 > -0.01f) ? -t2 * (1.0f + 0.5f * t2 * (1.0f + 0.33333334f * t2)) : 1.0f - __expf(t2);
                        ob[j] = sqrtf(fmaxf(em, 0.f)) * (gi * xc[j]); }
                    *(f32x4*)(AA + off) = oa; *(f32x4*)(BB + off) = ob; asm volatile("" ::: "memory"); } }
    }
};
}

#define XB_TMO      128
#define XB_XCNT(j)  (256  + 64 * (j))
#define XB_XSUB(j)  (1280 + 64 * (j))
#define XB_XGEN(j)  (2304 + 64 * (j))
#define XB_TOP      3328
#define XB_TOPGEN   3392
#define XCD_BAR_WORDS 3456
#define XB_SPIN_CAP (1u << 22)
__device__ __forceinline__ unsigned xb_ld(unsigned* p)              { return __hip_atomic_load(p, __ATOMIC_RELAXED, __HIP_MEMORY_SCOPE_AGENT); }
__device__ __forceinline__ unsigned xb_add(unsigned* p, unsigned v) { return __hip_atomic_fetch_add(p, v, __ATOMIC_RELAXED, __HIP_MEMORY_SCOPE_AGENT); }
__device__ __forceinline__ unsigned xb_xcc_id() { return (unsigned)__builtin_amdgcn_s_getreg((3 << 11) | 20) & 0xFu; }
#define XB_SPIN(cond, bar) do { unsigned _sp = 0; while (cond) { __builtin_amdgcn_s_sleep(1); \
    if ((++_sp & 255u) == 0u) { if (xb_ld(&(bar)[XB_TMO])) break; if (_sp > XB_SPIN_CAP) { atomicAdd(&(bar)[XB_TMO], 1u); break; } } } } while (0)
struct XcdBarrier { unsigned* bar; unsigned x; volatile LAS unsigned* st; };
__device__ __forceinline__ XcdBarrier xcd_barrier_post(unsigned* bar, volatile LAS unsigned* st) {
    XcdBarrier b; b.bar = bar; b.x = xb_xcc_id(); b.st = st;
    if (threadIdx.x == 0) (void)xb_add(&bar[XB_XCNT(b.x)], 1u);
    return b;
}
__device__ __forceinline__ void xcd_barrier_complete(unsigned* bar, unsigned x, unsigned& nloc, unsigned& nx) {
    const unsigned G = gridDim.x * gridDim.y * gridDim.z;
    unsigned sum, cnt, mine, sp = 0u;
    for (;;) {
        sum = 0u; cnt = 0u; mine = 0u;
#pragma unroll
        for (unsigned j = 0; j < 16; ++j) { const unsigned c = xb_ld(&bar[XB_XCNT(j)]); sum += c; cnt += (c > 0u) ? 1u : 0u; mine = (j == x) ? c : mine; }
        if (sum == G) break;
        __builtin_amdgcn_s_sleep(1);
        if ((++sp & 255u) == 0u) { if (xb_ld(&bar[XB_TMO])) break; if (sp > XB_SPIN_CAP) { atomicAdd(&bar[XB_TMO], 1u); break; } }
    }
    nloc = mine > 0u ? mine : 1u; nx = cnt > 0u ? cnt : 1u;
}
__device__ __forceinline__ void xcd_barrier(const XcdBarrier& b) {
    asm volatile("s_waitcnt vmcnt(0)" ::: "memory");
    __syncthreads();
    if (threadIdx.x == 0) {
        unsigned* bar = b.bar;
        __builtin_amdgcn_s_waitcnt(0);
        unsigned nloc = b.st[0], nx = b.st[1];
        if (nloc == 0u) { xcd_barrier_complete(bar, b.x, nloc, nx); b.st[0] = nloc; b.st[1] = nx; }
        const unsigned old = xb_add(&bar[XB_XSUB(b.x)], 1u);
        const unsigned gen = old / nloc;
        if (old + 1u == (gen + 1u) * nloc) {
            __builtin_amdgcn_fence(__ATOMIC_RELEASE, "agent");
            asm volatile("s_waitcnt vmcnt(0)" ::: "memory");
            const unsigned og = xb_add(&bar[XB_TOP], 1u);
            const unsigned tg = og / nx;
            if (og + 1u == (tg + 1u) * nx) xb_add(&bar[XB_TOPGEN], 1u);
            else XB_SPIN(xb_ld(&bar[XB_TOPGEN]) == tg, bar);
            __builtin_amdgcn_fence(__ATOMIC_ACQUIRE, "agent");
            xb_add(&bar[XB_XGEN(b.x)], 1u);
            asm volatile("s_waitcnt vmcnt(0)" ::: "memory");
        } else {
            XB_SPIN(xb_ld(&bar[XB_XGEN(b.x)]) == gen, bar);
            __builtin_amdgcn_fence(__ATOMIC_ACQUIRE, "agent");
            asm volatile("s_waitcnt vmcnt(0)" ::: "memory");
        }
    }
    __syncthreads();
}

struct Frame {
    LAS unsigned char* lds;
    int tid, lane, wave, G, blk;
    unsigned char* ws;
    const float* in[25];
    float* out;
};
enum { I_X = 0, I_NORMW, I_FNW, I_MIXIN, I_GCONV, I_ALOG, I_DTB, I_GNW, I_LBL, I_HNW, I_MIXOUT, I_FGU, I_FD, I_RGIN, I_RGCW, I_RGCB, I_RGAW, I_RGAB, I_RGXW, I_RGXB, I_LAM, I_RGOUT, I_ROUTER, I_MGU, I_MD };

struct Job { const float* src; bf16* dst; int ld, K, n0, ncols, drow0, mode, nbatch; long sbs; int dbs; };
__device__ __forceinline__ void conv_item(const Job& jb, LAS float* scr, int item, int lane) {
    const int nblk = jb.ncols / 32, per = (jb.K / 64) * nblk, b = item / per, r = item % per, kb = r / nblk, nb = r % nblk, k0 = 64 * kb, n0l = 32 * nb;
    const float* sp = jb.src + (size_t)b * jb.sbs + (size_t)k0 * jb.ld + jb.n0 + n0l;
#pragma unroll 8
    for (int i = 0; i < 32; ++i) { const int kk = 2 * i + (lane >> 5); scr[kk * 33 + (lane & 31)] = sp[(size_t)kk * jb.ld + (lane & 31)]; }
    LDS_WAIT(); asm volatile("" ::: "memory");
    const int c = lane & 7;
#pragma unroll
    for (int j = 0; j < 4; ++j) { const int n = (lane >> 3) + 8 * j, nl = n0l + n; const LAS float* s = scr + (8 * c) * 33 + n;
        const int drow = jb.drow0 + b * jb.dbs + (jb.mode ? ((nl >> 7) * 256 + (nl & 127)) : nl);
        v4u o; o.x = pk2(s[0 * 33], s[1 * 33]); o.y = pk2(s[2 * 33], s[3 * 33]); o.z = pk2(s[4 * 33], s[5 * 33]); o.w = pk2(s[6 * 33], s[7 * 33]);
        *(v4u*)(jb.dst + (size_t)drow * jb.K + k0 + 8 * c) = o; }
    LDS_WAIT(); asm volatile("" ::: "memory");
}
constexpr int NJOBS = 13;
__device__ __forceinline__ Job get_job(const Frame& F, int j) {
    Job b; b.n0 = 0; b.drow0 = 0; b.mode = 0; b.nbatch = 1; b.sbs = 0; b.dbs = 0;
    unsigned char* ws = F.ws;
    switch (j) {
    case 0:  b.src = F.in[I_MIXIN]; b.dst = (bf16*)(ws + O_WMI); b.ld = MIXLD; b.K = D; b.ncols = 4096; break;
    case 1:  b.src = F.in[I_MIXIN]; b.dst = (bf16*)(ws + O_WMI); b.ld = MIXLD; b.K = D; b.n0 = 4112; b.ncols = 4096; b.drow0 = 4096; break;
    case 2:  b.src = F.in[I_MIXOUT]; b.dst = (bf16*)(ws + O_WMO); b.ld = D; b.K = D; b.ncols = D; break;
    case 3:  b.src = F.in[I_FGU]; b.dst = (bf16*)(ws + O_WFG); b.ld = 2 * FF; b.K = D; b.ncols = FF; b.mode = 1; break;
    case 4:  b.src = F.in[I_FGU]; b.dst = (bf16*)(ws + O_WFG); b.ld = 2 * FF; b.K = D; b.n0 = FF; b.ncols = FF; b.drow0 = 128; b.mode = 1; break;
    case 5:  b.src = F.in[I_FD]; b.dst = (bf16*)(ws + O_WFD); b.ld = D; b.K = FF; b.ncols = D; break;
    case 6:  b.src = F.in[I_RGIN]; b.dst = (bf16*)(ws + O_WRI); b.ld = 2 * D; b.K = D; b.ncols = 2 * D; break;
    case 7:  b.src = F.in[I_RGAW]; b.dst = (bf16*)(ws + O_WRG); b.ld = 256; b.K = 256; b.ncols = 256; b.mode = 1; b.nbatch = 8; b.sbs = 65536; b.dbs = 512; break;
    case 8:  b.src = F.in[I_RGXW]; b.dst = (bf16*)(ws + O_WRG); b.ld = 256; b.K = 256; b.ncols = 256; b.drow0 = 128; b.mode = 1; b.nbatch = 8; b.sbs = 65536; b.dbs = 512; break;
    case 9:  b.src = F.in[I_RGOUT]; b.dst = (bf16*)(ws + O_WRO); b.ld = D; b.K = D; b.ncols = D; break;
    case 10: b.src = F.in[I_MGU]; b.dst = (bf16*)(ws + O_WMG); b.ld = 2 * FE; b.K = D; b.ncols = FE; b.mode = 1; b.nbatch = 8; b.sbs = (long)D * 2 * FE; b.dbs = 2 * FE; break;
    case 11: b.src = F.in[I_MGU]; b.dst = (bf16*)(ws + O_WMG); b.ld = 2 * FE; b.K = D; b.n0 = FE; b.ncols = FE; b.drow0 = 128; b.mode = 1; b.nbatch = 8; b.sbs = (long)D * 2 * FE; b.dbs = 2 * FE; break;
    default: b.src = F.in[I_MD]; b.dst = (bf16*)(ws + O_WMD); b.ld = D; b.K = FE; b.ncols = D; b.nbatch = 8; b.sbs = (long)FE * D; b.dbs = D; break;
    }
    return b;
}
__device__ __forceinline__ void convert_jobs(const Frame& F, int j0, int j1, int gw, int ngw) {
    LAS float* scr = (LAS float*)(F.lds + F.wave * 16384);
    for (int j = j0; j < j1; ++j) { const Job jb = get_job(F, j); const int nitems = jb.nbatch * (jb.K / 64) * (jb.ncols / 32);
        for (int it = gw; it < nitems; it += ngw) conv_item(jb, scr, it, F.lane); }
}

__device__ __forceinline__ void rms_load(const float* xrow, const float* nw, int lane, f32x4 (&v)[8]) {
    float s = 0.f;
#pragma unroll
    for (int j = 0; j < 8; ++j) { v[j] = ((const f32x4*)xrow)[lane + 64 * j]; s += (v[j].x * v[j].x + v[j].y * v[j].y) + (v[j].z * v[j].z + v[j].w * v[j].w); }
    const float rstd = rsqrtf(wave_sum(s) * (1.0f / D) + EPS);
#pragma unroll
    for (int j = 0; j < 8; ++j) { const f32x4 w = ((const f32x4*)nw)[lane + 64 * j]; v[j] = v[j] * rstd * w; }
}
__device__ __forceinline__ void row_store_bf16(bf16* orow, int lane, const f32x4 (&v)[8]) {
#pragma unroll
    for (int j = 0; j < 8; ++j) { v2u w; w.x = pk2(v[j].x, v[j].y); w.y = pk2(v[j].z, v[j].w); ((v2u*)orow)[lane + 64 * j] = w; }
}

__device__ __forceinline__ void phase_prologue(const Frame& F) {
    const int gw = F.blk * 8 + F.wave, ngw = F.G * 8;
    convert_jobs(F, 0, NJOBS, gw, ngw);
    if (F.blk == 0) for (int i = F.tid; i < D; i += 512) ((float*)(F.ws + O_SPL))[i] = -8.0f * log1pf(__expf(-F.in[I_LAM][i]));
    __syncthreads();
    LAS float* w16 = (LAS float*)F.lds;
    const float* W = F.in[I_MIXIN];
    for (int idx = F.tid; idx < D * 16; idx += 512) { const int c = idx & 15, i = idx >> 4; w16[c * 2052 + i] = W[(size_t)i * MIXLD + 4096 + c]; }
    __syncthreads();
    const float* nw = F.in[I_NORMW];
    bf16* XN = (bf16*)(F.ws + O_XN); float* GB = (float*)(F.ws + O_GB);
    for (int m = gw; m < T; m += ngw) {
        f32x4 v[8]; rms_load(F.in[I_X] + (size_t)m * D, nw, F.lane, v);
        row_store_bf16(XN + (size_t)m * D, F.lane, v);
        float mine = 0.f;
#pragma unroll 1
        for (int c = 0; c < 16; ++c) { float a = 0.f;
#pragma unroll
            for (int j = 0; j < 8; ++j) { const f32x4 w = *(const LAS f32x4*)(w16 + c * 2052 + 4 * F.lane + 256 * j); a += (v[j].x * w.x + v[j].y * w.y) + (v[j].z * w.z + v[j].w * w.w); }
            a = wave_sum(a); if (F.lane == c) mine = a; }
        if (F.lane < 8) GB[(size_t)m * 16 + F.lane] = sigmoidf_(mine);
        else if (F.lane < 16) { const int h = F.lane - 8; GB[(size_t)m * 16 + F.lane] = -__expf(F.in[I_ALOG][h]) * softplusf_(mine + F.in[I_DTB][h]); }
    }
    __syncthreads();
}

__device__ __forceinline__ void phase_rms(const Frame& F, const float* X, const float* nw) {
    const int gw = F.blk * 8 + F.wave, ngw = F.G * 8; bf16* XN = (bf16*)(F.ws + O_XN);
    for (int m = gw; m < T; m += ngw) { f32x4 v[8]; rms_load(X + (size_t)m * D, nw, F.lane, v); row_store_bf16(XN + (size_t)m * D, F.lane, v); }
}

__device__ __forceinline__ void phase_mix_pre(const Frame& F) {
    const int gw = F.blk * 8 + F.wave, ngw = F.G * 8, lane = F.lane;
    const bf16* P = (const bf16*)(F.ws + O_PROJ);
    float* QF = (float*)(F.ws + O_QF); float* KF = (float*)(F.ws + O_KF); float* VF = (float*)(F.ws + O_VF); float* FH = (float*)(F.ws + O_FH); float* QH = (float*)(F.ws + O_QH);
    const float* cw = F.in[I_GCONV];
    const float* lbl = F.in[I_LBL];
    for (int it = gw; it < T * 8; it += ngw) {
        const int t = it >> 3, h = it & 7, s = t & (SEQ - 1), d = h * 128 + 2 * lane;
        float r[3][2];
#pragma unroll
        for (int mat = 0; mat < 3; ++mat) { float a0 = 0.f, a1 = 0.f;
#pragma unroll
            for (int j = 0; j < 4; ++j) { if (s - 3 + j >= 0) { const unsigned w = *(const unsigned*)(P + (size_t)(t - 3 + j) * NPROJ + mat * 1024 + d);
                    const f32x2 c = *(const f32x2*)(cw + j * 3072 + mat * 1024 + d); a0 += c.x * bflo(w); a1 += c.y * bfhi(w); } }
            r[mat][0] = siluf_(a0); r[mat][1] = siluf_(a1); }
        const float qs = wave_sum(r[0][0] * r[0][0] + r[0][1] * r[0][1]), ks = wave_sum(r[1][0] * r[1][0] + r[1][1] * r[1][1]);
        const float qn = rsqrtf(qs + EPS) * 0.08838834764831845f, kn = rsqrtf(ks + EPS);
        const size_t o = (size_t)t * 1024 + d;
        *(f32x2*)(QF + o) = (f32x2){r[0][0] * qn, r[0][1] * qn}; *(f32x2*)(KF + o) = (f32x2){r[1][0] * kn, r[1][1] * kn}; *(f32x2*)(VF + o) = (f32x2){r[2][0], r[2][1]};
        const unsigned wq = *(const unsigned*)(P + (size_t)t * NPROJ + PQ_BQ + d), wf = *(const unsigned*)(P + (size_t)t * NPROJ + PQ_BF + d);
        const f32x2 l0 = *(const f32x2*)(lbl + d), l1 = *(const f32x2*)(lbl + 1024 + d);
        const float lb0 = sigmoidf_(l0.x - l1.x), lb1 = sigmoidf_(l0.y - l1.y);
        *(f32x2*)(FH + o) = (f32x2){lb0 + (1.f - lb0) * sigmoidf_(bflo(wf)), lb1 + (1.f - lb1) * sigmoidf_(bfhi(wf))};
        *(f32x2*)(QH + o) = (f32x2){siluf_(bflo(wq)) * 0.08838834764831845f, siluf_(bfhi(wq)) * 0.08838834764831845f};
    }
}

__device__ __forceinline__ void phase_mix_scan_slow(const Frame& F) {
    if (F.blk >= 32) return;
    const int mixer = F.blk >> 4, b = (F.blk >> 3) & 1, h = F.blk & 7, tid = F.tid;
    LAS float* ks = (LAS float*)F.lds;
    LAS float* qs = ks + 8192; LAS float* vs = qs + 8192; LAS float* ot = vs + 8192;
    LAS float* red1 = ot + 8192; LAS float* red2 = red1 + 512; LAS float* ab = red2 + 512;
    const float* KSRC = (const float*)(F.ws + (mixer ? O_FH : O_KF)); const float* QSRC = (const float*)(F.ws + (mixer ? O_QH : O_QF)); const float* VSRC = (const float*)(F.ws + O_VF);
    const bf16* P = (const bf16*)(F.ws + O_PROJ); const float* GB = (const float*)(F.ws + O_GB);
    bf16* O = (bf16*)(F.ws + O_O);
    const float* nw = mixer ? F.in[I_HNW] : F.in[I_GNW];
    const int e = tid & 127, qd = tid >> 7;
    float S[32];
#pragma unroll
    for (int i = 0; i < 32; ++i) S[i] = 0.f;
    for (int n = 0; n < 64; ++n) {
        const int t0 = b * SEQ + n * 64;
        for (int idx = tid; idx < 64 * 32; idx += 512) { const int r = idx >> 5, c4 = (idx & 31) * 4; const size_t go = (size_t)(t0 + r) * 1024 + h * 128 + c4;
            *(LAS f32x4*)(ks + r * 128 + c4) = *(const f32x4*)(KSRC + go); *(LAS f32x4*)(qs + r * 128 + c4) = *(const f32x4*)(QSRC + go);
            f32x4 vv; if (mixer) { const v2u w = *(const v2u*)(P + (size_t)(t0 + r) * NPROJ + PQ_BI + h * 128 + c4); vv = (f32x4){bflo(w.x), bfhi(w.x), bflo(w.y), bfhi(w.y)}; } else vv = *(const f32x4*)(VSRC + go);
            *(LAS f32x4*)(vs + r * 128 + c4) = vv; }
        if (tid < 64) { ab[tid * 2] = __expf(GB[(size_t)(t0 + tid) * 16 + 8 + h]); ab[tid * 2 + 1] = GB[(size_t)(t0 + tid) * 16 + h]; }
        __syncthreads();
        for (int r = 0; r < 64; ++r) {
            const LAS float* kr = ks + r * 128 + qd * 32; const LAS float* qr = qs + r * 128 + qd * 32; const float ve = vs[r * 128 + e];
            float osum = 0.f;
            if (mixer == 0) {
                const float a = ab[r * 2], bt = ab[r * 2 + 1];
                float p = 0.f;
#pragma unroll
                for (int i = 0; i < 32; ++i) p += kr[i] * S[i];
                red1[qd * 128 + e] = p;
                __syncthreads();
                const float kS = (red1[e] + red1[128 + e]) + (red1[256 + e] + red1[384 + e]);
                const float c1 = bt * (ve - a * kS);
#pragma unroll
                for (int i = 0; i < 32; ++i) { S[i] = a * S[i] + kr[i] * c1; osum += qr[i] * S[i]; }
            } else {
#pragma unroll
                for (int i = 0; i < 32; ++i) { const float f = kr[i]; S[i] = f * S[i] + (1.f - f) * ve; osum += qr[i] * S[i]; }
            }
            red2[qd * 128 + e] = osum;
            __syncthreads();
            if (tid < 128) ot[r * 128 + e] = (red2[e] + red2[128 + e]) + (red2[256 + e] + red2[384 + e]);
        }
        __syncthreads();
        {
            const int r = tid >> 3, c0 = (tid & 7) * 16; float o[16]; float ss = 0.f;
#pragma unroll
            for (int i = 0; i < 16; ++i) { o[i] = ot[r * 128 + c0 + i]; ss += o[i] * o[i]; }
            ss += __shfl_xor(ss, 1); ss += __shfl_xor(ss, 2); ss += __shfl_xor(ss, 4);
            const float rstd = rsqrtf(ss * (1.0f / 128.0f) + EPS);
            const bf16* zp = P + (size_t)(t0 + r) * NPROJ + (mixer ? PQ_BG : PQ_AZ) + h * 128 + c0;
            const v4u z0 = *(const v4u*)zp, z1 = *(const v4u*)(zp + 8);
            const unsigned zw[8] = {z0.x, z0.y, z0.z, z0.w, z1.x, z1.y, z1.z, z1.w};
            unsigned ow[8];
#pragma unroll
            for (int i = 0; i < 8; ++i) { const float za = bflo(zw[i]), zb = bfhi(zw[i]);
                ow[i] = pk2(o[2 * i] * rstd * nw[c0 + 2 * i] * siluf_(za), o[2 * i + 1] * rstd * nw[c0 + 2 * i + 1] * siluf_(zb)); }
            bf16* op = O + (size_t)(t0 + r) * D + mixer * 1024 + h * 128 + c0;
            *(v4u*)op = (v4u){ow[0], ow[1], ow[2], ow[3]}; *(v4u*)(op + 8) = (v4u){ow[4], ow[5], ow[6], ow[7]};
        }
        __syncthreads();
    }
}

__device__ __forceinline__ void phase_lru_conv(const Frame& F) {
    const bf16* XBR = (const bf16*)(F.ws + O_XBR); bf16* XC = (bf16*)(F.ws + O_XC);
    const float* cw = F.in[I_RGCW]; const float* cb = F.in[I_RGCB];
    for (int idx = F.blk * 512 + F.tid; idx < T * 256; idx += F.G * 512) {
        const int t = idx >> 8, c0 = (idx & 255) * 8, s = t & (SEQ - 1);
        float a[8];
        { const f32x4 b0 = *(const f32x4*)(cb + c0), b1 = *(const f32x4*)(cb + c0 + 4); a[0] = b0.x; a[1] = b0.y; a[2] = b0.z; a[3] = b0.w; a[4] = b1.x; a[5] = b1.y; a[6] = b1.z; a[7] = b1.w; }
#pragma unroll
        for (int j = 0; j < 4; ++j) { if (s - 3 + j >= 0) { const v4u w = *(const v4u*)(XBR + (size_t)(t - 3 + j) * D + c0);
                const f32x4 k0 = *(const f32x4*)(cw + j * D + c0), k1 = *(const f32x4*)(cw + j * D + c0 + 4);
                a[0] += k0.x * bflo(w.x); a[1] += k0.y * bfhi(w.x); a[2] += k0.z * bflo(w.y); a[3] += k0.w * bfhi(w.y);
                a[4] += k1.x * bflo(w.z); a[5] += k1.y * bfhi(w.z); a[6] += k1.z * bflo(w.w); a[7] += k1.w * bfhi(w.w); } }
        *(v4u*)(XC + (size_t)t * D + c0) = (v4u){pk2(a[0], a[1]), pk2(a[2], a[3]), pk2(a[4], a[5]), pk2(a[6], a[7])};
    }
}
__device__ __forceinline__ void phase_lru_scan1(const Frame& F) {
    const float* AA = (const float*)(F.ws + O_AA); const float* BB = (const float*)(F.ws + O_BB);
    float* SA = (float*)(F.ws + O_SUMA); float* SB = (float*)(F.ws + O_SUMB);
    for (int gid = F.blk * 512 + F.tid; gid < 2 * 32 * D; gid += F.G * 512) {
        const int ch = gid & 2047, chunk = (gid >> 11) & 31, b = gid >> 16; const size_t base = (size_t)(b * SEQ + chunk * 128) * D + ch;
        float hh = 0.f, pp = 1.f;
#pragma unroll 8
        for (int i = 0; i < 128; ++i) { const float a = AA[base + (size_t)i * D], bb = BB[base + (size_t)i * D]; hh = a * hh + bb; pp *= a; }
        SA[gid] = pp; SB[gid] = hh;
    }
}
__device__ __forceinline__ void phase_lru_scan2(const Frame& F) {
    const float* AA = (const float*)(F.ws + O_AA); const float* BB = (const float*)(F.ws + O_BB);
    const float* SA = (const float*)(F.ws + O_SUMA); const float* SB = (const float*)(F.ws + O_SUMB);
    const bf16* Y = (const bf16*)(F.ws + O_Y); bf16* YH = (bf16*)(F.ws + O_YH);
    for (int gid = F.blk * 512 + F.tid; gid < 2 * 32 * D; gid += F.G * 512) {
        const int ch = gid & 2047, chunk = (gid >> 11) & 31, b = gid >> 16; const size_t base = (size_t)(b * SEQ + chunk * 128) * D + ch;
        float hh = 0.f;
        for (int c = 0; c < chunk; ++c) { const int g2 = (b * 32 + c) * D + ch; hh = SA[g2] * hh + SB[g2]; }
#pragma unroll 8
        for (int i = 0; i < 128; ++i) { const float a = AA[base + (size_t)i * D], bb = BB[base + (size_t)i * D]; hh = a * hh + bb;
            YH[base + (size_t)i * D] = (bf16)f2bf(bf2f(Y[base + (size_t)i * D]) * hh); }
    }
}

__device__ __forceinline__ void phase_route1(const Frame& F) {
    const int gw = F.blk * 8 + F.wave, ngw = F.G * 8, lane = F.lane;
    LAS float* rwt = (LAS float*)F.lds;
    LAS unsigned* cntL = (LAS unsigned*)(F.lds + 8 * 2052 * 4);
    const float* RW = F.in[I_ROUTER];
    for (int idx = F.tid; idx < D * 8; idx += 512) { const int e = idx & 7, i = idx >> 3; rwt[e * 2052 + i] = RW[idx]; }
    if (F.tid < 8) cntL[F.tid] = 0u;
    __syncthreads();
    const float* X3 = (const float*)(F.ws + O_X3); const float* nw = F.in[I_NORMW] + 3 * D;
    bf16* XN = (bf16*)(F.ws + O_XN); unsigned* TOKE = (unsigned*)(F.ws + O_TOKE); float* TOKG = (float*)(F.ws + O_TOKG);
    for (int m = gw; m < T; m += ngw) {
        f32x4 v[8]; rms_load(X3 + (size_t)m * D, nw, lane, v);
        row_store_bf16(XN + (size_t)m * D, lane, v);
        float v0 = -3.0e38f, v1 = -3.0e38f; int i0 = 0, i1 = 0;
#pragma unroll 1
        for (int e = 0; e < 8; ++e) { float a = 0.f;
#pragma unroll
            for (int j = 0; j < 8; ++j) { const f32x4 w = *(const LAS f32x4*)(rwt + e * 2052 + 4 * lane + 256 * j); a += (v[j].x * w.x + v[j].y * w.y) + (v[j].z * w.z + v[j].w * w.w); }
            a = wave_sum(a);
            if (a > v0) { v1 = v0; i1 = i0; v0 = a; i0 = e; } else if (a > v1) { v1 = a; i1 = e; } }
        if (lane == 0) { const float g0 = 1.0f / (1.0f + __expf(v1 - v0)); TOKE[m] = (unsigned)i0 | ((unsigned)i1 << 8); TOKG[2 * m] = g0; TOKG[2 * m + 1] = 1.0f - g0;
            lds_add(cntL + i0, 1u); lds_add(cntL + i1, 1u); }
    }
    __syncthreads();
    if (F.tid < 8) ((unsigned*)(F.ws + O_WCNT))[F.blk * 8 + F.tid] = cntL[F.tid];
}
__device__ __forceinline__ void phase_route2(const Frame& F) {
    LAS unsigned* tot = (LAS unsigned*)F.lds; LAS unsigned* pre = tot + 8; LAS unsigned* eoff = tot + 16; LAS unsigned* basep = tot + 32; LAS unsigned* lpos = tot + 64; LAS unsigned* ltok = tot + 128;
    const unsigned* WCNT = (const unsigned*)(F.ws + O_WCNT); const unsigned* TOKE = (const unsigned*)(F.ws + O_TOKE);
    if (F.tid < 16) tot[F.tid] = 0u;
    if (F.tid < 32) ltok[F.tid] = TOKE[F.blk * 8 + (F.tid & 7) + 2048 * (F.tid >> 3)];
    __syncthreads();
    for (int idx = F.tid; idx < F.G * 8; idx += 512) { const int w = idx >> 3, e = idx & 7; const unsigned v = WCNT[idx]; lds_add(tot + e, v); if (w < F.blk) lds_add(pre + e, v); }
    __syncthreads();
    if (F.tid == 0) {
        unsigned off = 0;
        for (int e = 0; e < 8; ++e) { eoff[e] = off; basep[e] = off + pre[e]; off += (tot[e] + 255u) & ~255u; }
        eoff[8] = off;
        for (int i = 0; i < 32; ++i) { const unsigned te = ltok[i]; const unsigned e0 = te & 255u, e1 = te >> 8;
            lpos[2 * i] = basep[e0]; basep[e0] += 1; lpos[2 * i + 1] = basep[e1]; basep[e1] += 1; }
    }
    __syncthreads();
    if (F.blk == 0 && F.tid < 9) ((unsigned*)(F.ws + O_EOFF))[F.tid] = eoff[F.tid];
    if (F.tid < 32) { const int m = F.blk * 8 + (F.tid & 7) + 2048 * (F.tid >> 3); ((unsigned*)(F.ws + O_POS))[2 * m] = lpos[2 * F.tid]; ((unsigned*)(F.ws + O_POS))[2 * m + 1] = lpos[2 * F.tid + 1]; }
    const bf16* XN = (const bf16*)(F.ws + O_XN); bf16* HS = (bf16*)(F.ws + O_HS);
    for (int k = 0; k < 4; ++k) { const int li = k * 8 + F.wave, m = F.blk * 8 + F.wave + 2048 * k; const v4u* src = (const v4u*)(XN + (size_t)m * D);
        v4u a[4];
#pragma unroll
        for (int j = 0; j < 4; ++j) a[j] = src[F.lane + 64 * j];
#pragma unroll
        for (int sl = 0; sl < 2; ++sl) { v4u* dst = (v4u*)(HS + (size_t)lpos[2 * li + sl] * D);
#pragma unroll
            for (int j = 0; j < 4; ++j) dst[F.lane + 64 * j] = a[j]; } }
    if (F.blk < 8) {
        const unsigned r0 = eoff[F.blk] + tot[F.blk], r1 = eoff[F.blk + 1];
        for (unsigned idx = r0 * 256 + F.tid; idx < r1 * 256; idx += 512) ((v4u*)HS)[idx] = (v4u){0u, 0u, 0u, 0u};
    }
    __syncthreads();
}
struct SchedMoe {
    int nN, G, c, nrt; long aT, bT, bE; unsigned eo[9];
    __device__ __forceinline__ bool next(int i, pg8::Unit& u) const {
        if (!pg8::std_order(i, G, c, nrt, nN, u.pm, u.pn)) return false;
        int e = 0;
#pragma unroll
        for (int k = 1; k < 8; ++k) e += ((unsigned)(u.pm * 256) >= eo[k]) ? 1 : 0;
        u.aoff = (long)u.pm * aT; u.boff = (long)e * bE + (long)u.pn * bT; return true;
    }
};
struct SchedGates {
    int G, c;
    __device__ __forceinline__ bool next(int i, pg8::Unit& u) const {
        if (!pg8::std_order(i, G, c, 32, 16, u.pm, u.pn)) return false;
        u.aoff = ((long)u.pm * 256 * D + (u.pn >> 1) * 256) * 2; u.boff = (long)u.pn * 256 * 256 * 2; return true;
    }
};
__device__ __forceinline__ void phase_combine(const Frame& F) {
    const int gw = F.blk * 8 + F.wave, ngw = F.G * 8, lane = F.lane;
    const float* X3 = (const float*)(F.ws + O_X3); const float* YM = (const float*)(F.ws + O_YM);
    const unsigned* POS = (const unsigned*)(F.ws + O_POS); const float* TOKG = (const float*)(F.ws + O_TOKG); const float* fnw = F.in[I_FNW];
    for (int m = gw; m < T; m += ngw) {
        const unsigned p0 = POS[2 * m], p1 = POS[2 * m + 1]; const float g0 = TOKG[2 * m], g1 = TOKG[2 * m + 1];
        f32x4 v[8]; float s = 0.f;
#pragma unroll
        for (int j = 0; j < 8; ++j) { const f32x4 x = ((const f32x4*)(X3 + (size_t)m * D))[lane + 64 * j], y0 = ((const f32x4*)(YM + (size_t)p0 * D))[lane + 64 * j], y1 = ((const f32x4*)(YM + (size_t)p1 * D))[lane + 64 * j];
            v[j] = x + g0 * y0 + g1 * y1; s += (v[j].x * v[j].x + v[j].y * v[j].y) + (v[j].z * v[j].z + v[j].w * v[j].w); }
        const float rstd = rsqrtf(wave_sum(s) * (1.0f / D) + EPS);
#pragma unroll
        for (int j = 0; j < 8; ++j) { const f32x4 w = ((const f32x4*)fnw)[lane + 64 * j]; ((f32x4*)(F.out + (size_t)m * D))[lane + 64 * j] = v[j] * rstd * w; }
    }
}

constexpr int NPHASES = 20;
struct Args { const float* in[25]; float* out; unsigned char* ws; int ph_lo, ph_hi; };
__global__ void __launch_bounds__(512, 2) mk_fwd(Args args) {
    extern __shared__ __attribute__((aligned(16))) unsigned char lds_raw[];
    Frame F;
    F.lds = (LAS unsigned char*)lds_raw;
    F.tid = threadIdx.x; F.lane = F.tid & 63; F.wave = __builtin_amdgcn_readfirstlane(F.tid >> 6); F.G = gridDim.x; F.blk = blockIdx.x;
    F.ws = args.ws; F.out = args.out;
#pragma unroll
    for (int i = 0; i < 25; ++i) F.in[i] = args.in[i];
    volatile LAS unsigned* MISC = (volatile LAS unsigned*)(F.lds + MISC_OFF);
    if (F.tid < 64) MISC[F.tid] = 0u;
    __syncthreads();
    const int lo = args.ph_lo, hi = args.ph_hi;
    XcdBarrier bar; bar.bar = (unsigned*)(F.ws + O_CTL) + CW_BAR; bar.x = 0; bar.st = nullptr;
    if (hi - lo > 1) bar = xcd_barrier_post((unsigned*)(F.ws + O_CTL) + CW_BAR, MISC + 8);
#ifdef ONLY_PHASE
#define IN(k) ((k) == ONLY_PHASE && lo <= (k) && (k) < hi)
#else
#define IN(k) (lo <= (k) && (k) < hi)
#endif
#define SEAM(k) do { if (IN(k) && IN((k) + 1)) xcd_barrier(bar); } while (0)
    unsigned char* ws = F.ws;
    bf16* XN = (bf16*)(ws + O_XN);

    if (IN(0)) { phase_prologue(F); } SEAM(0);
    if (IN(1)) {
        pg8::Gemm g{XN, (const bf16*)(ws + O_WMI), D, D, D}; pg8::SchedStd S{T / 256, NPROJ / 256, F.G, F.blk, (long)256 * D * 2, (long)256 * D * 2};
        pg8::EpiBf16 E{(bf16*)(ws + O_PROJ), NPROJ};
        pg8::gemm_phase(F.lds, g, S, E);
    } SEAM(1);
    if (IN(2)) { phase_mix_pre(F); } SEAM(2);
    if (IN(3)) { phase_mix_scan_slow(F); } SEAM(3);
    if (IN(4)) {
        pg8::Gemm g{(const bf16*)(ws + O_O), (const bf16*)(ws + O_WMO), D, D, D}; pg8::SchedStd S{T / 256, D / 256, F.G, F.blk, (long)256 * D * 2, (long)256 * D * 2};
        pg8::EpiResF32 E{F.in[I_X], (float*)(ws + O_X1), D};
        pg8::gemm_phase(F.lds, g, S, E);
    } SEAM(4);
    if (IN(5)) { phase_rms(F, (const float*)(ws + O_X1), F.in[I_NORMW] + D); } SEAM(5);
    if (IN(6)) {
        pg8::Gemm g{XN, (const bf16*)(ws + O_WFG), D, D, D}; pg8::SchedStd S{T / 256, 2 * FF / 256, F.G, F.blk, (long)256 * D * 2, (long)256 * D * 2};
        pg8::EpiSwiglu E{(bf16*)(ws + O_ACT), FF};
        pg8::gemm_phase(F.lds, g, S, E);
    } SEAM(6);
    if (IN(7)) {
        pg8::Gemm g{(const bf16*)(ws + O_ACT), (const bf16*)(ws + O_WFD), FF, FF, FF}; pg8::SchedStd S{T / 256, D / 256, F.G, F.blk, (long)256 * FF * 2, (long)256 * FF * 2};
        pg8::EpiResF32 E{(const float*)(ws + O_X1), (float*)(ws + O_X2), D};
        pg8::gemm_phase(F.lds, g, S, E);
    } SEAM(7);
    if (IN(8)) { phase_rms(F, (const float*)(ws + O_X2), F.in[I_NORMW] + 2 * D); } SEAM(8);
    if (IN(9)) {
        pg8::Gemm g{XN, (const bf16*)(ws + O_WRI), D, D, D}; pg8::SchedStd S{T / 256, 2 * D / 256, F.G, F.blk, (long)256 * D * 2, (long)256 * D * 2};
        pg8::EpiRgIn E{(bf16*)(ws + O_Y), (bf16*)(ws + O_XBR)};
        pg8::gemm_phase(F.lds, g, S, E);
    } SEAM(9);
    if (IN(10)) { phase_lru_conv(F); } SEAM(10);
    if (IN(11)) {
        pg8::Gemm g{(const bf16*)(ws + O_XC), (const bf16*)(ws + O_WRG), D, 256, 256}; SchedGates S{F.G, F.blk};
        pg8::EpiGates E{(const bf16*)(ws + O_XC), F.in[I_RGAB], F.in[I_RGXB], (const float*)(ws + O_SPL), (float*)(ws + O_AA), (float*)(ws + O_BB)};
        pg8::gemm_phase(F.lds, g, S, E);
    } SEAM(11);
    if (IN(12)) { phase_lru_scan1(F); } SEAM(12);
    if (IN(13)) { phase_lru_scan2(F); } SEAM(13);
    if (IN(14)) {
        pg8::Gemm g{(const bf16*)(ws + O_YH), (const bf16*)(ws + O_WRO), D, D, D}; pg8::SchedStd S{T / 256, D / 256, F.G, F.blk, (long)256 * D * 2, (long)256 * D * 2};
        pg8::EpiResF32 E{(const float*)(ws + O_X2), (float*)(ws + O_X3), D};
        pg8::gemm_phase(F.lds, g, S, E);
    } SEAM(14);
    if (IN(15)) { phase_route1(F); } SEAM(15);
    if (IN(16)) { phase_route2(F); } SEAM(16);
    if (IN(17)) {
        SchedMoe S; S.nN = 2 * FE / 256; S.G = F.G; S.c = F.blk; S.aT = (long)256 * D * 2; S.bT = (long)256 * D * 2; S.bE = (long)2 * FE * D * 2;
        const unsigned* eo = (const unsigned*)(ws + O_EOFF);
#pragma unroll
        for (int k = 0; k < 9; ++k) S.eo[k] = __builtin_amdgcn_readfirstlane(eo[k]);
        S.nrt = (int)(S.eo[8] >> 8);
        pg8::Gemm g{(const bf16*)(ws + O_HS), (const bf16*)(ws + O_WMG), D, D, D};
        pg8::EpiSwiglu E{(bf16*)(ws + O_ACTM), FE};
        pg8::gemm_phase(F.lds, g, S, E);
    } SEAM(17);
    if (IN(18)) {
        SchedMoe S; S.nN = D / 256; S.G = F.G; S.c = F.blk; S.aT = (long)256 * FE * 2; S.bT = (long)256 * FE * 2; S.bE = (long)D * FE * 2;
        const unsigned* eo = (const unsigned*)(ws + O_EOFF);
#pragma unroll
        for (int k = 0; k < 9; ++k) S.eo[k] = __builtin_amdgcn_readfirstlane(eo[k]);
        S.nrt = (int)(S.eo[8] >> 8);
        pg8::Gemm g{(const bf16*)(ws + O_ACTM), (const bf16*)(ws + O_WMD), FE, FE, FE};
        pg8::EpiResF32 E{nullptr, (float*)(ws + O_YM), D};
        pg8::gemm_phase(F.lds, g, S, E);
    } SEAM(18);
    if (IN(19)) { phase_combine(F); }
#undef IN
#undef SEAM
}

extern "C" void kernel_launch(void* const* d_in, const int* in_sizes, int n_in, void* d_out, int out_size, void* d_ws, size_t ws_size, hipStream_t stream) {
    static int grid = 0;
    if (grid == 0) {
        if (n_in != 25 || out_size != T * D || ws_size < WS_END) { fprintf(stderr, "kernel_launch: unexpected shapes (n_in %d out %d ws %zu need %zu)\n", n_in, out_size, ws_size, (size_t)WS_END); grid = -1; return; }
        int dev = 0, cus = 0, per_cu = 0;
        if (hipGetDevice(&dev) != hipSuccess || hipDeviceGetAttribute(&cus, hipDeviceAttributeMultiprocessorCount, dev) != hipSuccess) { grid = -1; return; }
        if (hipFuncSetAttribute((const void*)mk_fwd, hipFuncAttributeMaxDynamicSharedMemorySize, LDS_BYTES) != hipSuccess) { fprintf(stderr, "kernel_launch: hipFuncSetAttribute failed\n"); grid = -1; return; }
        if (hipOccupancyMaxActiveBlocksPerMultiprocessor(&per_cu, (const void*)mk_fwd, 512, LDS_BYTES) != hipSuccess || per_cu < 1) fprintf(stderr, "kernel_launch: occupancy query reports %d\n", per_cu);
        (void)hipGetLastError();
        grid = cus > 256 ? 256 : cus;
    }
    if (grid < 0) return;
    (void)hipMemsetAsync((char*)d_ws + O_CTL, 0, CTL_BYTES, stream);
    Args a{};
    for (int i = 0; i < 25; ++i) a.in[i] = (const float*)d_in[i];
    a.out = (float*)d_out; a.ws = (unsigned char*)d_ws;
#if MK_SPLIT
    for (int p = 0; p < NPHASES; ++p) { a.ph_lo = p; a.ph_hi = p + 1; hipLaunchKernelGGL(mk_fwd, dim3(grid), dim3(512), LDS_BYTES, stream, a); }
#else
    a.ph_lo = 0; a.ph_hi = NPHASES; hipLaunchKernelGGL(mk_fwd, dim3(grid), dim3(512), LDS_BYTES, stream, a);
#endif
}
```

```cpp
#include <hip/hip_runtime.h>
#include <cstdio>
#include <cstdint>

#ifndef MK_SPLIT
#define MK_SPLIT 0
#endif

#ifndef FAST_GDN
#define FAST_GDN 1
#endif
#ifndef FAST_HGRN
#define FAST_HGRN 1
#endif
#define GAS __attribute__((address_space(1)))
#define LAS __attribute__((address_space(3)))
typedef unsigned short bf16;
typedef unsigned v4u __attribute__((ext_vector_type(4)));
typedef unsigned v2u __attribute__((ext_vector_type(2)));
typedef float f32x4 __attribute__((ext_vector_type(4)));
typedef float f32x2 __attribute__((ext_vector_type(2)));
typedef short bf16x8 __attribute__((ext_vector_type(8)));
#define RLX_AGENT __ATOMIC_RELAXED, __HIP_MEMORY_SCOPE_AGENT
#define LDS_WAIT() asm volatile("s_waitcnt lgkmcnt(0)" ::: "memory")
#define VM_WAIT() asm volatile("s_waitcnt vmcnt(0)" ::: "memory")

__device__ __forceinline__ unsigned f2bf(float f) { unsigned u = __builtin_bit_cast(unsigned, f); return (u + 0x7fffu + ((u >> 16) & 1u)) >> 16; }
__device__ __forceinline__ unsigned pk2(float lo, float hi) { return f2bf(lo) | (f2bf(hi) << 16); }
__device__ __forceinline__ float bf2f(unsigned short b) { return __builtin_bit_cast(float, ((unsigned)b) << 16); }
__device__ __forceinline__ float bflo(unsigned w) { return __builtin_bit_cast(float, w << 16); }
__device__ __forceinline__ float bfhi(unsigned w) { return __builtin_bit_cast(float, w & 0xffff0000u); }
__device__ __forceinline__ float sigmoidf_(float x) { return 1.0f / (1.0f + __expf(-x)); }
__device__ __forceinline__ float siluf_(float x) { return x / (1.0f + __expf(-x)); }
__device__ __forceinline__ float softplusf_(float x) { return x > 20.f ? x : log1pf(__expf(x)); }
__device__ __forceinline__ void lds_add(LAS unsigned* p, unsigned v) { (void)__hip_atomic_fetch_add(p, v, __ATOMIC_RELAXED, __HIP_MEMORY_SCOPE_WORKGROUP); }
__device__ __forceinline__ float wave_sum(float v) {
#pragma unroll
    for (int o = 1; o < 64; o <<= 1) v += __shfl_xor(v, o);
    return v;
}

constexpr int T = 8192, D = 2048, SEQ = 4096, NPROJ = 8192, FF = 5632, FE = 7168, NE = 8;
constexpr int MIXLD = 8208;
constexpr int PQ_AQ = 0, PQ_AK = 1024, PQ_AV = 2048, PQ_AZ = 3072, PQ_BQ = 4096, PQ_BF = 5120, PQ_BI = 6144, PQ_BG = 7168;
constexpr float EPS = 1e-6f;
constexpr int MOE_ROWS = 16384 + 8 * 256;

constexpr size_t al256(size_t x) { return (x + 255) & ~(size_t)255; }
constexpr size_t O_CTL = 0, CTL_BYTES = 1u << 20;
constexpr size_t O_WMI = CTL_BYTES;
constexpr size_t O_WMO = O_WMI + (size_t)NPROJ * D * 2;
constexpr size_t O_WFG = O_WMO + (size_t)D * D * 2;
constexpr size_t O_WFD = O_WFG + (size_t)2 * FF * D * 2;
constexpr size_t O_WRI = O_WFD + (size_t)D * FF * 2;
constexpr size_t O_WRG = O_WRI + (size_t)2 * D * D * 2;
constexpr size_t O_WRO = O_WRG + (size_t)16 * 256 * 256 * 2;
constexpr size_t O_WMG = O_WRO + (size_t)D * D * 2;
constexpr size_t O_WMD = O_WMG + (size_t)NE * 2 * FE * D * 2;
constexpr size_t O_XN = O_WMD + (size_t)NE * D * FE * 2;
constexpr size_t O_PROJ = O_XN + (size_t)T * D * 2;
constexpr size_t O_GB = O_PROJ + (size_t)T * NPROJ * 2;
constexpr size_t O_O = O_GB + (size_t)T * 16 * 4;
constexpr size_t O_X1 = O_O + (size_t)T * D * 2;
constexpr size_t O_X2 = O_X1 + (size_t)T * D * 4;
constexpr size_t O_X3 = O_X2 + (size_t)T * D * 4;
constexpr size_t O_ACT = O_X3 + (size_t)T * D * 4;
constexpr size_t O_Y = O_ACT + (size_t)T * FF * 2;
constexpr size_t O_XBR = O_Y + (size_t)T * D * 2;
constexpr size_t O_XC = O_XBR + (size_t)T * D * 2;
constexpr size_t O_AA = O_XC + (size_t)T * D * 2;
constexpr size_t O_BB = O_AA + (size_t)T * D * 4;
constexpr size_t O_YH = O_BB + (size_t)T * D * 4;
constexpr size_t O_SUMA = O_YH + (size_t)T * D * 2;
constexpr size_t O_SUMB = O_SUMA + (size_t)2 * 32 * D * 4;
constexpr size_t O_TOKE = O_SUMB + (size_t)2 * 32 * D * 4;
constexpr size_t O_TOKG = O_TOKE + (size_t)T * 4;
constexpr size_t O_POS = O_TOKG + (size_t)T * 8;
constexpr size_t O_WCNT = O_POS + (size_t)T * 8;
constexpr size_t O_EOFF = O_WCNT + 256 * 8 * 4;
constexpr size_t O_SPL = al256(O_EOFF + 64);
constexpr size_t O_HS = O_SPL + 2048 * 4;
constexpr size_t O_ACTM = O_HS + (size_t)MOE_ROWS * D * 2;
constexpr size_t O_YM = O_ACTM + (size_t)MOE_ROWS * FE * 2;
constexpr size_t O_QF = O_YM + (size_t)MOE_ROWS * D * 4;
constexpr size_t O_KF = O_QF + (size_t)T * 1024 * 4;
constexpr size_t O_VF = O_KF + (size_t)T * 1024 * 4;
constexpr size_t O_FH = O_VF + (size_t)T * 1024 * 4;
constexpr size_t O_QH = O_FH + (size_t)T * 1024 * 4;
constexpr size_t REC_BYTES = 57856;
constexpr size_t O_OPS = al256(O_QH + (size_t)T * 1024 * 4);
constexpr size_t O_UT = O_OPS + (size_t)32 * 64 * REC_BYTES;
constexpr size_t WS_END = O_UT + (size_t)32 * 64 * 8192 * 4;

constexpr int CW_BAR = 4096;

constexpr int LDS_BYTES = 155648;
constexpr int MISC_OFF = 155648 - 256;

namespace pg8 {
constexpr int BM = 256, BK = 64, HALF = 128, HTB = HALF * BK * 2, STAGE_BYTES = 8 * HTB, NXCD = 8, WGM = 8;
__host__ __device__ __forceinline__ int lds_byte(int r, int c) { const int st = (r >> 4) * 2 + (c >> 5), rr = r & 15, cc = c & 31, ob = rr * 64 + cc * 2; return st * 1024 + (ob ^ (((ob >> 9) & 1) << 5)); }
__host__ __device__ __forceinline__ void stage_rc(int b, int& R, int& C) { const int st = b / 1024, sb = b % 1024, swz = sb ^ (((sb >> 9) & 1) << 5); R = (st >> 1) * 16 + swz / 64; C = (st & 1) * 32 + (swz % 64) / 2; }
__host__ __device__ __forceinline__ int perm32(int rho) { const int n = rho >> 4, i = rho & 15; return 8 * (i >> 2) + 4 * n + (i & 3); }

struct Unit { int pm, pn; long aoff, boff; };
struct Gemm { const bf16* A; const bf16* Bt; int lda, ldb, K; };

__device__ __forceinline__ bool std_order(int i, int G, int c, int nM, int nN, int& pm, int& pn) {
    const int nwg = nM * nN; const long L = (long)i * G + c; if (L >= nwg) return false;
    int wgid = (int)L; { const int q = nwg / NXCD, r = nwg % NXCD, xcd = wgid % NXCD, off = wgid / NXCD; wgid = (xcd < r ? xcd * (q + 1) : r * (q + 1) + (xcd - r) * q) + off; }
    const int nig = WGM * nN, gid = wgid / nig, fm = gid * WGM, gsz = (nM - fm) < WGM ? (nM - fm) : WGM;
    pm = fm + ((wgid % nig) % gsz); pn = (wgid % nig) / gsz; return true;
}
struct SchedStd {
    int nM, nN, G, c; long aT, bT;
    __device__ __forceinline__ bool next(int i, Unit& u) const { if (!std_order(i, G, c, nM, nN, u.pm, u.pn)) return false; u.aoff = (long)u.pm * aT; u.boff = (long)u.pn * bT; return true; }
};

template <class Epi, class Sched>
__device__ __forceinline__ void gemm_phase(LAS unsigned char* lds, const Gemm g, const Sched& S, const Epi& E) {
    const int tid = threadIdx.x, wid = __builtin_amdgcn_readfirstlane(tid >> 6), lane = tid & 63, wr = wid >> 2, wc = wid & 3, fr = lane & 15, fq = lane >> 4;
    const int K = g.K, nt = K / BK;
    unsigned voffA[2], voffB[2];
#pragma unroll
    for (int i = 0; i < 2; ++i) { int R, C; stage_rc(tid * 16 + i * 8192, R, C); const int Rb = Epi::PERM ? ((R & ~31) + perm32(R & 31)) : R;
        voffA[i] = (unsigned)(R * g.lda + C) * 2u; voffB[i] = (unsigned)(Rb * g.ldb + C) * 2u; }
    const size_t kstep = (size_t)(BK * 2);
    const size_t hstepA = (size_t)HALF * g.lda * 2, hstepB = (size_t)HALF * g.ldb * 2;
    const unsigned ldsw = (unsigned)wid * 1024u;
    const int aoff = lds_byte(wr * 64 + fr, fq * 8), boff = lds_byte(wc * 32 + fr, fq * 8);
#define PG8_SA(b, h) (((b) * 2 + (h)) * HTB)
#define PG8_SB(b, h) ((4 + (b) * 2 + (h)) * HTB)
#define PG8_STAGE(bufoff, gbase, voff) do { _Pragma("unroll") for (int _i = 0; _i < 2; ++_i) \
        __builtin_amdgcn_global_load_lds((const unsigned*)((const char*)(gbase) + (voff)[_i]), (LAS unsigned*)(lds + (bufoff) + ldsw + _i * 8192), 16, 0, 0); } while (0)
#define PG8_LDA(dst, b, h) do { _Pragma("unroll") for (int m = 0; m < 4; ++m) _Pragma("unroll") for (int k = 0; k < 2; ++k) dst[m][k] = *(const LAS bf16x8*)(lds + PG8_SA(b, h) + aoff + m * 2048 + k * 1024); } while (0)
#define PG8_LDB(dst, b, h) do { _Pragma("unroll") for (int n = 0; n < 2; ++n) _Pragma("unroll") for (int k = 0; k < 2; ++k) dst[n][k] = *(const LAS bf16x8*)(lds + PG8_SB(b, h) + boff + n * 2048 + k * 1024); } while (0)
#define PG8_MMA(ai, bj, At, Bt) do { __builtin_amdgcn_s_setprio(1); _Pragma("unroll") for (int m = 0; m < 4; ++m) _Pragma("unroll") for (int n = 0; n < 2; ++n) _Pragma("unroll") for (int k = 0; k < 2; ++k) \
        acc[ai][bj][m][n] = __builtin_amdgcn_mfma_f32_16x16x32_bf16(Bt[n][k], At[m][k], acc[ai][bj][m][n], 0, 0, 0); __builtin_amdgcn_s_setprio(0); } while (0)
#define PG8_WAIT_V(n) asm volatile("s_waitcnt vmcnt(" #n ")" ::: "memory")
#define PG8_WAIT_L(n) asm volatile("s_waitcnt lgkmcnt(" #n ")" ::: "memory")
#define PG8_BAR __builtin_amdgcn_s_barrier()
#define PG8_SCHED __builtin_amdgcn_sched_barrier(0)
    Unit cur, nxt; int ui = 0;
    if (!S.next(0, cur)) return;
    f32x4 acc[2][2][4][2];
#pragma unroll
    for (int a = 0; a < 2; ++a)
#pragma unroll
        for (int b = 0; b < 2; ++b)
#pragma unroll
            for (int m = 0; m < 4; ++m)
#pragma unroll
                for (int n = 0; n < 2; ++n) acc[a][b][m][n] = (f32x4){0.f, 0.f, 0.f, 0.f};
    bf16x8 At[4][2], B0[2][2], B1[2][2];
    const char* cA = (const char*)g.A + cur.aoff; const char* cB = (const char*)g.Bt + cur.boff;
    PG8_STAGE(PG8_SB(0, 0), cB, voffB); PG8_STAGE(PG8_SB(0, 1), cB + hstepB, voffB); PG8_STAGE(PG8_SA(0, 0), cA, voffA); PG8_STAGE(PG8_SA(0, 1), cA + hstepA, voffA);
    if (wr == 1) PG8_BAR;
    PG8_WAIT_V(2); PG8_BAR;
    PG8_STAGE(PG8_SB(1, 0), cB + kstep, voffB); PG8_STAGE(PG8_SA(1, 0), cA + kstep, voffA); PG8_STAGE(PG8_SB(1, 1), cB + hstepB + kstep, voffB);
    PG8_WAIT_V(6); PG8_BAR;
    for (;;) {
        const bool has_next = S.next(ui + 1, nxt);
        const char* nA = has_next ? (const char*)g.A + nxt.aoff : cA; const char* nB = has_next ? (const char*)g.Bt + nxt.boff : cB;
#pragma unroll 1
        for (int t = 0; t < nt; t += 2) {
            const bool last = (t == nt - 2);
            const char* a1 = cA + (size_t)(t + 1) * kstep;
            const char* a2 = last ? nA : cA + (size_t)(t + 2) * kstep; const char* b2 = last ? nB : cB + (size_t)(t + 2) * kstep;
            const char* a3 = a2 + kstep; const char* b3 = b2 + kstep;
            PG8_LDB(B0, 0, 0); PG8_LDB(B1, 0, 1); PG8_SCHED; PG8_LDA(At, 0, 0); PG8_STAGE(PG8_SA(1, 1), a1 + hstepA, voffA);
            PG8_WAIT_V(8); PG8_WAIT_L(0); PG8_BAR; PG8_MMA(0, 0, At, B0); PG8_MMA(0, 1, At, B1); PG8_BAR; PG8_SCHED;
            PG8_LDA(At, 0, 1); PG8_STAGE(PG8_SB(0, 0), b2, voffB); PG8_STAGE(PG8_SB(0, 1), b2 + hstepB, voffB); PG8_STAGE(PG8_SA(0, 0), a2, voffA);
            PG8_WAIT_V(8); PG8_WAIT_L(0); PG8_BAR; PG8_MMA(1, 0, At, B0); PG8_MMA(1, 1, At, B1); PG8_BAR; PG8_SCHED;
            PG8_LDB(B0, 1, 0); PG8_LDB(B1, 1, 1); PG8_SCHED; PG8_LDA(At, 1, 0); PG8_STAGE(PG8_SA(0, 1), a2 + hstepA, voffA);
            PG8_WAIT_V(8); PG8_WAIT_L(0); PG8_BAR; PG8_MMA(0, 0, At, B0); PG8_MMA(0, 1, At, B1); PG8_BAR; PG8_SCHED;
            PG8_LDA(At, 1, 1); PG8_STAGE(PG8_SB(1, 0), b3, voffB); PG8_STAGE(PG8_SB(1, 1), b3 + hstepB, voffB); PG8_STAGE(PG8_SA(1, 0), a3, voffA);
            PG8_WAIT_V(8); PG8_WAIT_L(0); PG8_BAR; PG8_MMA(1, 0, At, B0); PG8_MMA(1, 1, At, B1); PG8_BAR; PG8_SCHED;
        }
        if (wr == 0) PG8_BAR;
        E(acc, cur, wr, wc, fr, fq);
        if (!has_next) break;
#pragma unroll
        for (int a = 0; a < 2; ++a)
#pragma unroll
            for (int b = 0; b < 2; ++b)
#pragma unroll
                for (int m = 0; m < 4; ++m)
#pragma unroll
                    for (int n = 0; n < 2; ++n) acc[a][b][m][n] = (f32x4){0.f, 0.f, 0.f, 0.f};
        cur = nxt; cA = nA; cB = nB; ++ui;
        if (wr == 1) PG8_BAR;
    }
    PG8_WAIT_V(0);
    PG8_BAR;
#undef PG8_SA
#undef PG8_SB
#undef PG8_STAGE
#undef PG8_LDA
#undef PG8_LDB
#undef PG8_MMA
#undef PG8_WAIT_V
#undef PG8_WAIT_L
#undef PG8_BAR
#undef PG8_SCHED
}

struct EpiBf16 {
    static constexpr bool PERM = true;
    bf16* O; int ldc;
    __device__ __forceinline__ void operator()(const f32x4 (&acc)[2][2][4][2], const Unit& u, int wr, int wc, int fr, int fq) const {
        const int row0 = u.pm * BM + wr * 64 + fr, col0 = u.pn * BM + wc * 32 + 8 * fq;
#pragma unroll
        for (int ai = 0; ai < 2; ++ai)
#pragma unroll
            for (int m = 0; m < 4; ++m) { bf16* rowp = O + (size_t)(row0 + ai * HALF + m * 16) * ldc + col0;
#pragma unroll
                for (int bj = 0; bj < 2; ++bj) { const f32x4 v0 = acc[ai][bj][m][0], v1 = acc[ai][bj][m][1];
                    v4u w; w.x = pk2(v0[0], v0[1]); w.y = pk2(v0[2], v0[3]); w.z = pk2(v1[0], v1[1]); w.w = pk2(v1[2], v1[3]);
                    *(v4u*)(rowp + bj * HALF) = w; } }
    }
};
struct EpiSwiglu {
    static constexpr bool PERM = true;
    bf16* O; int ldc;
    __device__ __forceinline__ void operator()(const f32x4 (&acc)[2][2][4][2], const Unit& u, int wr, int wc, int fr, int fq) const {
        const int row0 = u.pm * BM + wr * 64 + fr, col0 = u.pn * HALF + wc * 32 + 8 * fq;
#pragma unroll
        for (int ai = 0; ai < 2; ++ai)
#pragma unroll
            for (int m = 0; m < 4; ++m) { bf16* rowp = O + (size_t)(row0 + ai * HALF + m * 16) * ldc + col0;
                float o[8];
#pragma unroll
                for (int n = 0; n < 2; ++n)
#pragma unroll
                    for (int j = 0; j < 4; ++j) { const float gt = acc[ai][0][m][n][j], up = acc[ai][1][m][n][j]; o[n * 4 + j] = gt * __builtin_amdgcn_rcpf(1.0f + __expf(-gt)) * up; }
                v4u w; w.x = pk2(o[0], o[1]); w.y = pk2(o[2], o[3]); w.z = pk2(o[4], o[5]); w.w = pk2(o[6], o[7]);
                *(v4u*)rowp = w; }
    }
};
struct EpiResF32 {
    static constexpr bool PERM = false;
    const float* base; float* out; int ldc;
    __device__ __forceinline__ void operator()(const f32x4 (&acc)[2][2][4][2], const Unit& u, int wr, int wc, int fr, int fq) const {
        const int row0 = u.pm * BM + wr * 64 + fr, col0 = u.pn * BM + wc * 32 + 4 * fq;
#pragma unroll
        for (int ai = 0; ai < 2; ++ai)
#pragma unroll
            for (int m = 0; m < 4; ++m) { const size_t off = (size_t)(row0 + ai * HALF + m * 16) * ldc + col0;
#pragma unroll
                for (int bj = 0; bj < 2; ++bj)
#pragma unroll
                    for (int n = 0; n < 2; ++n) { f32x4 v = acc[ai][bj][m][n]; if (base) v += *(const f32x4*)(base + off + bj * HALF + n * 16); *(f32x4*)(out + off + bj * HALF + n * 16) = v; } }
    }
};
struct EpiRgIn {
    static constexpr bool PERM = true;
    bf16* Y; bf16* XBR;
    __device__ __forceinline__ void operator()(const f32x4 (&acc)[2][2][4][2], const Unit& u, int wr, int wc, int fr, int fq) const {
        const bool isy = u.pn < 8; bf16* O = isy ? Y : XBR;
        const int row0 = u.pm * BM + wr * 64 + fr, col0 = (u.pn & 7) * BM + wc * 32 + 8 * fq;
#pragma unroll
        for (int ai = 0; ai < 2; ++ai)
#pragma unroll
            for (int m = 0; m < 4; ++m) { bf16* rowp = O + (size_t)(row0 + ai * HALF + m * 16) * D + col0;
#pragma unroll
                for (int bj = 0; bj < 2; ++bj) { float o[8];
#pragma unroll
                    for (int n = 0; n < 2; ++n)
#pragma unroll
                        for (int j = 0; j < 4; ++j) { float x = acc[ai][bj][m][n][j];
                            if (isy) { const float y2 = 1.5957691216f * (x + 0.044715f * x * x * x); x = x * __builtin_amdgcn_rcpf(1.0f + __expf(-y2)); }
                            o[n * 4 + j] = x; }
                    v4u w; w.x = pk2(o[0], o[1]); w.y = pk2(o[2], o[3]); w.z = pk2(o[4], o[5]); w.w = pk2(o[6], o[7]);
                    *(v4u*)(rowp + bj * HALF) = w; } }
    }
};
struct EpiGates {
    static constexpr bool PERM = false;
    const bf16* XC; const float* ba; const float* bx; const float* lam; float* AA; float* BB;
    __device__ __forceinline__ void operator()(const f32x4 (&acc)[2][2][4][2], const Unit& u, int wr, int wc, int fr, int fq) const {
        const int row0 = u.pm * BM + wr * 64 + fr, col0 = u.pn * HALF + wc * 32 + 4 * fq;
#pragma unroll
        for (int n = 0; n < 2; ++n) { const int col = col0 + n * 16;
            const f32x4 vba = *(const f32x4*)(ba + col), vbx = *(const f32x4*)(bx + col), sp = *(const f32x4*)(lam + col);
#pragma unroll
            for (int ai = 0; ai < 2; ++ai)
#pragma unroll
                for (int m = 0; m < 4; ++m) { const size_t off = (size_t)(row0 + ai * HALF + m * 16) * D + col;
                    const v2u xw = *(const v2u*)(XC + off); const float xc[4] = {bflo(xw.x), bfhi(xw.x), bflo(xw.y), bfhi(xw.y)};
                    f32x4 oa, ob;
#pragma unroll
                    for (int j = 0; j < 4; ++j) { const float r = sigmoidf_(acc[ai][0][m][n][j] + vba[j]), gi = sigmoidf_(acc[ai][1][m][n][j] + vbx[j]);
                        const float la = sp[j] * r, t2 = 2.0f * la; oa[j] = __expf(la);
                        const float em = (t2 > -0.01f) ? -t2 * (1.0f + 0.5f * t2 * (1.0f + 0.33333334f * t2)) : 1.0f - __expf(t2);
                        ob[j] = sqrtf(fmaxf(em, 0.f)) * (gi * xc[j]); }
                    *(f32x4*)(AA + off) = oa; *(f32x4*)(BB + off) = ob; asm volatile("" ::: "memory"); } }
    }
};
}

#define XB_TMO      128
#define XB_XCNT(j)  (256  + 64 * (j))
#define XB_XSUB(j)  (1280 + 64 * (j))
#define XB_XGEN(j)  (2304 + 64 * (j))
#define XB_TOP      3328
#define XB_TOPGEN   3392
#define XCD_BAR_WORDS 3456
#define XB_SPIN_CAP (1u << 22)
__device__ __forceinline__ unsigned xb_ld(unsigned* p)              { return __hip_atomic_load(p, __ATOMIC_RELAXED, __HIP_MEMORY_SCOPE_AGENT); }
__device__ __forceinline__ unsigned xb_add(unsigned* p, unsigned v) { return __hip_atomic_fetch_add(p, v, __ATOMIC_RELAXED, __HIP_MEMORY_SCOPE_AGENT); }
__device__ __forceinline__ unsigned xb_xcc_id() { return (unsigned)__builtin_amdgcn_s_getreg((3 << 11) | 20) & 0xFu; }
#define XB_SPIN(cond, bar) do { unsigned _sp = 0; while (cond) { __builtin_amdgcn_s_sleep(1); \
    if ((++_sp & 255u) == 0u) { if (xb_ld(&(bar)[XB_TMO])) break; if (_sp > XB_SPIN_CAP) { atomicAdd(&(bar)[XB_TMO], 1u); break; } } } } while (0)
struct XcdBarrier { unsigned* bar; unsigned x; volatile LAS unsigned* st; };
__device__ __forceinline__ XcdBarrier xcd_barrier_post(unsigned* bar, volatile LAS unsigned* st) {
    XcdBarrier b; b.bar = bar; b.x = xb_xcc_id(); b.st = st;
    if (threadIdx.x == 0) (void)xb_add(&bar[XB_XCNT(b.x)], 1u);
    return b;
}
__device__ __forceinline__ void xcd_barrier_complete(unsigned* bar, unsigned x, unsigned& nloc, unsigned& nx) {
    const unsigned G = gridDim.x * gridDim.y * gridDim.z;
    unsigned sum, cnt, mine, sp = 0u;
    for (;;) {
        sum = 0u; cnt = 0u; mine = 0u;
#pragma unroll
        for (unsigned j = 0; j < 16; ++j) { const unsigned c = xb_ld(&bar[XB_XCNT(j)]); sum += c; cnt += (c > 0u) ? 1u : 0u; mine = (j == x) ? c : mine; }
        if (sum == G) break;
        __builtin_amdgcn_s_sleep(1);
        if ((++sp & 255u) == 0u) { if (xb_ld(&bar[XB_TMO])) break; if (sp > XB_SPIN_CAP) { atomicAdd(&bar[XB_TMO], 1u); break; } }
    }
    nloc = mine > 0u ? mine : 1u; nx = cnt > 0u ? cnt : 1u;
}
__device__ __forceinline__ void xcd_barrier(const XcdBarrier& b) {
    asm volatile("s_waitcnt vmcnt(0)" ::: "memory");
    __syncthreads();
    if (threadIdx.x == 0) {
        unsigned* bar = b.bar;
        __builtin_amdgcn_s_waitcnt(0);
        unsigned nloc = b.st[0], nx = b.st[1];
        if (nloc == 0u) { xcd_barrier_complete(bar, b.x, nloc, nx); b.st[0] = nloc; b.st[1] = nx; }
        const unsigned old = xb_add(&bar[XB_XSUB(b.x)], 1u);
        const unsigned gen = old / nloc;
        if (old + 1u == (gen + 1u) * nloc) {
            __builtin_amdgcn_fence(__ATOMIC_RELEASE, "agent");
            asm volatile("s_waitcnt vmcnt(0)" ::: "memory");
            const unsigned og = xb_add(&bar[XB_TOP], 1u);
            const unsigned tg = og / nx;
            if (og + 1u == (tg + 1u) * nx) xb_add(&bar[XB_TOPGEN], 1u);
            else XB_SPIN(xb_ld(&bar[XB_TOPGEN]) == tg, bar);
            __builtin_amdgcn_fence(__ATOMIC_ACQUIRE, "agent");
            xb_add(&bar[XB_XGEN(b.x)], 1u);
            asm volatile("s_waitcnt vmcnt(0)" ::: "memory");
        } else {
            XB_SPIN(xb_ld(&bar[XB_XGEN(b.x)]) == gen, bar);
            __builtin_amdgcn_fence(__ATOMIC_ACQUIRE, "agent");
            asm volatile("s_waitcnt vmcnt(0)" ::: "memory");
        }
    }
    __syncthreads();
}

struct Frame {
    LAS unsigned char* lds;
    int tid, lane, wave, G, blk;
    unsigned char* ws;
    const float* in[25];
    float* out;
};
enum { I_X = 0, I_NORMW, I_FNW, I_MIXIN, I_GCONV, I_ALOG, I_DTB, I_GNW, I_LBL, I_HNW, I_MIXOUT, I_FGU, I_FD, I_RGIN, I_RGCW, I_RGCB, I_RGAW, I_RGAB, I_RGXW, I_RGXB, I_LAM, I_RGOUT, I_ROUTER, I_MGU, I_MD };

struct Job { const float* src; bf16* dst; int ld, K, n0, ncols, drow0, mode, nbatch; long sbs; int dbs; };
__device__ __forceinline__ void conv_item(const Job& jb, LAS float* scr, int item, int lane) {
    const int nblk = jb.ncols / 32, per = (jb.K / 64) * nblk, b = item / per, r = item % per, kb = r / nblk, nb = r % nblk, k0 = 64 * kb, n0l = 32 * nb;
    const float* sp = jb.src + (size_t)b * jb.sbs + (size_t)k0 * jb.ld + jb.n0 + n0l;
#pragma unroll 8
    for (int i = 0; i < 32; ++i) { const int kk = 2 * i + (lane >> 5); scr[kk * 33 + (lane & 31)] = sp[(size_t)kk * jb.ld + (lane & 31)]; }
    LDS_WAIT(); asm volatile("" ::: "memory");
    const int c = lane & 7;
#pragma unroll
    for (int j = 0; j < 4; ++j) { const int n = (lane >> 3) + 8 * j, nl = n0l + n; const LAS float* s = scr + (8 * c) * 33 + n;
        const int drow = jb.drow0 + b * jb.dbs + (jb.mode ? ((nl >> 7) * 256 + (nl & 127)) : nl);
        v4u o; o.x = pk2(s[0 * 33], s[1 * 33]); o.y = pk2(s[2 * 33], s[3 * 33]); o.z = pk2(s[4 * 33], s[5 * 33]); o.w = pk2(s[6 * 33], s[7 * 33]);
        *(v4u*)(jb.dst + (size_t)drow * jb.K + k0 + 8 * c) = o; }
    LDS_WAIT(); asm volatile("" ::: "memory");
}
constexpr int NJOBS = 13;
__device__ __forceinline__ Job get_job(const Frame& F, int j) {
    Job b; b.n0 = 0; b.drow0 = 0; b.mode = 0; b.nbatch = 1; b.sbs = 0; b.dbs = 0;
    unsigned char* ws = F.ws;
    switch (j) {
    case 0:  b.src = F.in[I_MIXIN]; b.dst = (bf16*)(ws + O_WMI); b.ld = MIXLD; b.K = D; b.ncols = 4096; break;
    case 1:  b.src = F.in[I_MIXIN]; b.dst = (bf16*)(ws + O_WMI); b.ld = MIXLD; b.K = D; b.n0 = 4112; b.ncols = 4096; b.drow0 = 4096; break;
    case 2:  b.src = F.in[I_MIXOUT]; b.dst = (bf16*)(ws + O_WMO); b.ld = D; b.K = D; b.ncols = D; break;
    case 3:  b.src = F.in[I_FGU]; b.dst = (bf16*)(ws + O_WFG); b.ld = 2 * FF; b.K = D; b.ncols = FF; b.mode = 1; break;
    case 4:  b.src = F.in[I_FGU]; b.dst = (bf16*)(ws + O_WFG); b.ld = 2 * FF; b.K = D; b.n0 = FF; b.ncols = FF; b.drow0 = 128; b.mode = 1; break;
    case 5:  b.src = F.in[I_FD]; b.dst = (bf16*)(ws + O_WFD); b.ld = D; b.K = FF; b.ncols = D; break;
    case 6:  b.src = F.in[I_RGIN]; b.dst = (bf16*)(ws + O_WRI); b.ld = 2 * D; b.K = D; b.ncols = 2 * D; break;
    case 7:  b.src = F.in[I_RGAW]; b.dst = (bf16*)(ws + O_WRG); b.ld = 256; b.K = 256; b.ncols = 256; b.mode = 1; b.nbatch = 8; b.sbs = 65536; b.dbs = 512; break;
    case 8:  b.src = F.in[I_RGXW]; b.dst = (bf16*)(ws + O_WRG); b.ld = 256; b.K = 256; b.ncols = 256; b.drow0 = 128; b.mode = 1; b.nbatch = 8; b.sbs = 65536; b.dbs = 512; break;
    case 9:  b.src = F.in[I_RGOUT]; b.dst = (bf16*)(ws + O_WRO); b.ld = D; b.K = D; b.ncols = D; break;
    case 10: b.src = F.in[I_MGU]; b.dst = (bf16*)(ws + O_WMG); b.ld = 2 * FE; b.K = D; b.ncols = FE; b.mode = 1; b.nbatch = 8; b.sbs = (long)D * 2 * FE; b.dbs = 2 * FE; break;
    case 11: b.src = F.in[I_MGU]; b.dst = (bf16*)(ws + O_WMG); b.ld = 2 * FE; b.K = D; b.n0 = FE; b.ncols = FE; b.drow0 = 128; b.mode = 1; b.nbatch = 8; b.sbs = (long)D * 2 * FE; b.dbs = 2 * FE; break;
    default: b.src = F.in[I_MD]; b.dst = (bf16*)(ws + O_WMD); b.ld = D; b.K = FE; b.ncols = D; b.nbatch = 8; b.sbs = (long)FE * D; b.dbs = D; break;
    }
    return b;
}
__device__ __forceinline__ void convert_jobs(const Frame& F, int j0, int j1, int gw, int ngw) {
    LAS float* scr = (LAS float*)(F.lds + F.wave * 16384);
    for (int j = j0; j < j1; ++j) { const Job jb = get_job(F, j); const int nitems = jb.nbatch * (jb.K / 64) * (jb.ncols / 32);
        for (int it = gw; it < nitems; it += ngw) conv_item(jb, scr, it, F.lane); }
}

__device__ __forceinline__ void rms_load(const float* xrow, const float* nw, int lane, f32x4 (&v)[8]) {
    float s = 0.f;
#pragma unroll
    for (int j = 0; j < 8; ++j) { v[j] = ((const f32x4*)xrow)[lane + 64 * j]; s += (v[j].x * v[j].x + v[j].y * v[j].y) + (v[j].z * v[j].z + v[j].w * v[j].w); }
    const float rstd = rsqrtf(wave_sum(s) * (1.0f / D) + EPS);
#pragma unroll
    for (int j = 0; j < 8; ++j) { const f32x4 w = ((const f32x4*)nw)[lane + 64 * j]; v[j] = v[j] * rstd * w; }
}
__device__ __forceinline__ void row_store_bf16(bf16* orow, int lane, const f32x4 (&v)[8]) {
#pragma unroll
    for (int j = 0; j < 8; ++j) { v2u w; w.x = pk2(v[j].x, v[j].y); w.y = pk2(v[j].z, v[j].w); ((v2u*)orow)[lane + 64 * j] = w; }
}

__device__ __forceinline__ void phase_prologue(const Frame& F) {
    const int gw = F.blk * 8 + F.wave, ngw = F.G * 8;
    convert_jobs(F, 0, NJOBS, gw, ngw);
    if (F.blk == 0) for (int i = F.tid; i < D; i += 512) ((float*)(F.ws + O_SPL))[i] = -8.0f * log1pf(__expf(-F.in[I_LAM][i]));
    __syncthreads();
    LAS float* w16 = (LAS float*)F.lds;
    const float* W = F.in[I_MIXIN];
    for (int idx = F.tid; idx < D * 16; idx += 512) { const int c = idx & 15, i = idx >> 4; w16[c * 2052 + i] = W[(size_t)i * MIXLD + 4096 + c]; }
    __syncthreads();
    const float* nw = F.in[I_NORMW];
    bf16* XN = (bf16*)(F.ws + O_XN); float* GB = (float*)(F.ws + O_GB);
    for (int m = gw; m < T; m += ngw) {
        f32x4 v[8]; rms_load(F.in[I_X] + (size_t)m * D, nw, F.lane, v);
        row_store_bf16(XN + (size_t)m * D, F.lane, v);
        float mine = 0.f;
#pragma unroll 1
        for (int c = 0; c < 16; ++c) { float a = 0.f;
#pragma unroll
            for (int j = 0; j < 8; ++j) { const f32x4 w = *(const LAS f32x4*)(w16 + c * 2052 + 4 * F.lane + 256 * j); a += (v[j].x * w.x + v[j].y * w.y) + (v[j].z * w.z + v[j].w * w.w); }
            a = wave_sum(a); if (F.lane == c) mine = a; }
        if (F.lane < 8) GB[(size_t)m * 16 + F.lane] = sigmoidf_(mine);
        else if (F.lane < 16) { const int h = F.lane - 8; GB[(size_t)m * 16 + F.lane] = -__expf(F.in[I_ALOG][h]) * softplusf_(mine + F.in[I_DTB][h]); }
    }
    __syncthreads();
}

__device__ __forceinline__ void phase_rms(const Frame& F, const float* X, const float* nw) {
    const int gw = F.blk * 8 + F.wave, ngw = F.G * 8; bf16* XN = (bf16*)(F.ws + O_XN);
    for (int m = gw; m < T; m += ngw) { f32x4 v[8]; rms_load(X + (size_t)m * D, nw, F.lane, v); row_store_bf16(XN + (size_t)m * D, F.lane, v); }
}

__device__ __forceinline__ void phase_mix_pre(const Frame& F) {
    const int gw = F.blk * 8 + F.wave, ngw = F.G * 8, lane = F.lane;
    const bf16* P = (const bf16*)(F.ws + O_PROJ);
    float* QF = (float*)(F.ws + O_QF); float* KF = (float*)(F.ws + O_KF); float* VF = (float*)(F.ws + O_VF); float* FH = (float*)(F.ws + O_FH); float* QH = (float*)(F.ws + O_QH);
    const float* cw = F.in[I_GCONV];
    const float* lbl = F.in[I_LBL];
    for (int it = gw; it < T * 8; it += ngw) {
        const int t = it >> 3, h = it & 7, s = t & (SEQ - 1), d = h * 128 + 2 * lane;
        float r[3][2];
#pragma unroll
        for (int mat = 0; mat < 3; ++mat) { float a0 = 0.f, a1 = 0.f;
#pragma unroll
            for (int j = 0; j < 4; ++j) { if (s - 3 + j >= 0) { const unsigned w = *(const unsigned*)(P + (size_t)(t - 3 + j) * NPROJ + mat * 1024 + d);
                    const f32x2 c = *(const f32x2*)(cw + j * 3072 + mat * 1024 + d); a0 += c.x * bflo(w); a1 += c.y * bfhi(w); } }
            r[mat][0] = siluf_(a0); r[mat][1] = siluf_(a1); }
        const float qs = wave_sum(r[0][0] * r[0][0] + r[0][1] * r[0][1]), ks = wave_sum(r[1][0] * r[1][0] + r[1][1] * r[1][1]);
        const float qn = rsqrtf(qs + EPS) * 0.08838834764831845f, kn = rsqrtf(ks + EPS);
        const size_t o = (size_t)t * 1024 + d;
        *(f32x2*)(QF + o) = (f32x2){r[0][0] * qn, r[0][1] * qn}; *(f32x2*)(KF + o) = (f32x2){r[1][0] * kn, r[1][1] * kn}; *(f32x2*)(VF + o) = (f32x2){r[2][0], r[2][1]};
        const unsigned wq = *(const unsigned*)(P + (size_t)t * NPROJ + PQ_BQ + d), wf = *(const unsigned*)(P + (size_t)t * NPROJ + PQ_BF + d);
        const f32x2 l0 = *(const f32x2*)(lbl + d), l1 = *(const f32x2*)(lbl + 1024 + d);
        const float lb0 = sigmoidf_(l0.x - l1.x), lb1 = sigmoidf_(l0.y - l1.y);
        *(f32x2*)(FH + o) = (f32x2){lb0 + (1.f - lb0) * sigmoidf_(bflo(wf)), lb1 + (1.f - lb1) * sigmoidf_(bfhi(wf))};
        *(f32x2*)(QH + o) = (f32x2){siluf_(bflo(wq)) * 0.08838834764831845f, siluf_(bfhi(wq)) * 0.08838834764831845f};
    }
}

__device__ __forceinline__ void phase_mix_scan_slow(const Frame& F) {
    if (F.blk >= 32) return;
    const int mixer = F.blk >> 4, b = (F.blk >> 3) & 1, h = F.blk & 7, tid = F.tid;
    if (mixer == 0 && FAST_GDN) return;
    if (mixer == 1 && FAST_HGRN) return;
    LAS float* ks = (LAS float*)F.lds;
    LAS float* qs = ks + 8192; LAS float* vs = qs + 8192; LAS float* ot = vs + 8192;
    LAS float* red1 = ot + 8192; LAS float* red2 = red1 + 512; LAS float* ab = red2 + 512;
    const float* KSRC = (const float*)(F.ws + (mixer ? O_FH : O_KF)); const float* QSRC = (const float*)(F.ws + (mixer ? O_QH : O_QF)); const float* VSRC = (const float*)(F.ws + O_VF);
    const bf16* P = (const bf16*)(F.ws + O_PROJ); const float* GB = (const float*)(F.ws + O_GB);
    bf16* O = (bf16*)(F.ws + O_O);
    const float* nw = mixer ? F.in[I_HNW] : F.in[I_GNW];
    const int e = tid & 127, qd = tid >> 7;
    float S[32];
#pragma unroll
    for (int i = 0; i < 32; ++i) S[i] = 0.f;
    for (int n = 0; n < 64; ++n) {
        const int t0 = b * SEQ + n * 64;
        for (int idx = tid; idx < 64 * 32; idx += 512) { const int r = idx >> 5, c4 = (idx & 31) * 4; const size_t go = (size_t)(t0 + r) * 1024 + h * 128 + c4;
            *(LAS f32x4*)(ks + r * 128 + c4) = *(const f32x4*)(KSRC + go); *(LAS f32x4*)(qs + r * 128 + c4) = *(const f32x4*)(QSRC + go);
            f32x4 vv; if (mixer) { const v2u w = *(const v2u*)(P + (size_t)(t0 + r) * NPROJ + PQ_BI + h * 128 + c4); vv = (f32x4){bflo(w.x), bfhi(w.x), bflo(w.y), bfhi(w.y)}; } else vv = *(const f32x4*)(VSRC + go);
            *(LAS f32x4*)(vs + r * 128 + c4) = vv; }
        if (tid < 64) { ab[tid * 2] = __expf(GB[(size_t)(t0 + tid) * 16 + 8 + h]); ab[tid * 2 + 1] = GB[(size_t)(t0 + tid) * 16 + h]; }
        __syncthreads();
        for (int r = 0; r < 64; ++r) {
            const LAS float* kr = ks + r * 128 + qd * 32; const LAS float* qr = qs + r * 128 + qd * 32; const float ve = vs[r * 128 + e];
            float osum = 0.f;
            if (mixer == 0) {
                const float a = ab[r * 2], bt = ab[r * 2 + 1];
                float p = 0.f;
#pragma unroll
                for (int i = 0; i < 32; ++i) p += kr[i] * S[i];
                red1[qd * 128 + e] = p;
                __syncthreads();
                const float kS = (red1[e] + red1[128 + e]) + (red1[256 + e] + red1[384 + e]);
                const float c1 = bt * (ve - a * kS);
#pragma unroll
                for (int i = 0; i < 32; ++i) { S[i] = a * S[i] + kr[i] * c1; osum += qr[i] * S[i]; }
            } else {
#pragma unroll
                for (int i = 0; i < 32; ++i) { const float f = kr[i]; S[i] = f * S[i] + (1.f - f) * ve; osum += qr[i] * S[i]; }
            }
            red2[qd * 128 + e] = osum;
            __syncthreads();
            if (tid < 128) ot[r * 128 + e] = (red2[e] + red2[128 + e]) + (red2[256 + e] + red2[384 + e]);
        }
        __syncthreads();
        {
            const int r = tid >> 3, c0 = (tid & 7) * 16; float o[16]; float ss = 0.f;
#pragma unroll
            for (int i = 0; i < 16; ++i) { o[i] = ot[r * 128 + c0 + i]; ss += o[i] * o[i]; }
            ss += __shfl_xor(ss, 1); ss += __shfl_xor(ss, 2); ss += __shfl_xor(ss, 4);
            const float rstd = rsqrtf(ss * (1.0f / 128.0f) + EPS);
            const bf16* zp = P + (size_t)(t0 + r) * NPROJ + (mixer ? PQ_BG : PQ_AZ) + h * 128 + c0;
            const v4u z0 = *(const v4u*)zp, z1 = *(const v4u*)(zp + 8);
            const unsigned zw[8] = {z0.x, z0.y, z0.z, z0.w, z1.x, z1.y, z1.z, z1.w};
            unsigned ow[8];
#pragma unroll
            for (int i = 0; i < 8; ++i) { const float za = bflo(zw[i]), zb = bfhi(zw[i]);
                ow[i] = pk2(o[2 * i] * rstd * nw[c0 + 2 * i] * siluf_(za), o[2 * i + 1] * rstd * nw[c0 + 2 * i + 1] * siluf_(zb)); }
            bf16* op = O + (size_t)(t0 + r) * D + mixer * 1024 + h * 128 + c0;
            *(v4u*)op = (v4u){ow[0], ow[1], ow[2], ow[3]}; *(v4u*)(op + 8) = (v4u){ow[4], ow[5], ow[6], ow[7]};
        }
        __syncthreads();
    }
}


constexpr int R_NW = 0, R_QD = 16384, R_QK = 32768, R_KDT = 40960, R_DEC = 57344;
__device__ __forceinline__ int frag_off(int row, int k, int nkb) { const int mt = row >> 4, kb = k >> 5, r = row & 15, k5 = k & 31, g = (k5 >> 2) & 3, j = (k5 >> 4) * 4 + (k5 & 3); return ((mt * nkb + kb) * 64 + g * 16 + r) * 16 + j * 2; }
__device__ __forceinline__ bf16x8 pack8(const f32x4 a, const f32x4 b) { v4u w; w.x = pk2(a[0], a[1]); w.y = pk2(a[2], a[3]); w.z = pk2(b[0], b[1]); w.w = pk2(b[2], b[3]); return __builtin_bit_cast(bf16x8, w); }
#define SBAR() do { asm volatile("s_waitcnt lgkmcnt(0)" ::: "memory"); __builtin_amdgcn_s_barrier(); asm volatile("" ::: "memory"); } while (0)

__device__ __forceinline__ void store_frag_row16(unsigned char* base, int row, int cb, int nkb, const float (&x)[16]) {
#pragma unroll
    for (int a = 0; a < 4; ++a) { v2u w; w.x = pk2(x[4 * a], x[4 * a + 1]); w.y = pk2(x[4 * a + 2], x[4 * a + 3]); *(v2u*)(base + frag_off(row, cb * 16 + 4 * a, nkb)) = w; }
}

__device__ __forceinline__ void gdn_prep_unit(const Frame& F, int b, int h, int n) {
    const int tid = F.tid, lane = F.lane, wave = F.wave, r = tid >> 3, cb = tid & 7, t0 = b * SEQ + n * 64, seq = b * 8 + h;
    LAS bf16* KB = (LAS bf16*)F.lds;
    LAS bf16* QB = (LAS bf16*)(F.lds + 17408);
    LAS float* LM = (LAS float*)(F.lds + 34816);
    LAS float* RHS = (LAS float*)(F.lds + 52224);
    LAS float* GC = (LAS float*)(F.lds + 117760);
    const bf16* P = (const bf16*)(F.ws + O_PROJ); const float* GB = (const float*)(F.ws + O_GB); const float* cw = F.in[I_GCONV];
    unsigned char* rec = F.ws + O_OPS + ((size_t)seq * 64 + n) * REC_BYTES; float* UT = (float*)(F.ws + O_UT) + ((size_t)seq * 64 + n) * 8192;
    float q[16], k[16], v[16];
    {
        const int s = n * 64 + r;
#pragma unroll
        for (int mat = 0; mat < 3; ++mat) { float a[16];
#pragma unroll
            for (int i = 0; i < 16; ++i) a[i] = 0.f;
#pragma unroll
            for (int j = 0; j < 4; ++j) { if (s - 3 + j >= 0) { const bf16* pp = P + (size_t)(t0 + r - 3 + j) * NPROJ + mat * 1024 + h * 128 + cb * 16; const v4u w0 = *(const v4u*)pp, w1 = *(const v4u*)(pp + 8);
                    const float* cp = cw + j * 3072 + mat * 1024 + h * 128 + cb * 16; const f32x4 c0 = *(const f32x4*)cp, c1 = *(const f32x4*)(cp + 4), c2 = *(const f32x4*)(cp + 8), c3 = *(const f32x4*)(cp + 12);
                    a[0] += c0.x * bflo(w0.x); a[1] += c0.y * bfhi(w0.x); a[2] += c0.z * bflo(w0.y); a[3] += c0.w * bfhi(w0.y); a[4] += c1.x * bflo(w0.z); a[5] += c1.y * bfhi(w0.z); a[6] += c1.z * bflo(w0.w); a[7] += c1.w * bfhi(w0.w);
                    a[8] += c2.x * bflo(w1.x); a[9] += c2.y * bfhi(w1.x); a[10] += c2.z * bflo(w1.y); a[11] += c2.w * bfhi(w1.y); a[12] += c3.x * bflo(w1.z); a[13] += c3.y * bfhi(w1.z); a[14] += c3.z * bflo(w1.w); a[15] += c3.w * bfhi(w1.w); } }
#pragma unroll
            for (int i = 0; i < 16; ++i) { const float y = siluf_(a[i]); if (mat == 0) q[i] = y; else if (mat == 1) k[i] = y; else v[i] = y; } }
        float qs = 0.f, ks = 0.f;
#pragma unroll
        for (int i = 0; i < 16; ++i) { qs += q[i] * q[i]; ks += k[i] * k[i]; }
        qs += __shfl_xor(qs, 1); qs += __shfl_xor(qs, 2); qs += __shfl_xor(qs, 4); ks += __shfl_xor(ks, 1); ks += __shfl_xor(ks, 2); ks += __shfl_xor(ks, 4);
        const float qn = rsqrtf(qs + EPS) * 0.08838834764831845f, kn = rsqrtf(ks + EPS);
#pragma unroll
        for (int i = 0; i < 16; ++i) { q[i] *= qn; k[i] *= kn; }
        if (cb == 0) { GC[64 + r] = GB[(size_t)(t0 + r) * 16 + h]; GC[128 + r] = GB[(size_t)(t0 + r) * 16 + 8 + h]; }
        v4u w0, w1; w0.x = pk2(k[0], k[1]); w0.y = pk2(k[2], k[3]); w0.z = pk2(k[4], k[5]); w0.w = pk2(k[6], k[7]); w1.x = pk2(k[8], k[9]); w1.y = pk2(k[10], k[11]); w1.z = pk2(k[12], k[13]); w1.w = pk2(k[14], k[15]);
        *(LAS v4u*)(KB + r * 136 + cb * 16) = w0; *(LAS v4u*)(KB + r * 136 + cb * 16 + 8) = w1;
        w0.x = pk2(q[0], q[1]); w0.y = pk2(q[2], q[3]); w0.z = pk2(q[4], q[5]); w0.w = pk2(q[6], q[7]); w1.x = pk2(q[8], q[9]); w1.y = pk2(q[10], q[11]); w1.z = pk2(q[12], q[13]); w1.w = pk2(q[14], q[15]);
        *(LAS v4u*)(QB + r * 136 + cb * 16) = w0; *(LAS v4u*)(QB + r * 136 + cb * 16 + 8) = w1;
    }
    __syncthreads();
    if (wave == 0) { float x = GC[128 + lane];
#pragma unroll
        for (int o = 1; o < 64; o <<= 1) { const float y = __shfl_up(x, o); if (lane >= o) x += y; }
        GC[lane] = x; }
    __syncthreads();
    const float gcr = GC[r], betar = GC[64 + r], egr = __expf(gcr), gclast = GC[63];
    {
#pragma unroll
        for (int a = 0; a < 4; ++a) { *(LAS f32x4*)(RHS + r * 256 + cb * 16 + 4 * a) = (f32x4){v[4 * a] * betar, v[4 * a + 1] * betar, v[4 * a + 2] * betar, v[4 * a + 3] * betar};
            const float kb_ = betar * egr; *(LAS f32x4*)(RHS + r * 256 + 128 + cb * 16 + 4 * a) = (f32x4){k[4 * a] * kb_, k[4 * a + 1] * kb_, k[4 * a + 2] * kb_, k[4 * a + 3] * kb_}; }
        float qd[16];
#pragma unroll
        for (int i = 0; i < 16; ++i) qd[i] = q[i] * egr;
        store_frag_row16(rec + R_QD, r, cb, 4, qd);
    }
    {
        const int mat = wave >> 2, mt = wave & 3, fr = lane & 15, g = lane >> 4; const LAS bf16* AB = mat ? QB : KB;
        bf16x8 af[4];
#pragma unroll
        for (int kb = 0; kb < 4; ++kb) af[kb] = *(const LAS bf16x8*)(AB + (mt * 16 + fr) * 136 + kb * 32 + 8 * g);
#pragma unroll
        for (int nt = 0; nt < 4; ++nt) { f32x4 acc = (f32x4){0.f, 0.f, 0.f, 0.f};
            if (nt <= mt) {
#pragma unroll
                for (int kb = 0; kb < 4; ++kb) { const bf16x8 bfr = *(const LAS bf16x8*)(KB + (nt * 16 + fr) * 136 + kb * 32 + 8 * g); acc = __builtin_amdgcn_mfma_f32_16x16x32_bf16(af[kb], bfr, acc, 0, 0, 0); } }
            const int sc = nt * 16 + fr; const float gcs = GC[sc];
#pragma unroll
            for (int i = 0; i < 4; ++i) { const int c = mt * 16 + 4 * g + i; const float dcy = __expf(GC[c] - gcs);
                if (mat == 0) { if (nt <= mt) LM[c * 68 + sc] = (sc < c) ? GC[64 + c] * acc[i] * dcy : 0.f; }
                else *(bf16*)(rec + R_QK + frag_off(c, sc, 2)) = (bf16)f2bf((sc <= c && nt <= mt) ? acc[i] * dcy : 0.f); } }
    }
    __syncthreads();
    if (tid < 256) {
        float x[64];
#pragma unroll
        for (int i = 0; i < 64; ++i) { float acc = RHS[i * 256 + tid];
#pragma unroll
            for (int j4 = 0; j4 < (i + 3) / 4; ++j4) { const f32x4 l4 = *(const LAS f32x4*)(LM + i * 68 + 4 * j4);
#pragma unroll
                for (int e = 0; e < 4; ++e) if (4 * j4 + e < i) acc -= l4[e] * x[4 * j4 + e]; }
            x[i] = acc; }
#pragma unroll
        for (int i = 0; i < 64; ++i) RHS[i * 256 + tid] = x[i];
    } else {
        const int tt = tid - 256, d = tt >> 1, half = tt & 1;
#pragma unroll
        for (int cq = 0; cq < 8; ++cq) { float y[4];
#pragma unroll
            for (int e = 0; e < 4; ++e) { const int c = 32 * half + 4 * cq + e; y[e] = bf2f(KB[c * 136 + d]) * __expf(gclast - GC[c]); }
            v2u w; w.x = pk2(y[0], y[1]); w.y = pk2(y[2], y[3]); *(v2u*)(rec + R_KDT + frag_off(d, 32 * half + 4 * cq, 2)) = w; }
        if (tt < 128) ((float*)(rec + R_DEC))[tt] = __expf(gclast);
    }
    __syncthreads();
    {
        const int dv = tid >> 2, cq = (tid & 3) * 16;
#pragma unroll
        for (int a = 0; a < 4; ++a) { f32x4 o;
#pragma unroll
            for (int e = 0; e < 4; ++e) o[e] = RHS[(cq + 4 * a + e) * 256 + dv];
            *(f32x4*)(UT + dv * 64 + cq + 4 * a) = o; }
        float nw[16];
#pragma unroll
        for (int a = 0; a < 4; ++a) { const f32x4 t4 = *(const LAS f32x4*)(RHS + r * 256 + 128 + cb * 16 + 4 * a); nw[4 * a] = -t4.x; nw[4 * a + 1] = -t4.y; nw[4 * a + 2] = -t4.z; nw[4 * a + 3] = -t4.w; }
        store_frag_row16(rec + R_NW, r, cb, 4, nw);
    }
    __syncthreads();
}

__device__ __forceinline__ void hgrn_prep_unit(const Frame& F, int b, int h, int n) {
    const int tid = F.tid, lane = F.lane, wave = F.wave, r = tid >> 3, cb = tid & 7, t0 = b * SEQ + n * 64, seq = 16 + b * 8 + h;
    LAS float* LF = (LAS float*)F.lds;
    LAS bf16* QB = (LAS bf16*)(F.lds + 32768);
    LAS bf16* KB = (LAS bf16*)(F.lds + 50176);
    LAS bf16* KD = (LAS bf16*)(F.lds + 67584);
    LAS float* VT = (LAS float*)(F.lds + 84992);
    const bf16* P = (const bf16*)(F.ws + O_PROJ); const float* lbl = F.in[I_LBL];
    unsigned char* rec = F.ws + O_OPS + ((size_t)seq * 64 + n) * REC_BYTES; float* UT = (float*)(F.ws + O_UT) + ((size_t)seq * 64 + n) * 8192;
    float q[16], kk[16], lf[16];
    {
        const bf16* pq = P + (size_t)(t0 + r) * NPROJ + PQ_BQ + h * 128 + cb * 16; const bf16* pf = P + (size_t)(t0 + r) * NPROJ + PQ_BF + h * 128 + cb * 16; const bf16* pi = P + (size_t)(t0 + r) * NPROJ + PQ_BI + h * 128 + cb * 16;
        const v4u q0 = *(const v4u*)pq, q1 = *(const v4u*)(pq + 8), f0 = *(const v4u*)pf, f1 = *(const v4u*)(pf + 8), i0 = *(const v4u*)pi, i1 = *(const v4u*)(pi + 8);
        const unsigned qw[8] = {q0.x, q0.y, q0.z, q0.w, q1.x, q1.y, q1.z, q1.w}, fw[8] = {f0.x, f0.y, f0.z, f0.w, f1.x, f1.y, f1.z, f1.w}, iw[8] = {i0.x, i0.y, i0.z, i0.w, i1.x, i1.y, i1.z, i1.w};
#pragma unroll
        for (int i = 0; i < 16; ++i) { const int d = h * 128 + cb * 16 + i; const float lb = sigmoidf_(lbl[d] - lbl[1024 + d]);
            const float fl = (i & 1) ? bfhi(fw[i >> 1]) : bflo(fw[i >> 1]), ql = (i & 1) ? bfhi(qw[i >> 1]) : bflo(qw[i >> 1]), vl = (i & 1) ? bfhi(iw[i >> 1]) : bflo(iw[i >> 1]);
            const float fg = lb + (1.f - lb) * sigmoidf_(fl); lf[i] = __logf(fg); kk[i] = 1.f - fg; q[i] = siluf_(ql) * 0.08838834764831845f;
            VT[(cb * 16 + i) * 65 + r] = vl; }
#pragma unroll
        for (int a = 0; a < 4; ++a) *(LAS f32x4*)(LF + r * 128 + cb * 16 + 4 * a) = (f32x4){lf[4 * a], lf[4 * a + 1], lf[4 * a + 2], lf[4 * a + 3]};
    }
    __syncthreads();
    {
        const int d = tid & 127, qr = tid >> 7; float run = 0.f;
#pragma unroll
        for (int i = 0; i < 16; ++i) { run += LF[(16 * qr + i) * 128 + d]; LF[(16 * qr + i) * 128 + d] = run; }
    }
    __syncthreads();
    {
        float bb[16], bref[16], blast[16];
#pragma unroll
        for (int a = 0; a < 4; ++a) { const int co = cb * 16 + 4 * a;
            const f32x4 t15 = *(const LAS f32x4*)(LF + 15 * 128 + co), t31 = *(const LAS f32x4*)(LF + 31 * 128 + co), t47 = *(const LAS f32x4*)(LF + 47 * 128 + co), t63 = *(const LAS f32x4*)(LF + 63 * 128 + co), tr = *(const LAS f32x4*)(LF + r * 128 + co);
            const int qr = r >> 4;
#pragma unroll
            for (int e = 0; e < 4; ++e) { float off = 0.f; if (qr > 0) off += t15[e]; if (qr > 1) off += t31[e]; if (qr > 2) off += t47[e];
                bb[4 * a + e] = tr[e] + off; bref[4 * a + e] = t15[e] + t31[e]; blast[4 * a + e] = (t15[e] + t31[e]) + (t47[e] + t63[e]); } }
        float qt[16], kt[16], kd[16], qd[16];
#pragma unroll
        for (int i = 0; i < 16; ++i) { qt[i] = q[i] * __expf(bb[i] - bref[i]); kt[i] = kk[i] * __expf(bref[i] - bb[i]); kd[i] = kk[i] * __expf(blast[i] - bb[i]); qd[i] = q[i] * __expf(bb[i]); }
        v4u w0, w1;
        w0.x = pk2(qt[0], qt[1]); w0.y = pk2(qt[2], qt[3]); w0.z = pk2(qt[4], qt[5]); w0.w = pk2(qt[6], qt[7]); w1.x = pk2(qt[8], qt[9]); w1.y = pk2(qt[10], qt[11]); w1.z = pk2(qt[12], qt[13]); w1.w = pk2(qt[14], qt[15]);
        *(LAS v4u*)(QB + r * 136 + cb * 16) = w0; *(LAS v4u*)(QB + r * 136 + cb * 16 + 8) = w1;
        w0.x = pk2(kt[0], kt[1]); w0.y = pk2(kt[2], kt[3]); w0.z = pk2(kt[4], kt[5]); w0.w = pk2(kt[6], kt[7]); w1.x = pk2(kt[8], kt[9]); w1.y = pk2(kt[10], kt[11]); w1.z = pk2(kt[12], kt[13]); w1.w = pk2(kt[14], kt[15]);
        *(LAS v4u*)(KB + r * 136 + cb * 16) = w0; *(LAS v4u*)(KB + r * 136 + cb * 16 + 8) = w1;
        w0.x = pk2(kd[0], kd[1]); w0.y = pk2(kd[2], kd[3]); w0.z = pk2(kd[4], kd[5]); w0.w = pk2(kd[6], kd[7]); w1.x = pk2(kd[8], kd[9]); w1.y = pk2(kd[10], kd[11]); w1.z = pk2(kd[12], kd[13]); w1.w = pk2(kd[14], kd[15]);
        *(LAS v4u*)(KD + r * 136 + cb * 16) = w0; *(LAS v4u*)(KD + r * 136 + cb * 16 + 8) = w1;
        store_frag_row16(rec + R_QD, r, cb, 4, qd);
        if (r == 63) {
#pragma unroll
            for (int a = 0; a < 4; ++a) *(f32x4*)((float*)(rec + R_DEC) + cb * 16 + 4 * a) = (f32x4){__expf(blast[4 * a]), __expf(blast[4 * a + 1]), __expf(blast[4 * a + 2]), __expf(blast[4 * a + 3])}; }
    }
    __syncthreads();
    {
        const int mt = wave >> 1, fr = lane & 15, g = lane >> 4;
        bf16x8 af[4];
#pragma unroll
        for (int kb = 0; kb < 4; ++kb) af[kb] = *(const LAS bf16x8*)(QB + (mt * 16 + fr) * 136 + kb * 32 + 8 * g);
#pragma unroll
        for (int nn = 0; nn < 2; ++nn) { const int nt = 2 * (wave & 1) + nn; f32x4 acc = (f32x4){0.f, 0.f, 0.f, 0.f};
            if (nt <= mt) {
#pragma unroll
                for (int kb = 0; kb < 4; ++kb) { const bf16x8 bfr = *(const LAS bf16x8*)(KB + (nt * 16 + fr) * 136 + kb * 32 + 8 * g); acc = __builtin_amdgcn_mfma_f32_16x16x32_bf16(af[kb], bfr, acc, 0, 0, 0); } }
            const int sc = nt * 16 + fr;
#pragma unroll
            for (int i = 0; i < 4; ++i) { const int c = mt * 16 + 4 * g + i; *(bf16*)(rec + R_QK + frag_off(c, sc, 2)) = (bf16)f2bf((sc <= c && nt <= mt) ? acc[i] : 0.f); } }
        const int d = tid >> 2, cp = tid & 3;
#pragma unroll
        for (int a = 0; a < 4; ++a) { float y[4];
#pragma unroll
            for (int e = 0; e < 4; ++e) y[e] = bf2f(KD[(16 * cp + 4 * a + e) * 136 + d]);
            v2u w; w.x = pk2(y[0], y[1]); w.y = pk2(y[2], y[3]); *(v2u*)(rec + R_KDT + frag_off(d, 16 * cp + 4 * a, 2)) = w;
            f32x4 o;
#pragma unroll
            for (int e = 0; e < 4; ++e) o[e] = VT[d * 65 + 16 * cp + 4 * a + e];
            *(f32x4*)(UT + d * 64 + 16 * cp + 4 * a) = o; }
    }
    __syncthreads();
}

__device__ __forceinline__ void phase_mix_prep(const Frame& F) {
    for (int u = F.blk; u < 2048; u += F.G) { const int mixer = u & 1, rest = u >> 1, n = rest & 63, h = (rest >> 6) & 7, b = rest >> 9;
        if (mixer == 0) { if (FAST_GDN) gdn_prep_unit(F, b, h, n); } else { if (FAST_HGRN) hgrn_prep_unit(F, b, h, n); } }
}

__device__ __forceinline__ void phase_mix_scan(const Frame& F) {
    if (F.blk >= 32) return;
    const int seq = F.blk, mixer = seq >> 4, b = (seq >> 3) & 1, h = seq & 7, tid = F.tid, lane = F.lane, w = F.wave, n16 = lane & 15, g = lane >> 4;
    if (mixer == 0 && !FAST_GDN) return;
    if (mixer == 1 && !FAST_HGRN) return;
    LAS unsigned char* buf0 = F.lds; LAS unsigned char* buf1 = F.lds + REC_BYTES; LAS float* OT = (LAS float*)(F.lds + 2 * REC_BYTES);
    const unsigned char* rec = F.ws + O_OPS + (size_t)seq * 64 * REC_BYTES; const float* UTb = (const float*)(F.ws + O_UT) + (size_t)seq * 64 * 8192;
    const bf16* P = (const bf16*)(F.ws + O_PROJ); bf16* O = (bf16*)(F.ws + O_O); const float* nwp = mixer ? F.in[I_HNW] : F.in[I_GNW];
    const int er = tid >> 3, ec0 = (tid & 7) * 16, zcol = (mixer ? PQ_BG : PQ_AZ) + h * 128 + ec0;
    float nw[16];
#pragma unroll
    for (int i = 0; i < 16; ++i) nw[i] = nwp[ec0 + i];
    const int kb0 = mixer ? 16 : 0, nkb = mixer ? 5 : 7;
#define SCAN_ISSUE(st_, buf_) do { const unsigned char* rs_ = rec + (size_t)(st_) * REC_BYTES; \
        for (int i_ = 0; i_ < nkb; ++i_) { const int p_ = kb0 + w + 8 * i_; __builtin_amdgcn_global_load_lds((const unsigned*)(rs_ + p_ * 1024 + lane * 16), (LAS unsigned*)((buf_) + p_ * 1024), 16, 0, 0); } \
        if (w == 0) { __builtin_amdgcn_global_load_lds((const unsigned*)(rs_ + R_DEC + lane * 4), (LAS unsigned*)((buf_) + R_DEC), 4, 0, 0); \
                      __builtin_amdgcn_global_load_lds((const unsigned*)(rs_ + R_DEC + 256 + lane * 4), (LAS unsigned*)((buf_) + R_DEC + 256), 4, 0, 0); } } while (0)
    f32x4 Sacc[8]; bf16x8 Sb[4];
#pragma unroll
    for (int i = 0; i < 8; ++i) Sacc[i] = (f32x4){0.f, 0.f, 0.f, 0.f};
#pragma unroll
    for (int i = 0; i < 4; ++i) Sb[i] = (bf16x8){0, 0, 0, 0, 0, 0, 0, 0};
    SCAN_ISSUE(0, buf0);
    f32x4 Un[4];
#pragma unroll
    for (int mt = 0; mt < 4; ++mt) Un[mt] = *(const f32x4*)(UTb + (16 * w + n16) * 64 + 16 * mt + 4 * g);
    for (int st = 0; st < 64; ++st) {
        LAS unsigned char* cur = (st & 1) ? buf1 : buf0; LAS unsigned char* nxt = (st & 1) ? buf0 : buf1;
        asm volatile("s_waitcnt vmcnt(0)" ::: "memory"); SBAR();
        f32x4 U[4];
#pragma unroll
        for (int mt = 0; mt < 4; ++mt) U[mt] = Un[mt];
        if (st + 1 < 64) { SCAN_ISSUE(st + 1, nxt);
#pragma unroll
            for (int mt = 0; mt < 4; ++mt) Un[mt] = *(const f32x4*)(UTb + (size_t)(st + 1) * 8192 + (16 * w + n16) * 64 + 16 * mt + 4 * g); }
        const int t0 = b * SEQ + st * 64;
        const bf16* zp = P + (size_t)(t0 + er) * NPROJ + zcol; const v4u z0 = *(const v4u*)zp, z1 = *(const v4u*)(zp + 8);
#define AFR(base_, idx_) (*(const LAS bf16x8*)(cur + (base_) + (idx_) * 1024 + lane * 16))
        f32x4 vn[4];
#pragma unroll
        for (int mt = 0; mt < 4; ++mt) { vn[mt] = U[mt];
            if (mixer == 0) {
#pragma unroll
                for (int kb = 0; kb < 4; ++kb) vn[mt] = __builtin_amdgcn_mfma_f32_16x16x32_bf16(AFR(R_NW, mt * 4 + kb), Sb[kb], vn[mt], 0, 0, 0); } }
        bf16x8 Vb[2]; Vb[0] = pack8(vn[0], vn[1]); Vb[1] = pack8(vn[2], vn[3]);
        f32x4 o[4];
#pragma unroll
        for (int mt = 0; mt < 4; ++mt) { o[mt] = (f32x4){0.f, 0.f, 0.f, 0.f};
#pragma unroll
            for (int kb = 0; kb < 4; ++kb) o[mt] = __builtin_amdgcn_mfma_f32_16x16x32_bf16(AFR(R_QD, mt * 4 + kb), Sb[kb], o[mt], 0, 0, 0);
#pragma unroll
            for (int q2 = 0; q2 < 2; ++q2) o[mt] = __builtin_amdgcn_mfma_f32_16x16x32_bf16(AFR(R_QK, mt * 2 + q2), Vb[q2], o[mt], 0, 0, 0); }
#pragma unroll
        for (int m8 = 0; m8 < 8; ++m8) { const f32x4 dec = *(const LAS f32x4*)(cur + R_DEC + (16 * m8 + 4 * g) * 4); Sacc[m8] = Sacc[m8] * dec;
#pragma unroll
            for (int q2 = 0; q2 < 2; ++q2) Sacc[m8] = __builtin_amdgcn_mfma_f32_16x16x32_bf16(AFR(R_KDT, m8 * 2 + q2), Vb[q2], Sacc[m8], 0, 0, 0); }
#pragma unroll
        for (int kb = 0; kb < 4; ++kb) Sb[kb] = pack8(Sacc[2 * kb], Sacc[2 * kb + 1]);
#pragma unroll
        for (int mt = 0; mt < 4; ++mt)
#pragma unroll
            for (int i = 0; i < 4; ++i) OT[(16 * mt + 4 * g + i) * 132 + 16 * w + n16] = o[mt][i];
        SBAR();
        {
            float ov[16]; float ss = 0.f;
#pragma unroll
            for (int a = 0; a < 4; ++a) { const f32x4 t4 = *(const LAS f32x4*)(OT + er * 132 + ec0 + 4 * a); ov[4 * a] = t4.x; ov[4 * a + 1] = t4.y; ov[4 * a + 2] = t4.z; ov[4 * a + 3] = t4.w; ss += (t4.x * t4.x + t4.y * t4.y) + (t4.z * t4.z + t4.w * t4.w); }
            ss += __shfl_xor(ss, 1); ss += __shfl_xor(ss, 2); ss += __shfl_xor(ss, 4);
            const float rstd = rsqrtf(ss * (1.0f / 128.0f) + EPS);
            const unsigned zw[8] = {z0.x, z0.y, z0.z, z0.w, z1.x, z1.y, z1.z, z1.w}; unsigned ow[8];
#pragma unroll
            for (int i = 0; i < 8; ++i) ow[i] = pk2(ov[2 * i] * rstd * nw[2 * i] * siluf_(bflo(zw[i])), ov[2 * i + 1] * rstd * nw[2 * i + 1] * siluf_(bfhi(zw[i])));
            bf16* op = O + (size_t)(t0 + er) * D + mixer * 1024 + h * 128 + ec0;
            *(v4u*)op = (v4u){ow[0], ow[1], ow[2], ow[3]}; *(v4u*)(op + 8) = (v4u){ow[4], ow[5], ow[6], ow[7]};
        }
    }
    asm volatile("s_waitcnt vmcnt(0)" ::: "memory"); SBAR();
#undef AFR
#undef SCAN_ISSUE
}

__device__ __forceinline__ void phase_lru_conv(const Frame& F) {
    const bf16* XBR = (const bf16*)(F.ws + O_XBR); bf16* XC = (bf16*)(F.ws + O_XC);
    const float* cw = F.in[I_RGCW]; const float* cb = F.in[I_RGCB];
    for (int idx = F.blk * 512 + F.tid; idx < T * 256; idx += F.G * 512) {
        const int t = idx >> 8, c0 = (idx & 255) * 8, s = t & (SEQ - 1);
        float a[8];
        { const f32x4 b0 = *(const f32x4*)(cb + c0), b1 = *(const f32x4*)(cb + c0 + 4); a[0] = b0.x; a[1] = b0.y; a[2] = b0.z; a[3] = b0.w; a[4] = b1.x; a[5] = b1.y; a[6] = b1.z; a[7] = b1.w; }
#pragma unroll
        for (int j = 0; j < 4; ++j) { if (s - 3 + j >= 0) { const v4u w = *(const v4u*)(XBR + (size_t)(t - 3 + j) * D + c0);
                const f32x4 k0 = *(const f32x4*)(cw + j * D + c0), k1 = *(const f32x4*)(cw + j * D + c0 + 4);
                a[0] += k0.x * bflo(w.x); a[1] += k0.y * bfhi(w.x); a[2] += k0.z * bflo(w.y); a[3] += k0.w * bfhi(w.y);
                a[4] += k1.x * bflo(w.z); a[5] += k1.y * bfhi(w.z); a[6] += k1.z * bflo(w.w); a[7] += k1.w * bfhi(w.w); } }
        *(v4u*)(XC + (size_t)t * D + c0) = (v4u){pk2(a[0], a[1]), pk2(a[2], a[3]), pk2(a[4], a[5]), pk2(a[6], a[7])};
    }
}
__device__ __forceinline__ void phase_lru_scan1(const Frame& F) {
    const float* AA = (const float*)(F.ws + O_AA); const float* BB = (const float*)(F.ws + O_BB);
    float* SA = (float*)(F.ws + O_SUMA); float* SB = (float*)(F.ws + O_SUMB);
    for (int gid = F.blk * 512 + F.tid; gid < 2 * 32 * D; gid += F.G * 512) {
        const int ch = gid & 2047, chunk = (gid >> 11) & 31, b = gid >> 16; const size_t base = (size_t)(b * SEQ + chunk * 128) * D + ch;
        float hh = 0.f, pp = 1.f;
#pragma unroll 8
        for (int i = 0; i < 128; ++i) { const float a = AA[base + (size_t)i * D], bb = BB[base + (size_t)i * D]; hh = a * hh + bb; pp *= a; }
        SA[gid] = pp; SB[gid] = hh;
    }
}
__device__ __forceinline__ void phase_lru_scan2(const Frame& F) {
    const float* AA = (const float*)(F.ws + O_AA); const float* BB = (const float*)(F.ws + O_BB);
    const float* SA = (const float*)(F.ws + O_SUMA); const float* SB = (const float*)(F.ws + O_SUMB);
    const bf16* Y = (const bf16*)(F.ws + O_Y); bf16* YH = (bf16*)(F.ws + O_YH);
    for (int gid = F.blk * 512 + F.tid; gid < 2 * 32 * D; gid += F.G * 512) {
        const int ch = gid & 2047, chunk = (gid >> 11) & 31, b = gid >> 16; const size_t base = (size_t)(b * SEQ + chunk * 128) * D + ch;
        float hh = 0.f;
        for (int c = 0; c < chunk; ++c) { const int g2 = (b * 32 + c) * D + ch; hh = SA[g2] * hh + SB[g2]; }
#pragma unroll 8
        for (int i = 0; i < 128; ++i) { const float a = AA[base + (size_t)i * D], bb = BB[base + (size_t)i * D]; hh = a * hh + bb;
            YH[base + (size_t)i * D] = (bf16)f2bf(bf2f(Y[base + (size_t)i * D]) * hh); }
    }
}

__device__ __forceinline__ void phase_route1(const Frame& F) {
    const int gw = F.blk * 8 + F.wave, ngw = F.G * 8, lane = F.lane;
    LAS float* rwt = (LAS float*)F.lds;
    LAS unsigned* cntL = (LAS unsigned*)(F.lds + 8 * 2052 * 4);
    const float* RW = F.in[I_ROUTER];
    for (int idx = F.tid; idx < D * 8; idx += 512) { const int e = idx & 7, i = idx >> 3; rwt[e * 2052 + i] = RW[idx]; }
    if (F.tid < 8) cntL[F.tid] = 0u;
    __syncthreads();
    const float* X3 = (const float*)(F.ws + O_X3); const float* nw = F.in[I_NORMW] + 3 * D;
    bf16* XN = (bf16*)(F.ws + O_XN); unsigned* TOKE = (unsigned*)(F.ws + O_TOKE); float* TOKG = (float*)(F.ws + O_TOKG);
    for (int m = gw; m < T; m += ngw) {
        f32x4 v[8]; rms_load(X3 + (size_t)m * D, nw, lane, v);
        row_store_bf16(XN + (size_t)m * D, lane, v);
        float v0 = -3.0e38f, v1 = -3.0e38f; int i0 = 0, i1 = 0;
#pragma unroll 1
        for (int e = 0; e < 8; ++e) { float a = 0.f;
#pragma unroll
            for (int j = 0; j < 8; ++j) { const f32x4 w = *(const LAS f32x4*)(rwt + e * 2052 + 4 * lane + 256 * j); a += (v[j].x * w.x + v[j].y * w.y) + (v[j].z * w.z + v[j].w * w.w); }
            a = wave_sum(a);
            if (a > v0) { v1 = v0; i1 = i0; v0 = a; i0 = e; } else if (a > v1) { v1 = a; i1 = e; } }
        if (lane == 0) { const float g0 = 1.0f / (1.0f + __expf(v1 - v0)); TOKE[m] = (unsigned)i0 | ((unsigned)i1 << 8); TOKG[2 * m] = g0; TOKG[2 * m + 1] = 1.0f - g0;
            lds_add(cntL + i0, 1u); lds_add(cntL + i1, 1u); }
    }
    __syncthreads();
    if (F.tid < 8) ((unsigned*)(F.ws + O_WCNT))[F.blk * 8 + F.tid] = cntL[F.tid];
}
__device__ __forceinline__ void phase_route2(const Frame& F) {
    LAS unsigned* tot = (LAS unsigned*)F.lds; LAS unsigned* pre = tot + 8; LAS unsigned* eoff = tot + 16; LAS unsigned* basep = tot + 32; LAS unsigned* lpos = tot + 64; LAS unsigned* ltok = tot + 128;
    const unsigned* WCNT = (const unsigned*)(F.ws + O_WCNT); const unsigned* TOKE = (const unsigned*)(F.ws + O_TOKE);
    if (F.tid < 16) tot[F.tid] = 0u;
    if (F.tid < 32) ltok[F.tid] = TOKE[F.blk * 8 + (F.tid & 7) + 2048 * (F.tid >> 3)];
    __syncthreads();
    for (int idx = F.tid; idx < F.G * 8; idx += 512) { const int w = idx >> 3, e = idx & 7; const unsigned v = WCNT[idx]; lds_add(tot + e, v); if (w < F.blk) lds_add(pre + e, v); }
    __syncthreads();
    if (F.tid == 0) {
        unsigned off = 0;
        for (int e = 0; e < 8; ++e) { eoff[e] = off; basep[e] = off + pre[e]; off += (tot[e] + 255u) & ~255u; }
        eoff[8] = off;
        for (int i = 0; i < 32; ++i) { const unsigned te = ltok[i]; const unsigned e0 = te & 255u, e1 = te >> 8;
            lpos[2 * i] = basep[e0]; basep[e0] += 1; lpos[2 * i + 1] = basep[e1]; basep[e1] += 1; }
    }
    __syncthreads();
    if (F.blk == 0 && F.tid < 9) ((unsigned*)(F.ws + O_EOFF))[F.tid] = eoff[F.tid];
    if (F.tid < 32) { const int m = F.blk * 8 + (F.tid & 7) + 2048 * (F.tid >> 3); ((unsigned*)(F.ws + O_POS))[2 * m] = lpos[2 * F.tid]; ((unsigned*)(F.ws + O_POS))[2 * m + 1] = lpos[2 * F.tid + 1]; }
    const bf16* XN = (const bf16*)(F.ws + O_XN); bf16* HS = (bf16*)(F.ws + O_HS);
    for (int k = 0; k < 4; ++k) { const int li = k * 8 + F.wave, m = F.blk * 8 + F.wave + 2048 * k; const v4u* src = (const v4u*)(XN + (size_t)m * D);
        v4u a[4];
#pragma unroll
        for (int j = 0; j < 4; ++j) a[j] = src[F.lane + 64 * j];
#pragma unroll
        for (int sl = 0; sl < 2; ++sl) { v4u* dst = (v4u*)(HS + (size_t)lpos[2 * li + sl] * D);
#pragma unroll
            for (int j = 0; j < 4; ++j) dst[F.lane + 64 * j] = a[j]; } }
    if (F.blk < 8) {
        const unsigned r0 = eoff[F.blk] + tot[F.blk], r1 = eoff[F.blk + 1];
        for (unsigned idx = r0 * 256 + F.tid; idx < r1 * 256; idx += 512) ((v4u*)HS)[idx] = (v4u){0u, 0u, 0u, 0u};
    }
    __syncthreads();
}
struct SchedMoe {
    int nN, G, c, nrt; long aT, bT, bE; unsigned eo[9];
    __device__ __forceinline__ bool next(int i, pg8::Unit& u) const {
        if (!pg8::std_order(i, G, c, nrt, nN, u.pm, u.pn)) return false;
        int e = 0;
#pragma unroll
        for (int k = 1; k < 8; ++k) e += ((unsigned)(u.pm * 256) >= eo[k]) ? 1 : 0;
        u.aoff = (long)u.pm * aT; u.boff = (long)e * bE + (long)u.pn * bT; return true;
    }
};
struct SchedGates {
    int G, c;
    __device__ __forceinline__ bool next(int i, pg8::Unit& u) const {
        if (!pg8::std_order(i, G, c, 32, 16, u.pm, u.pn)) return false;
        u.aoff = ((long)u.pm * 256 * D + (u.pn >> 1) * 256) * 2; u.boff = (long)u.pn * 256 * 256 * 2; return true;
    }
};
__device__ __forceinline__ void phase_combine(const Frame& F) {
    const int gw = F.blk * 8 + F.wave, ngw = F.G * 8, lane = F.lane;
    const float* X3 = (const float*)(F.ws + O_X3); const float* YM = (const float*)(F.ws + O_YM);
    const unsigned* POS = (const unsigned*)(F.ws + O_POS); const float* TOKG = (const float*)(F.ws + O_TOKG); const float* fnw = F.in[I_FNW];
    for (int m = gw; m < T; m += ngw) {
        const unsigned p0 = POS[2 * m], p1 = POS[2 * m + 1]; const float g0 = TOKG[2 * m], g1 = TOKG[2 * m + 1];
        f32x4 v[8]; float s = 0.f;
#pragma unroll
        for (int j = 0; j < 8; ++j) { const f32x4 x = ((const f32x4*)(X3 + (size_t)m * D))[lane + 64 * j], y0 = ((const f32x4*)(YM + (size_t)p0 * D))[lane + 64 * j], y1 = ((const f32x4*)(YM + (size_t)p1 * D))[lane + 64 * j];
            v[j] = x + g0 * y0 + g1 * y1; s += (v[j].x * v[j].x + v[j].y * v[j].y) + (v[j].z * v[j].z + v[j].w * v[j].w); }
        const float rstd = rsqrtf(wave_sum(s) * (1.0f / D) + EPS);
#pragma unroll
        for (int j = 0; j < 8; ++j) { const f32x4 w = ((const f32x4*)fnw)[lane + 64 * j]; ((f32x4*)(F.out + (size_t)m * D))[lane + 64 * j] = v[j] * rstd * w; }
    }
}

constexpr int NPHASES = 20;
struct Args { const float* in[25]; float* out; unsigned char* ws; int ph_lo, ph_hi; };
__global__ void __launch_bounds__(512, 2) mk_fwd(Args args) {
    extern __shared__ __attribute__((aligned(16))) unsigned char lds_raw[];
    Frame F;
    F.lds = (LAS unsigned char*)lds_raw;
    F.tid = threadIdx.x; F.lane = F.tid & 63; F.wave = __builtin_amdgcn_readfirstlane(F.tid >> 6); F.G = gridDim.x; F.blk = blockIdx.x;
    F.ws = args.ws; F.out = args.out;
#pragma unroll
    for (int i = 0; i < 25; ++i) F.in[i] = args.in[i];
    volatile LAS unsigned* MISC = (volatile LAS unsigned*)(F.lds + MISC_OFF);
    if (F.tid < 64) MISC[F.tid] = 0u;
    __syncthreads();
    const int lo = args.ph_lo, hi = args.ph_hi;
    XcdBarrier bar; bar.bar = (unsigned*)(F.ws + O_CTL) + CW_BAR; bar.x = 0; bar.st = nullptr;
    if (hi - lo > 1) bar = xcd_barrier_post((unsigned*)(F.ws + O_CTL) + CW_BAR, MISC + 8);
#ifdef ONLY_PHASE
#define IN(k) ((k) == ONLY_PHASE && lo <= (k) && (k) < hi)
#else
#define IN(k) (lo <= (k) && (k) < hi)
#endif
#define SEAM(k) do { if (IN(k) && IN((k) + 1)) xcd_barrier(bar); } while (0)
    unsigned char* ws = F.ws;
    bf16* XN = (bf16*)(ws + O_XN);

    if (IN(0)) { phase_prologue(F); } SEAM(0);
    if (IN(1)) {
        pg8::Gemm g{XN, (const bf16*)(ws + O_WMI), D, D, D}; pg8::SchedStd S{T / 256, NPROJ / 256, F.G, F.blk, (long)256 * D * 2, (long)256 * D * 2};
        pg8::EpiBf16 E{(bf16*)(ws + O_PROJ), NPROJ};
        pg8::gemm_phase(F.lds, g, S, E);
    } SEAM(1);
    if (IN(2)) { if (!(FAST_GDN && FAST_HGRN)) phase_mix_pre(F); if (FAST_GDN || FAST_HGRN) phase_mix_prep(F); } SEAM(2);
    if (IN(3)) { if (!(FAST_GDN && FAST_HGRN)) phase_mix_scan_slow(F); if (FAST_GDN || FAST_HGRN) phase_mix_scan(F); } SEAM(3);
    if (IN(4)) {
        pg8::Gemm g{(const bf16*)(ws + O_O), (const bf16*)(ws + O_WMO), D, D, D}; pg8::SchedStd S{T / 256, D / 256, F.G, F.blk, (long)256 * D * 2, (long)256 * D * 2};
        pg8::EpiResF32 E{F.in[I_X], (float*)(ws + O_X1), D};
        pg8::gemm_phase(F.lds, g, S, E);
    } SEAM(4);
    if (IN(5)) { phase_rms(F, (const float*)(ws + O_X1), F.in[I_NORMW] + D); } SEAM(5);
    if (IN(6)) {
        pg8::Gemm g{XN, (const bf16*)(ws + O_WFG), D, D, D}; pg8::SchedStd S{T / 256, 2 * FF / 256, F.G, F.blk, (long)256 * D * 2, (long)256 * D * 2};
        pg8::EpiSwiglu E{(bf16*)(ws + O_ACT), FF};
        pg8::gemm_phase(F.lds, g, S, E);
    } SEAM(6);
    if (IN(7)) {
        pg8::Gemm g{(const bf16*)(ws + O_ACT), (const bf16*)(ws + O_WFD), FF, FF, FF}; pg8::SchedStd S{T / 256, D / 256, F.G, F.blk, (long)256 * FF * 2, (long)256 * FF * 2};
        pg8::EpiResF32 E{(const float*)(ws + O_X1), (float*)(ws + O_X2), D};
        pg8::gemm_phase(F.lds, g, S, E);
    } SEAM(7);
    if (IN(8)) { phase_rms(F, (const float*)(ws + O_X2), F.in[I_NORMW] + 2 * D); } SEAM(8);
    if (IN(9)) {
        pg8::Gemm g{XN, (const bf16*)(ws + O_WRI), D, D, D}; pg8::SchedStd S{T / 256, 2 * D / 256, F.G, F.blk, (long)256 * D * 2, (long)256 * D * 2};
        pg8::EpiRgIn E{(bf16*)(ws + O_Y), (bf16*)(ws + O_XBR)};
        pg8::gemm_phase(F.lds, g, S, E);
    } SEAM(9);
    if (IN(10)) { phase_lru_conv(F); } SEAM(10);
    if (IN(11)) {
        pg8::Gemm g{(const bf16*)(ws + O_XC), (const bf16*)(ws + O_WRG), D, 256, 256}; SchedGates S{F.G, F.blk};
        pg8::EpiGates E{(const bf16*)(ws + O_XC), F.in[I_RGAB], F.in[I_RGXB], (const float*)(ws + O_SPL), (float*)(ws + O_AA), (float*)(ws + O_BB)};
        pg8::gemm_phase(F.lds, g, S, E);
    } SEAM(11);
    if (IN(12)) { phase_lru_scan1(F); } SEAM(12);
    if (IN(13)) { phase_lru_scan2(F); } SEAM(13);
    if (IN(14)) {
        pg8::Gemm g{(const bf16*)(ws + O_YH), (const bf16*)(ws + O_WRO), D, D, D}; pg8::SchedStd S{T / 256, D / 256, F.G, F.blk, (long)256 * D * 2, (long)256 * D * 2};
        pg8::EpiResF32 E{(const float*)(ws + O_X2), (float*)(ws + O_X3), D};
        pg8::gemm_phase(F.lds, g, S, E);
    } SEAM(14);
    if (IN(15)) { phase_route1(F); } SEAM(15);
    if (IN(16)) { phase_route2(F); } SEAM(16);
    if (IN(17)) {
        SchedMoe S; S.nN = 2 * FE / 256; S.G = F.G; S.c = F.blk; S.aT = (long)256 * D * 2; S.bT = (long)256 * D * 2; S.bE = (long)2 * FE * D * 2;
        const unsigned* eo = (const unsigned*)(ws + O_EOFF);
#pragma unroll
        for (int k = 0; k < 9; ++k) S.eo[k] = __builtin_amdgcn_readfirstlane(eo[k]);
        S.nrt = (int)(S.eo[8] >> 8);
        pg8::Gemm g{(const bf16*)(ws + O_HS), (const bf16*)(ws + O_WMG), D, D, D};
        pg8::EpiSwiglu E{(bf16*)(ws + O_ACTM), FE};
        pg8::gemm_phase(F.lds, g, S, E);
    } SEAM(17);
    if (IN(18)) {
        SchedMoe S; S.nN = D / 256; S.G = F.G; S.c = F.blk; S.aT = (long)256 * FE * 2; S.bT = (long)256 * FE * 2; S.bE = (long)D * FE * 2;
        const unsigned* eo = (const unsigned*)(ws + O_EOFF);
#pragma unroll
        for (int k = 0; k < 9; ++k) S.eo[k] = __builtin_amdgcn_readfirstlane(eo[k]);
        S.nrt = (int)(S.eo[8] >> 8);
        pg8::Gemm g{(const bf16*)(ws + O_ACTM), (const bf16*)(ws + O_WMD), FE, FE, FE};
        pg8::EpiResF32 E{nullptr, (float*)(ws + O_YM), D};
        pg8::gemm_phase(F.lds, g, S, E);
    } SEAM(18);
    if (IN(19)) { phase_combine(F); }
#undef IN
#undef SEAM
}

extern "C" void kernel_launch(void* const* d_in, const int* in_sizes, int n_in, void* d_out, int out_size, void* d_ws, size_t ws_size, hipStream_t stream) {
    static int grid = 0;
    if (grid == 0) {
        if (n_in != 25 || out_size != T * D || ws_size < WS_END) { fprintf(stderr, "kernel_launch: unexpected shapes (n_in %d out %d ws %zu need %zu)\n", n_in, out_size, ws_size, (size_t)WS_END); grid = -1; return; }
        int dev = 0, cus = 0, per_cu = 0;
        if (hipGetDevice(&dev) != hipSuccess || hipDeviceGetAttribute(&cus, hipDeviceAttributeMultiprocessorCount, dev) != hipSuccess) { grid = -1; return; }
        if (hipFuncSetAttribute((const void*)mk_fwd, hipFuncAttributeMaxDynamicSharedMemorySize, LDS_BYTES) != hipSuccess) { fprintf(stderr, "kernel_launch: hipFuncSetAttribute failed\n"); grid = -1; return; }
        if (hipOccupancyMaxActiveBlocksPerMultiprocessor(&per_cu, (const void*)mk_fwd, 512, LDS_BYTES) != hipSuccess || per_cu < 1) fprintf(stderr, "kernel_launch: occupancy query reports %d\n", per_cu);
        (void)hipGetLastError();
        grid = cus > 256 ? 256 : cus;
    }
    if (grid < 0) return;
    (void)hipMemsetAsync((char*)d_ws + O_CTL, 0, CTL_BYTES, stream);
    Args a{};
    for (int i = 0; i < 25; ++i) a.in[i] = (const float*)d_in[i];
    a.out = (float*)d_out; a.ws = (unsigned char*)d_ws;
#if MK_SPLIT
    for (int p = 0; p < NPHASES; ++p) { a.ph_lo = p; a.ph_hi = p + 1; hipLaunchKernelGGL(mk_fwd, dim3(grid), dim3(512), LDS_BYTES, stream, a); }
#else
    a.ph_lo = 0; a.ph_hi = NPHASES; hipLaunchKernelGGL(mk_fwd, dim3(grid), dim3(512), LDS_BYTES, stream, a);
#endif
}
```

```cpp
#include <hip/hip_runtime.h>
#include <cstdio>
#include <cstdint>

#ifndef MK_SPLIT
#define MK_SPLIT 0
#endif

#define REP_PHASE -1
#define REP_COUNT 2
#ifndef FAST_GDN
#define FAST_GDN 1
#endif
#ifndef FAST_HGRN
#define FAST_HGRN 1
#endif
#define GAS __attribute__((address_space(1)))
#define LAS __attribute__((address_space(3)))
typedef unsigned short bf16;
typedef unsigned v4u __attribute__((ext_vector_type(4)));
typedef unsigned v2u __attribute__((ext_vector_type(2)));
typedef float f32x4 __attribute__((ext_vector_type(4)));
typedef float f32x2 __attribute__((ext_vector_type(2)));
typedef short bf16x8 __attribute__((ext_vector_type(8)));
#define RLX_AGENT __ATOMIC_RELAXED, __HIP_MEMORY_SCOPE_AGENT
#define LDS_WAIT() asm volatile("s_waitcnt lgkmcnt(0)" ::: "memory")
#define VM_WAIT() asm volatile("s_waitcnt vmcnt(0)" ::: "memory")

__device__ __forceinline__ unsigned f2bf(float f) { unsigned u = __builtin_bit_cast(unsigned, f); return (u + 0x7fffu + ((u >> 16) & 1u)) >> 16; }
__device__ __forceinline__ unsigned pk2(float lo, float hi) { return f2bf(lo) | (f2bf(hi) << 16); }
__device__ __forceinline__ float bf2f(unsigned short b) { return __builtin_bit_cast(float, ((unsigned)b) << 16); }
__device__ __forceinline__ float bflo(unsigned w) { return __builtin_bit_cast(float, w << 16); }
__device__ __forceinline__ float bfhi(unsigned w) { return __builtin_bit_cast(float, w & 0xffff0000u); }
__device__ __forceinline__ float sigmoidf_(float x) { return 1.0f / (1.0f + __expf(-x)); }
__device__ __forceinline__ float siluf_(float x) { return x / (1.0f + __expf(-x)); }
__device__ __forceinline__ float softplusf_(float x) { return x > 20.f ? x : log1pf(__expf(x)); }
__device__ __forceinline__ void lds_add(LAS unsigned* p, unsigned v) { (void)__hip_atomic_fetch_add(p, v, __ATOMIC_RELAXED, __HIP_MEMORY_SCOPE_WORKGROUP); }
__device__ __forceinline__ float wave_sum(float v) {
#pragma unroll
    for (int o = 1; o < 64; o <<= 1) v += __shfl_xor(v, o);
    return v;
}

constexpr int T = 8192, D = 2048, SEQ = 4096, NPROJ = 8192, FF = 5632, FE = 7168, NE = 8;
constexpr int MIXLD = 8208;
constexpr int PQ_AQ = 0, PQ_AK = 1024, PQ_AV = 2048, PQ_AZ = 3072, PQ_BQ = 4096, PQ_BF = 5120, PQ_BI = 6144, PQ_BG = 7168;
constexpr float EPS = 1e-6f;
constexpr int MOE_ROWS = 16384 + 8 * 256;

constexpr size_t al256(size_t x) { return (x + 255) & ~(size_t)255; }
constexpr size_t O_CTL = 0, CTL_BYTES = 1u << 20;
constexpr size_t O_WMI = CTL_BYTES;
constexpr size_t O_WMO = O_WMI + (size_t)NPROJ * D * 2;
constexpr size_t O_WFG = O_WMO + (size_t)D * D * 2;
constexpr size_t O_WFD = O_WFG + (size_t)2 * FF * D * 2;
constexpr size_t O_WRI = O_WFD + (size_t)D * FF * 2;
constexpr size_t O_WRG = O_WRI + (size_t)2 * D * D * 2;
constexpr size_t O_WRO = O_WRG + (size_t)16 * 256 * 256 * 2;
constexpr size_t O_WMG = O_WRO + (size_t)D * D * 2;
constexpr size_t O_WMD = O_WMG + (size_t)NE * 2 * FE * D * 2;
constexpr size_t O_XN = O_WMD + (size_t)NE * D * FE * 2;
constexpr size_t O_PROJ = O_XN + (size_t)T * D * 2;
constexpr size_t O_GB = O_PROJ + (size_t)T * NPROJ * 2;
constexpr size_t O_O = O_GB + (size_t)T * 16 * 4;
constexpr size_t O_X1 = O_O + (size_t)T * D * 2;
constexpr size_t O_X2 = O_X1 + (size_t)T * D * 4;
constexpr size_t O_X3 = O_X2 + (size_t)T * D * 4;
constexpr size_t O_ACT = O_X3 + (size_t)T * D * 4;
constexpr size_t O_Y = O_ACT + (size_t)T * FF * 2;
constexpr size_t O_XBR = O_Y + (size_t)T * D * 2;
constexpr size_t O_XC = O_XBR + (size_t)T * D * 2;
constexpr size_t O_AA = O_XC + (size_t)T * D * 2;
constexpr size_t O_BB = O_AA + (size_t)T * D * 4;
constexpr size_t O_YH = O_BB + (size_t)T * D * 4;
constexpr size_t O_SUMA = O_YH + (size_t)T * D * 2;
constexpr size_t O_SUMB = O_SUMA + (size_t)2 * 32 * D * 4;
constexpr size_t O_TOKE = O_SUMB + (size_t)2 * 32 * D * 4;
constexpr size_t O_TOKG = O_TOKE + (size_t)T * 4;
constexpr size_t O_POS = O_TOKG + (size_t)T * 8;
constexpr size_t O_WCNT = O_POS + (size_t)T * 8;
constexpr size_t O_EOFF = O_WCNT + 256 * 8 * 4;
constexpr size_t O_SPL = al256(O_EOFF + 64);
constexpr size_t O_HS = O_SPL + 2048 * 4;
constexpr size_t O_ACTM = O_HS + (size_t)MOE_ROWS * D * 2;
constexpr size_t O_YM = O_ACTM + (size_t)MOE_ROWS * FE * 2;
constexpr size_t O_QF = O_YM + (size_t)MOE_ROWS * D * 4;
constexpr size_t O_KF = O_QF + (size_t)T * 1024 * 4;
constexpr size_t O_VF = O_KF + (size_t)T * 1024 * 4;
constexpr size_t O_FH = O_VF + (size_t)T * 1024 * 4;
constexpr size_t O_QH = O_FH + (size_t)T * 1024 * 4;
constexpr size_t REC_BYTES = 57856;
constexpr size_t O_OPS = al256(O_QH + (size_t)T * 1024 * 4);
constexpr size_t O_UT = O_OPS + (size_t)32 * 64 * REC_BYTES;
constexpr size_t WS_END = O_UT + (size_t)32 * 64 * 8192 * 4;

constexpr int CW_BAR = 4096, CW_Q = 64;

constexpr int LDS_BYTES = 155648;
constexpr int MISC_OFF = 155648 - 256;

namespace pg8 {
constexpr int BM = 256, BK = 64, HALF = 128, HTB = HALF * BK * 2, STAGE_BYTES = 8 * HTB, NXCD = 8, WGM = 8;
__host__ __device__ __forceinline__ int lds_byte(int r, int c) { const int st = (r >> 4) * 2 + (c >> 5), rr = r & 15, cc = c & 31, ob = rr * 64 + cc * 2; return st * 1024 + (ob ^ (((ob >> 9) & 1) << 5)); }
__host__ __device__ __forceinline__ void stage_rc(int b, int& R, int& C) { const int st = b / 1024, sb = b % 1024, swz = sb ^ (((sb >> 9) & 1) << 5); R = (st >> 1) * 16 + swz / 64; C = (st & 1) * 32 + (swz % 64) / 2; }
__host__ __device__ __forceinline__ int perm32(int rho) { const int n = rho >> 4, i = rho & 15; return 8 * (i >> 2) + 4 * n + (i & 3); }

struct Unit { int pm, pn; long aoff, boff; };
struct Gemm { const bf16* A; const bf16* Bt; int lda, ldb, K; };

__device__ __forceinline__ bool std_order(int i, int G, int c, int nM, int nN, int& pm, int& pn) {
    const int nwg = nM * nN; const long L = (long)i * G + c; if (L >= nwg) return false;
    int wgid = (int)L; { const int q = nwg / NXCD, r = nwg % NXCD, xcd = wgid % NXCD, off = wgid / NXCD; wgid = (xcd < r ? xcd * (q + 1) : r * (q + 1) + (xcd - r) * q) + off; }
    const int nig = WGM * nN, gid = wgid / nig, fm = gid * WGM, gsz = (nM - fm) < WGM ? (nM - fm) : WGM;
    pm = fm + ((wgid % nig) % gsz); pn = (wgid % nig) / gsz; return true;
}
struct SchedStd {
    int nM, nN, G, c; long aT, bT;
    __device__ __forceinline__ bool next(int i, Unit& u) const { if (!std_order(i, G, c, nM, nN, u.pm, u.pn)) return false; u.aoff = (long)u.pm * aT; u.boff = (long)u.pn * bT; return true; }
};

template <class Epi, class Sched>
__device__ __forceinline__ void gemm_phase(LAS unsigned char* lds, const Gemm g, const Sched& S, const Epi& E) {
    const int tid = threadIdx.x, wid = __builtin_amdgcn_readfirstlane(tid >> 6), lane = tid & 63, wr = wid >> 2, wc = wid & 3, fr = lane & 15, fq = lane >> 4;
    const int K = g.K, nt = K / BK;
    unsigned voffA[2], voffB[2];
#pragma unroll
    for (int i = 0; i < 2; ++i) { int R, C; stage_rc(tid * 16 + i * 8192, R, C); const int Rb = Epi::PERM ? ((R & ~31) + perm32(R & 31)) : R;
        voffA[i] = (unsigned)(R * g.lda + C) * 2u; voffB[i] = (unsigned)(Rb * g.ldb + C) * 2u; }
    const size_t kstep = (size_t)(BK * 2);
    const size_t hstepA = (size_t)HALF * g.lda * 2, hstepB = (size_t)HALF * g.ldb * 2;
    const unsigned ldsw = (unsigned)wid * 1024u;
    const int aoff = lds_byte(wr * 64 + fr, fq * 8), boff = lds_byte(wc * 32 + fr, fq * 8);
#define PG8_SA(b, h) (((b) * 2 + (h)) * HTB)
#define PG8_SB(b, h) ((4 + (b) * 2 + (h)) * HTB)
#define PG8_STAGE(bufoff, gbase, voff) do { _Pragma("unroll") for (int _i = 0; _i < 2; ++_i) \
        __builtin_amdgcn_global_load_lds((const unsigned*)((const char*)(gbase) + (voff)[_i]), (LAS unsigned*)(lds + (bufoff) + ldsw + _i * 8192), 16, 0, 0); } while (0)
#define PG8_LDA(dst, b, h) do { _Pragma("unroll") for (int m = 0; m < 4; ++m) _Pragma("unroll") for (int k = 0; k < 2; ++k) dst[m][k] = *(const LAS bf16x8*)(lds + PG8_SA(b, h) + aoff + m * 2048 + k * 1024); } while (0)
#define PG8_LDB(dst, b, h) do { _Pragma("unroll") for (int n = 0; n < 2; ++n) _Pragma("unroll") for (int k = 0; k < 2; ++k) dst[n][k] = *(const LAS bf16x8*)(lds + PG8_SB(b, h) + boff + n * 2048 + k * 1024); } while (0)
#define PG8_MMA(ai, bj, At, Bt) do { __builtin_amdgcn_s_setprio(1); _Pragma("unroll") for (int m = 0; m < 4; ++m) _Pragma("unroll") for (int n = 0; n < 2; ++n) _Pragma("unroll") for (int k = 0; k < 2; ++k) \
        acc[ai][bj][m][n] = __builtin_amdgcn_mfma_f32_16x16x32_bf16(Bt[n][k], At[m][k], acc[ai][bj][m][n], 0, 0, 0); __builtin_amdgcn_s_setprio(0); } while (0)
#define PG8_WAIT_V(n) asm volatile("s_waitcnt vmcnt(" #n ")" ::: "memory")
#define PG8_WAIT_L(n) asm volatile("s_waitcnt lgkmcnt(" #n ")" ::: "memory")
#define PG8_BAR __builtin_amdgcn_s_barrier()
#define PG8_SCHED __builtin_amdgcn_sched_barrier(0)
    Unit cur, nxt; int ui = 0;
    if (!S.next(0, cur)) return;
    f32x4 acc[2][2][4][2];
#pragma unroll
    for (int a = 0; a < 2; ++a)
#pragma unroll
        for (int b = 0; b < 2; ++b)
#pragma unroll
            for (int m = 0; m < 4; ++m)
#pragma unroll
                for (int n = 0; n < 2; ++n) acc[a][b][m][n] = (f32x4){0.f, 0.f, 0.f, 0.f};
    bf16x8 At[4][2], B0[2][2], B1[2][2];
    const char* cA = (const char*)g.A + cur.aoff; const char* cB = (const char*)g.Bt + cur.boff;
    PG8_STAGE(PG8_SB(0, 0), cB, voffB); PG8_STAGE(PG8_SB(0, 1), cB + hstepB, voffB); PG8_STAGE(PG8_SA(0, 0), cA, voffA); PG8_STAGE(PG8_SA(0, 1), cA + hstepA, voffA);
    if (wr == 1) PG8_BAR;
    PG8_WAIT_V(2); PG8_BAR;
    PG8_STAGE(PG8_SB(1, 0), cB + kstep, voffB); PG8_STAGE(PG8_SA(1, 0), cA + kstep, voffA); PG8_STAGE(PG8_SB(1, 1), cB + hstepB + kstep, voffB);
    PG8_WAIT_V(6); PG8_BAR;
    for (;;) {
        const bool has_next = S.next(ui + 1, nxt);
        const char* nA = has_next ? (const char*)g.A + nxt.aoff : cA; const char* nB = has_next ? (const char*)g.Bt + nxt.boff : cB;
#pragma unroll 1
        for (int t = 0; t < nt; t += 2) {
            const bool last = (t == nt - 2);
            const char* a1 = cA + (size_t)(t + 1) * kstep;
            const char* a2 = last ? nA : cA + (size_t)(t + 2) * kstep; const char* b2 = last ? nB : cB + (size_t)(t + 2) * kstep;
            const char* a3 = a2 + kstep; const char* b3 = b2 + kstep;
            PG8_LDB(B0, 0, 0); PG8_LDB(B1, 0, 1); PG8_SCHED; PG8_LDA(At, 0, 0); PG8_STAGE(PG8_SA(1, 1), a1 + hstepA, voffA);
            PG8_WAIT_V(8); PG8_WAIT_L(0); PG8_BAR; PG8_MMA(0, 0, At, B0); PG8_MMA(0, 1, At, B1); PG8_BAR; PG8_SCHED;
            PG8_LDA(At, 0, 1); PG8_STAGE(PG8_SB(0, 0), b2, voffB); PG8_STAGE(PG8_SB(0, 1), b2 + hstepB, voffB); PG8_STAGE(PG8_SA(0, 0), a2, voffA);
            PG8_WAIT_V(8); PG8_WAIT_L(0); PG8_BAR; PG8_MMA(1, 0, At, B0); PG8_MMA(1, 1, At, B1); PG8_BAR; PG8_SCHED;
            PG8_LDB(B0, 1, 0); PG8_LDB(B1, 1, 1); PG8_SCHED; PG8_LDA(At, 1, 0); PG8_STAGE(PG8_SA(0, 1), a2 + hstepA, voffA);
            PG8_WAIT_V(8); PG8_WAIT_L(0); PG8_BAR; PG8_MMA(0, 0, At, B0); PG8_MMA(0, 1, At, B1); PG8_BAR; PG8_SCHED;
            PG8_LDA(At, 1, 1); PG8_STAGE(PG8_SB(1, 0), b3, voffB); PG8_STAGE(PG8_SB(1, 1), b3 + hstepB, voffB); PG8_STAGE(PG8_SA(1, 0), a3, voffA);
            PG8_WAIT_V(8); PG8_WAIT_L(0); PG8_BAR; PG8_MMA(1, 0, At, B0); PG8_MMA(1, 1, At, B1); PG8_BAR; PG8_SCHED;
        }
        if (wr == 0) PG8_BAR;
        E(acc, cur, wr, wc, fr, fq);
        if (!has_next) break;
#pragma unroll
        for (int a = 0; a < 2; ++a)
#pragma unroll
            for (int b = 0; b < 2; ++b)
#pragma unroll
                for (int m = 0; m < 4; ++m)
#pragma unroll
                    for (int n = 0; n < 2; ++n) acc[a][b][m][n] = (f32x4){0.f, 0.f, 0.f, 0.f};
        cur = nxt; cA = nA; cB = nB; ++ui;
        if (wr == 1) PG8_BAR;
    }
    PG8_WAIT_V(0);
    PG8_BAR;
#undef PG8_SA
#undef PG8_SB
#undef PG8_STAGE
#undef PG8_LDA
#undef PG8_LDB
#undef PG8_MMA
#undef PG8_WAIT_V
#undef PG8_WAIT_L
#undef PG8_BAR
#undef PG8_SCHED
}

struct EpiBf16 {
    static constexpr bool PERM = true;
    bf16* O; int ldc;
    __device__ __forceinline__ void operator()(const f32x4 (&acc)[2][2][4][2], const Unit& u, int wr, int wc, int fr, int fq) const {
        const int row0 = u.pm * BM + wr * 64 + fr, col0 = u.pn * BM + wc * 32 + 8 * fq;
#pragma unroll
        for (int ai = 0; ai < 2; ++ai)
#pragma unroll
            for (int m = 0; m < 4; ++m) { bf16* rowp = O + (size_t)(row0 + ai * HALF + m * 16) * ldc + col0;
#pragma unroll
                for (int bj = 0; bj < 2; ++bj) { const f32x4 v0 = acc[ai][bj][m][0], v1 = acc[ai][bj][m][1];
                    v4u w; w.x = pk2(v0[0], v0[1]); w.y = pk2(v0[2], v0[3]); w.z = pk2(v1[0], v1[1]); w.w = pk2(v1[2], v1[3]);
                    *(v4u*)(rowp + bj * HALF) = w; } }
    }
};
struct EpiSwiglu {
    static constexpr bool PERM = true;
    bf16* O; int ldc;
    __device__ __forceinline__ void operator()(const f32x4 (&acc)[2][2][4][2], const Unit& u, int wr, int wc, int fr, int fq) const {
        const int row0 = u.pm * BM + wr * 64 + fr, col0 = u.pn * HALF + wc * 32 + 8 * fq;
#pragma unroll
        for (int ai = 0; ai < 2; ++ai)
#pragma unroll
            for (int m = 0; m < 4; ++m) { bf16* rowp = O + (size_t)(row0 + ai * HALF + m * 16) * ldc + col0;
                float o[8];
#pragma unroll
                for (int n = 0; n < 2; ++n)
#pragma unroll
                    for (int j = 0; j < 4; ++j) { const float gt = acc[ai][0][m][n][j], up = acc[ai][1][m][n][j]; o[n * 4 + j] = gt * __builtin_amdgcn_rcpf(1.0f + __expf(-gt)) * up; }
                v4u w; w.x = pk2(o[0], o[1]); w.y = pk2(o[2], o[3]); w.z = pk2(o[4], o[5]); w.w = pk2(o[6], o[7]);
                *(v4u*)rowp = w; }
    }
};
struct EpiResF32 {
    static constexpr bool PERM = false;
    const float* base; float* out; int ldc;
    __device__ __forceinline__ void operator()(const f32x4 (&acc)[2][2][4][2], const Unit& u, int wr, int wc, int fr, int fq) const {
        const int row0 = u.pm * BM + wr * 64 + fr, col0 = u.pn * BM + wc * 32 + 4 * fq;
#pragma unroll
        for (int ai = 0; ai < 2; ++ai)
#pragma unroll
            for (int m = 0; m < 4; ++m) { const size_t off = (size_t)(row0 + ai * HALF + m * 16) * ldc + col0;
#pragma unroll
                for (int bj = 0; bj < 2; ++bj)
#pragma unroll
                    for (int n = 0; n < 2; ++n) { f32x4 v = acc[ai][bj][m][n]; if (base) v += *(const f32x4*)(base + off + bj * HALF + n * 16); *(f32x4*)(out + off + bj * HALF + n * 16) = v; } }
    }
};
struct EpiRgIn {
    static constexpr bool PERM = true;
    bf16* Y; bf16* XBR;
    __device__ __forceinline__ void operator()(const f32x4 (&acc)[2][2][4][2], const Unit& u, int wr, int wc, int fr, int fq) const {
        const bool isy = u.pn < 8; bf16* O = isy ? Y : XBR;
        const int row0 = u.pm * BM + wr * 64 + fr, col0 = (u.pn & 7) * BM + wc * 32 + 8 * fq;
#pragma unroll
        for (int ai = 0; ai < 2; ++ai)
#pragma unroll
            for (int m = 0; m < 4; ++m) { bf16* rowp = O + (size_t)(row0 + ai * HALF + m * 16) * D + col0;
#pragma unroll
                for (int bj = 0; bj < 2; ++bj) { float o[8];
#pragma unroll
                    for (int n = 0; n < 2; ++n)
#pragma unroll
                        for (int j = 0; j < 4; ++j) { float x = acc[ai][bj][m][n][j];
                            if (isy) { const float y2 = 1.5957691216f * (x + 0.044715f * x * x * x); x = x * __builtin_amdgcn_rcpf(1.0f + __expf(-y2)); }
                            o[n * 4 + j] = x; }
                    v4u w; w.x = pk2(o[0], o[1]); w.y = pk2(o[2], o[3]); w.z = pk2(o[4], o[5]); w.w = pk2(o[6], o[7]);
                    *(v4u*)(rowp + bj * HALF) = w; } }
    }
};
struct EpiGates {
    static constexpr bool PERM = false;
    const bf16* XC; const float* ba; const float* bx; const float* lam; float* AA; float* BB;
    __device__ __forceinline__ void operator()(const f32x4 (&acc)[2][2][4][2], const Unit& u, int wr, int wc, int fr, int fq) const {
        const int row0 = u.pm * BM + wr * 64 + fr, col0 = u.pn * HALF + wc * 32 + 4 * fq;
#pragma unroll
        for (int n = 0; n < 2; ++n) { const int col = col0 + n * 16;
            const f32x4 vba = *(const f32x4*)(ba + col), vbx = *(const f32x4*)(bx + col), sp = *(const f32x4*)(lam + col);
#pragma unroll
            for (int ai = 0; ai < 2; ++ai)
#pragma unroll
                for (int m = 0; m < 4; ++m) { const size_t off = (size_t)(row0 + ai * HALF + m * 16) * D + col;
                    const v2u xw = *(const v2u*)(XC + off); const float xc[4] = {bflo(xw.x), bfhi(xw.x), bflo(xw.y), bfhi(xw.y)};
                    f32x4 oa, ob;
#pragma unroll
                    for (int j = 0; j < 4; ++j) { const float r = sigmoidf_(acc[ai][0][m][n][j] + vba[j]), gi = sigmoidf_(acc[ai][1][m][n][j] + vbx[j]);
                        const float la = sp[j] * r, t2 = 2.0f * la; oa[j] = __expf(la);
                        const float em = (t2 > -0.01f) ? -t2 * (1.0f + 0.5f * t2 * (1.0f + 0.33333334f * t2)) : 1.0f - __expf(t2);
                        ob[j] = sqrtf(fmaxf(em, 0.f)) * (gi * xc[j]); }
                    *(f32x4*)(AA + off) = oa; *(f32x4*)(BB + off) = ob; asm volatile("" ::: "memory"); } }
    }
};
}

#define XB_TMO      128
#define XB_XCNT(j)  (256  + 64 * (j))
#define XB_XSUB(j)  (1280 + 64 * (j))
#define XB_XGEN(j)  (2304 + 64 * (j))
#define XB_TOP      3328
#define XB_TOPGEN   3392
#define XCD_BAR_WORDS 3456
#define XB_SPIN_CAP (1u << 22)
__device__ __forceinline__ unsigned xb_ld(unsigned* p)              { return __hip_atomic_load(p, __ATOMIC_RELAXED, __HIP_MEMORY_SCOPE_AGENT); }
__device__ __forceinline__ unsigned xb_add(unsigned* p, unsigned v) { return __hip_atomic_fetch_add(p, v, __ATOMIC_RELAXED, __HIP_MEMORY_SCOPE_AGENT); }
__device__ __forceinline__ unsigned xb_xcc_id() { return (unsigned)__builtin_amdgcn_s_getreg((3 << 11) | 20) & 0xFu; }
#define XB_SPIN(cond, bar) do { unsigned _sp = 0; while (cond) { __builtin_amdgcn_s_sleep(1); \
    if ((++_sp & 255u) == 0u) { if (xb_ld(&(bar)[XB_TMO])) break; if (_sp > XB_SPIN_CAP) { atomicAdd(&(bar)[XB_TMO], 1u); break; } } } } while (0)
struct XcdBarrier { unsigned* bar; unsigned x; volatile LAS unsigned* st; };
__device__ __forceinline__ XcdBarrier xcd_barrier_post(unsigned* bar, volatile LAS unsigned* st) {
    XcdBarrier b; b.bar = bar; b.x = xb_xcc_id(); b.st = st;
    if (threadIdx.x == 0) (void)xb_add(&bar[XB_XCNT(b.x)], 1u);
    return b;
}
__device__ __forceinline__ void xcd_barrier_complete(unsigned* bar, unsigned x, unsigned& nloc, unsigned& nx) {
    const unsigned G = gridDim.x * gridDim.y * gridDim.z;
    unsigned sum, cnt, mine, sp = 0u;
    for (;;) {
        sum = 0u; cnt = 0u; mine = 0u;
#pragma unroll
        for (unsigned j = 0; j < 16; ++j) { const unsigned c = xb_ld(&bar[XB_XCNT(j)]); sum += c; cnt += (c > 0u) ? 1u : 0u; mine = (j == x) ? c : mine; }
        if (sum == G) break;
        __builtin_amdgcn_s_sleep(1);
        if ((++sp & 255u) == 0u) { if (xb_ld(&bar[XB_TMO])) break; if (sp > XB_SPIN_CAP) { atomicAdd(&bar[XB_TMO], 1u); break; } }
    }
    nloc = mine > 0u ? mine : 1u; nx = cnt > 0u ? cnt : 1u;
}
__device__ __forceinline__ void xcd_barrier(const XcdBarrier& b) {
    asm volatile("s_waitcnt vmcnt(0)" ::: "memory");
    __syncthreads();
    if (threadIdx.x == 0) {
        unsigned* bar = b.bar;
        __builtin_amdgcn_s_waitcnt(0);
        unsigned nloc = b.st[0], nx = b.st[1];
        if (nloc == 0u) { xcd_barrier_complete(bar, b.x, nloc, nx); b.st[0] = nloc; b.st[1] = nx; }
        const unsigned old = xb_add(&bar[XB_XSUB(b.x)], 1u);
        const unsigned gen = old / nloc;
        if (old + 1u == (gen + 1u) * nloc) {
            __builtin_amdgcn_fence(__ATOMIC_RELEASE, "agent");
            asm volatile("s_waitcnt vmcnt(0)" ::: "memory");
            const unsigned og = xb_add(&bar[XB_TOP], 1u);
            const unsigned tg = og / nx;
            if (og + 1u == (tg + 1u) * nx) xb_add(&bar[XB_TOPGEN], 1u);
            else XB_SPIN(xb_ld(&bar[XB_TOPGEN]) == tg, bar);
            __builtin_amdgcn_fence(__ATOMIC_ACQUIRE, "agent");
            xb_add(&bar[XB_XGEN(b.x)], 1u);
            asm volatile("s_waitcnt vmcnt(0)" ::: "memory");
        } else {
            XB_SPIN(xb_ld(&bar[XB_XGEN(b.x)]) == gen, bar);
            __builtin_amdgcn_fence(__ATOMIC_ACQUIRE, "agent");
            asm volatile("s_waitcnt vmcnt(0)" ::: "memory");
        }
    }
    __syncthreads();
}

struct Frame {
    LAS unsigned char* lds;
    int tid, lane, wave, G, blk;
    unsigned char* ws;
    const float* in[25];
    float* out;
};
enum { I_X = 0, I_NORMW, I_FNW, I_MIXIN, I_GCONV, I_ALOG, I_DTB, I_GNW, I_LBL, I_HNW, I_MIXOUT, I_FGU, I_FD, I_RGIN, I_RGCW, I_RGCB, I_RGAW, I_RGAB, I_RGXW, I_RGXB, I_LAM, I_RGOUT, I_ROUTER, I_MGU, I_MD };

struct Job { const float* src; bf16* dst; int ld, K, n0, ncols, drow0, mode, nbatch; long sbs; int dbs; };
__device__ __forceinline__ void conv_item(const Job& jb, LAS float* scr, int item, int lane) {
    const int nblk = jb.ncols / 32, per = (jb.K / 64) * nblk, b = item / per, r = item % per, kb = r / nblk, nb = r % nblk, k0 = 64 * kb, n0l = 32 * nb;
    const float* sp = jb.src + (size_t)b * jb.sbs + (size_t)k0 * jb.ld + jb.n0 + n0l;
#pragma unroll 8
    for (int i = 0; i < 32; ++i) { const int kk = 2 * i + (lane >> 5); scr[kk * 33 + (lane & 31)] = sp[(size_t)kk * jb.ld + (lane & 31)]; }
    LDS_WAIT(); asm volatile("" ::: "memory");
    const int c = lane & 7;
#pragma unroll
    for (int j = 0; j < 4; ++j) { const int n = (lane >> 3) + 8 * j, nl = n0l + n; const LAS float* s = scr + (8 * c) * 33 + n;
        const int drow = jb.drow0 + b * jb.dbs + (jb.mode ? ((nl >> 7) * 256 + (nl & 127)) : nl);
        v4u o; o.x = pk2(s[0 * 33], s[1 * 33]); o.y = pk2(s[2 * 33], s[3 * 33]); o.z = pk2(s[4 * 33], s[5 * 33]); o.w = pk2(s[6 * 33], s[7 * 33]);
        *(v4u*)(jb.dst + (size_t)drow * jb.K + k0 + 8 * c) = o; }
    LDS_WAIT(); asm volatile("" ::: "memory");
}
constexpr int NJOBS = 13;
__device__ __forceinline__ Job get_job(const Frame& F, int j) {
    Job b; b.n0 = 0; b.drow0 = 0; b.mode = 0; b.nbatch = 1; b.sbs = 0; b.dbs = 0;
    unsigned char* ws = F.ws;
    switch (j) {
    case 0:  b.src = F.in[I_MIXIN]; b.dst = (bf16*)(ws + O_WMI); b.ld = MIXLD; b.K = D; b.ncols = 4096; break;
    case 1:  b.src = F.in[I_MIXIN]; b.dst = (bf16*)(ws + O_WMI); b.ld = MIXLD; b.K = D; b.n0 = 4112; b.ncols = 4096; b.drow0 = 4096; break;
    case 2:  b.src = F.in[I_MIXOUT]; b.dst = (bf16*)(ws + O_WMO); b.ld = D; b.K = D; b.ncols = D; break;
    case 3:  b.src = F.in[I_FGU]; b.dst = (bf16*)(ws + O_WFG); b.ld = 2 * FF; b.K = D; b.ncols = FF; b.mode = 1; break;
    case 4:  b.src = F.in[I_FGU]; b.dst = (bf16*)(ws + O_WFG); b.ld = 2 * FF; b.K = D; b.n0 = FF; b.ncols = FF; b.drow0 = 128; b.mode = 1; break;
    case 5:  b.src = F.in[I_FD]; b.dst = (bf16*)(ws + O_WFD); b.ld = D; b.K = FF; b.ncols = D; break;
    case 6:  b.src = F.in[I_RGIN]; b.dst = (bf16*)(ws + O_WRI); b.ld = 2 * D; b.K = D; b.ncols = 2 * D; break;
    case 7:  b.src = F.in[I_RGAW]; b.dst = (bf16*)(ws + O_WRG); b.ld = 256; b.K = 256; b.ncols = 256; b.mode = 1; b.nbatch = 8; b.sbs = 65536; b.dbs = 512; break;
    case 8:  b.src = F.in[I_RGXW]; b.dst = (bf16*)(ws + O_WRG); b.ld = 256; b.K = 256; b.ncols = 256; b.drow0 = 128; b.mode = 1; b.nbatch = 8; b.sbs = 65536; b.dbs = 512; break;
    case 9:  b.src = F.in[I_RGOUT]; b.dst = (bf16*)(ws + O_WRO); b.ld = D; b.K = D; b.ncols = D; break;
    case 10: b.src = F.in[I_MGU]; b.dst = (bf16*)(ws + O_WMG); b.ld = 2 * FE; b.K = D; b.ncols = FE; b.mode = 1; b.nbatch = 8; b.sbs = (long)D * 2 * FE; b.dbs = 2 * FE; break;
    case 11: b.src = F.in[I_MGU]; b.dst = (bf16*)(ws + O_WMG); b.ld = 2 * FE; b.K = D; b.n0 = FE; b.ncols = FE; b.drow0 = 128; b.mode = 1; b.nbatch = 8; b.sbs = (long)D * 2 * FE; b.dbs = 2 * FE; break;
    default: b.src = F.in[I_MD]; b.dst = (bf16*)(ws + O_WMD); b.ld = D; b.K = FE; b.ncols = D; b.nbatch = 8; b.sbs = (long)FE * D; b.dbs = D; break;
    }
    return b;
}
constexpr int job_items(int j) { return j == 0 || j == 1 ? 32 * 128 : j == 2 ? 32 * 64 : j == 3 || j == 4 ? 32 * 176 : j == 5 ? 88 * 64 : j == 6 ? 32 * 128 : j == 7 || j == 8 ? 8 * 4 * 8 : j == 9 ? 32 * 64 : j == 10 || j == 11 ? 8 * 32 * 224 : 8 * 112 * 64; }
constexpr int job_cum(int j) { int s = 0; for (int k = 2; k < j; ++k) s += job_items(k); return s; }
__device__ __forceinline__ void convert_queue(const Frame& F, unsigned* qhead) {
    LAS float* scr = (LAS float*)(F.lds + F.wave * 16384);
    constexpr int total = job_cum(NJOBS);
    for (;;) {
        unsigned base = 0;
        if (F.lane == 0) base = __hip_atomic_fetch_add(qhead, 16u, __ATOMIC_RELAXED, __HIP_MEMORY_SCOPE_AGENT);
        base = (unsigned)__builtin_amdgcn_readfirstlane((int)base);
        if ((int)base >= total) break;
        for (int i = 0; i < 16; ++i) { const int it = (int)base + i; if (it >= total) break;
            int j = 2;
#pragma unroll
            for (int k = 3; k < NJOBS; ++k) j += (it >= job_cum(k)) ? 1 : 0;
            int c = 0;
#pragma unroll
            for (int k = 3; k < NJOBS; ++k) c = (it >= job_cum(k)) ? job_cum(k) : c;
            const Job jb = get_job(F, j);
            conv_item(jb, scr, it - c, F.lane); }
    }
}
__device__ __forceinline__ void convert_jobs(const Frame& F, int j0, int j1, int gw, int ngw) {
    LAS float* scr = (LAS float*)(F.lds + F.wave * 16384);
    for (int j = j0; j < j1; ++j) { const Job jb = get_job(F, j); const int nitems = jb.nbatch * (jb.K / 64) * (jb.ncols / 32);
        for (int it = gw; it < nitems; it += ngw) conv_item(jb, scr, it, F.lane); }
}

__device__ __forceinline__ void rms_load(const float* xrow, const float* nw, int lane, f32x4 (&v)[8]) {
    float s = 0.f;
#pragma unroll
    for (int j = 0; j < 8; ++j) { v[j] = ((const f32x4*)xrow)[lane + 64 * j]; s += (v[j].x * v[j].x + v[j].y * v[j].y) + (v[j].z * v[j].z + v[j].w * v[j].w); }
    const float rstd = rsqrtf(wave_sum(s) * (1.0f / D) + EPS);
#pragma unroll
    for (int j = 0; j < 8; ++j) { const f32x4 w = ((const f32x4*)nw)[lane + 64 * j]; v[j] = v[j] * rstd * w; }
}
__device__ __forceinline__ void row_store_bf16(bf16* orow, int lane, const f32x4 (&v)[8]) {
#pragma unroll
    for (int j = 0; j < 8; ++j) { v2u w; w.x = pk2(v[j].x, v[j].y); w.y = pk2(v[j].z, v[j].w); ((v2u*)orow)[lane + 64 * j] = w; }
}

__device__ __forceinline__ void phase_prologue(const Frame& F) {
    const int gw = F.blk * 8 + F.wave, ngw = F.G * 8;
    convert_jobs(F, 0, 2, gw, ngw);
    if (F.blk == 0) for (int i = F.tid; i < D; i += 512) ((float*)(F.ws + O_SPL))[i] = -8.0f * log1pf(__expf(-F.in[I_LAM][i]));
    __syncthreads();
    LAS float* w16 = (LAS float*)F.lds;
    const float* W = F.in[I_MIXIN];
    for (int idx = F.tid; idx < D * 16; idx += 512) { const int c = idx & 15, i = idx >> 4; w16[c * 2052 + i] = W[(size_t)i * MIXLD + 4096 + c]; }
    __syncthreads();
    const float* nw = F.in[I_NORMW];
    bf16* XN = (bf16*)(F.ws + O_XN); float* GB = (float*)(F.ws + O_GB);
    for (int m = gw; m < T; m += ngw) {
        f32x4 v[8]; rms_load(F.in[I_X] + (size_t)m * D, nw, F.lane, v);
        row_store_bf16(XN + (size_t)m * D, F.lane, v);
        float mine = 0.f;
#pragma unroll 1
        for (int c = 0; c < 16; ++c) { float a = 0.f;
#pragma unroll
            for (int j = 0; j < 8; ++j) { const f32x4 w = *(const LAS f32x4*)(w16 + c * 2052 + 4 * F.lane + 256 * j); a += (v[j].x * w.x + v[j].y * w.y) + (v[j].z * w.z + v[j].w * w.w); }
            a = wave_sum(a); if (F.lane == c) mine = a; }
        if (F.lane < 8) GB[(size_t)m * 16 + F.lane] = sigmoidf_(mine);
        else if (F.lane < 16) { const int h = F.lane - 8; GB[(size_t)m * 16 + F.lane] = -__expf(F.in[I_ALOG][h]) * softplusf_(mine + F.in[I_DTB][h]); }
    }
    __syncthreads();
}

__device__ __forceinline__ void phase_rms(const Frame& F, const float* X, const float* nw) {
    const int gw = F.blk * 8 + F.wave, ngw = F.G * 8; bf16* XN = (bf16*)(F.ws + O_XN);
    for (int m = gw; m < T; m += ngw) { f32x4 v[8]; rms_load(X + (size_t)m * D, nw, F.lane, v); row_store_bf16(XN + (size_t)m * D, F.lane, v); }
}

__device__ __forceinline__ void phase_mix_pre(const Frame& F) {
    const int gw = F.blk * 8 + F.wave, ngw = F.G * 8, lane = F.lane;
    const bf16* P = (const bf16*)(F.ws + O_PROJ);
    float* QF = (float*)(F.ws + O_QF); float* KF = (float*)(F.ws + O_KF); float* VF = (float*)(F.ws + O_VF); float* FH = (float*)(F.ws + O_FH); float* QH = (float*)(F.ws + O_QH);
    const float* cw = F.in[I_GCONV];
    const float* lbl = F.in[I_LBL];
    for (int it = gw; it < T * 8; it += ngw) {
        const int t = it >> 3, h = it & 7, s = t & (SEQ - 1), d = h * 128 + 2 * lane;
        float r[3][2];
#pragma unroll
        for (int mat = 0; mat < 3; ++mat) { float a0 = 0.f, a1 = 0.f;
#pragma unroll
            for (int j = 0; j < 4; ++j) { if (s - 3 + j >= 0) { const unsigned w = *(const unsigned*)(P + (size_t)(t - 3 + j) * NPROJ + mat * 1024 + d);
                    const f32x2 c = *(const f32x2*)(cw + j * 3072 + mat * 1024 + d); a0 += c.x * bflo(w); a1 += c.y * bfhi(w); } }
            r[mat][0] = siluf_(a0); r[mat][1] = siluf_(a1); }
        const float qs = wave_sum(r[0][0] * r[0][0] + r[0][1] * r[0][1]), ks = wave_sum(r[1][0] * r[1][0] + r[1][1] * r[1][1]);
        const float qn = rsqrtf(qs + EPS) * 0.08838834764831845f, kn = rsqrtf(ks + EPS);
        const size_t o = (size_t)t * 1024 + d;
        *(f32x2*)(QF + o) = (f32x2){r[0][0] * qn, r[0][1] * qn}; *(f32x2*)(KF + o) = (f32x2){r[1][0] * kn, r[1][1] * kn}; *(f32x2*)(VF + o) = (f32x2){r[2][0], r[2][1]};
        const unsigned wq = *(const unsigned*)(P + (size_t)t * NPROJ + PQ_BQ + d), wf = *(const unsigned*)(P + (size_t)t * NPROJ + PQ_BF + d);
        const f32x2 l0 = *(const f32x2*)(lbl + d), l1 = *(const f32x2*)(lbl + 1024 + d);
        const float lb0 = sigmoidf_(l0.x - l1.x), lb1 = sigmoidf_(l0.y - l1.y);
        *(f32x2*)(FH + o) = (f32x2){lb0 + (1.f - lb0) * sigmoidf_(bflo(wf)), lb1 + (1.f - lb1) * sigmoidf_(bfhi(wf))};
        *(f32x2*)(QH + o) = (f32x2){siluf_(bflo(wq)) * 0.08838834764831845f, siluf_(bfhi(wq)) * 0.08838834764831845f};
    }
}

__device__ __forceinline__ void phase_mix_scan_slow(const Frame& F) {
    if (F.blk >= 32) return;
    const int mixer = F.blk >> 4, b = (F.blk >> 3) & 1, h = F.blk & 7, tid = F.tid;
    if (mixer == 0 && FAST_GDN) return;
    if (mixer == 1 && FAST_HGRN) return;
    LAS float* ks = (LAS float*)F.lds;
    LAS float* qs = ks + 8192; LAS float* vs = qs + 8192; LAS float* ot = vs + 8192;
    LAS float* red1 = ot + 8192; LAS float* red2 = red1 + 512; LAS float* ab = red2 + 512;
    const float* KSRC = (const float*)(F.ws + (mixer ? O_FH : O_KF)); const float* QSRC = (const float*)(F.ws + (mixer ? O_QH : O_QF)); const float* VSRC = (const float*)(F.ws + O_VF);
    const bf16* P = (const bf16*)(F.ws + O_PROJ); const float* GB = (const float*)(F.ws + O_GB);
    bf16* O = (bf16*)(F.ws + O_O);
    const float* nw = mixer ? F.in[I_HNW] : F.in[I_GNW];
    const int e = tid & 127, qd = tid >> 7;
    float S[32];
#pragma unroll
    for (int i = 0; i < 32; ++i) S[i] = 0.f;
    for (int n = 0; n < 64; ++n) {
        const int t0 = b * SEQ + n * 64;
        for (int idx = tid; idx < 64 * 32; idx += 512) { const int r = idx >> 5, c4 = (idx & 31) * 4; const size_t go = (size_t)(t0 + r) * 1024 + h * 128 + c4;
            *(LAS f32x4*)(ks + r * 128 + c4) = *(const f32x4*)(KSRC + go); *(LAS f32x4*)(qs + r * 128 + c4) = *(const f32x4*)(QSRC + go);
            f32x4 vv; if (mixer) { const v2u w = *(const v2u*)(P + (size_t)(t0 + r) * NPROJ + PQ_BI + h * 128 + c4); vv = (f32x4){bflo(w.x), bfhi(w.x), bflo(w.y), bfhi(w.y)}; } else vv = *(const f32x4*)(VSRC + go);
            *(LAS f32x4*)(vs + r * 128 + c4) = vv; }
        if (tid < 64) { ab[tid * 2] = __expf(GB[(size_t)(t0 + tid) * 16 + 8 + h]); ab[tid * 2 + 1] = GB[(size_t)(t0 + tid) * 16 + h]; }
        __syncthreads();
        for (int r = 0; r < 64; ++r) {
            const LAS float* kr = ks + r * 128 + qd * 32; const LAS float* qr = qs + r * 128 + qd * 32; const float ve = vs[r * 128 + e];
            float osum = 0.f;
            if (mixer == 0) {
                const float a = ab[r * 2], bt = ab[r * 2 + 1];
                float p = 0.f;
#pragma unroll
                for (int i = 0; i < 32; ++i) p += kr[i] * S[i];
                red1[qd * 128 + e] = p;
                __syncthreads();
                const float kS = (red1[e] + red1[128 + e]) + (red1[256 + e] + red1[384 + e]);
                const float c1 = bt * (ve - a * kS);
#pragma unroll
                for (int i = 0; i < 32; ++i) { S[i] = a * S[i] + kr[i] * c1; osum += qr[i] * S[i]; }
            } else {
#pragma unroll
                for (int i = 0; i < 32; ++i) { const float f = kr[i]; S[i] = f * S[i] + (1.f - f) * ve; osum += qr[i] * S[i]; }
            }
            red2[qd * 128 + e] = osum;
            __syncthreads();
            if (tid < 128) ot[r * 128 + e] = (red2[e] + red2[128 + e]) + (red2[256 + e] + red2[384 + e]);
        }
        __syncthreads();
        {
            const int r = tid >> 3, c0 = (tid & 7) * 16; float o[16]; float ss = 0.f;
#pragma unroll
            for (int i = 0; i < 16; ++i) { o[i] = ot[r * 128 + c0 + i]; ss += o[i] * o[i]; }
            ss += __shfl_xor(ss, 1); ss += __shfl_xor(ss, 2); ss += __shfl_xor(ss, 4);
            const float rstd = rsqrtf(ss * (1.0f / 128.0f) + EPS);
            const bf16* zp = P + (size_t)(t0 + r) * NPROJ + (mixer ? PQ_BG : PQ_AZ) + h * 128 + c0;
            const v4u z0 = *(const v4u*)zp, z1 = *(const v4u*)(zp + 8);
            const unsigned zw[8] = {z0.x, z0.y, z0.z, z0.w, z1.x, z1.y, z1.z, z1.w};
            unsigned ow[8];
#pragma unroll
            for (int i = 0; i < 8; ++i) { const float za = bflo(zw[i]), zb = bfhi(zw[i]);
                ow[i] = pk2(o[2 * i] * rstd * nw[c0 + 2 * i] * siluf_(za), o[2 * i + 1] * rstd * nw[c0 + 2 * i + 1] * siluf_(zb)); }
            bf16* op = O + (size_t)(t0 + r) * D + mixer * 1024 + h * 128 + c0;
            *(v4u*)op = (v4u){ow[0], ow[1], ow[2], ow[3]}; *(v4u*)(op + 8) = (v4u){ow[4], ow[5], ow[6], ow[7]};
        }
        __syncthreads();
    }
}


constexpr int R_NW = 0, R_QD = 16384, R_QK = 32768, R_KDT = 40960, R_DEC = 57344;
__device__ __forceinline__ int frag_off(int row, int k, int nkb) { const int mt = row >> 4, kb = k >> 5, r = row & 15, k5 = k & 31, g = (k5 >> 2) & 3, j = (k5 >> 4) * 4 + (k5 & 3); return ((mt * nkb + kb) * 64 + g * 16 + r) * 16 + j * 2; }
__device__ __forceinline__ bf16x8 pack8(const f32x4 a, const f32x4 b) { v4u w; w.x = pk2(a[0], a[1]); w.y = pk2(a[2], a[3]); w.z = pk2(b[0], b[1]); w.w = pk2(b[2], b[3]); return __builtin_bit_cast(bf16x8, w); }
#define SBAR() do { asm volatile("s_waitcnt lgkmcnt(0)" ::: "memory"); __builtin_amdgcn_s_barrier(); asm volatile("" ::: "memory"); } while (0)

__device__ __forceinline__ void store_frag_row16(unsigned char* base, int row, int cb, int nkb, const float (&x)[16]) {
#pragma unroll
    for (int a = 0; a < 4; ++a) { v2u w; w.x = pk2(x[4 * a], x[4 * a + 1]); w.y = pk2(x[4 * a + 2], x[4 * a + 3]); *(v2u*)(base + frag_off(row, cb * 16 + 4 * a, nkb)) = w; }
}

__device__ __forceinline__ void gdn_prep_unit(const Frame& F, int b, int h, int n) {
    const int tid = F.tid, lane = F.lane, wave = F.wave, r = tid >> 3, cb = tid & 7, t0 = b * SEQ + n * 64, seq = b * 8 + h;
    LAS bf16* KB = (LAS bf16*)F.lds;
    LAS bf16* QB = (LAS bf16*)(F.lds + 17408);
    LAS float* LM = (LAS float*)(F.lds + 34816);
    LAS float* RHS = (LAS float*)(F.lds + 52224);
    LAS float* GC = (LAS float*)(F.lds + 117760);
    const bf16* P = (const bf16*)(F.ws + O_PROJ); const float* GB = (const float*)(F.ws + O_GB); const float* cw = F.in[I_GCONV];
    unsigned char* rec = F.ws + O_OPS + ((size_t)seq * 64 + n) * REC_BYTES; float* UT = (float*)(F.ws + O_UT) + ((size_t)seq * 64 + n) * 8192;
    float q[16], k[16], v[16];
    {
        const int s = n * 64 + r;
#pragma unroll
        for (int mat = 0; mat < 3; ++mat) { float a[16];
#pragma unroll
            for (int i = 0; i < 16; ++i) a[i] = 0.f;
#pragma unroll
            for (int j = 0; j < 4; ++j) { if (s - 3 + j >= 0) { const bf16* pp = P + (size_t)(t0 + r - 3 + j) * NPROJ + mat * 1024 + h * 128 + cb * 16; const v4u w0 = *(const v4u*)pp, w1 = *(const v4u*)(pp + 8);
                    const float* cp = cw + j * 3072 + mat * 1024 + h * 128 + cb * 16; const f32x4 c0 = *(const f32x4*)cp, c1 = *(const f32x4*)(cp + 4), c2 = *(const f32x4*)(cp + 8), c3 = *(const f32x4*)(cp + 12);
                    a[0] += c0.x * bflo(w0.x); a[1] += c0.y * bfhi(w0.x); a[2] += c0.z * bflo(w0.y); a[3] += c0.w * bfhi(w0.y); a[4] += c1.x * bflo(w0.z); a[5] += c1.y * bfhi(w0.z); a[6] += c1.z * bflo(w0.w); a[7] += c1.w * bfhi(w0.w);
                    a[8] += c2.x * bflo(w1.x); a[9] += c2.y * bfhi(w1.x); a[10] += c2.z * bflo(w1.y); a[11] += c2.w * bfhi(w1.y); a[12] += c3.x * bflo(w1.z); a[13] += c3.y * bfhi(w1.z); a[14] += c3.z * bflo(w1.w); a[15] += c3.w * bfhi(w1.w); } }
#pragma unroll
            for (int i = 0; i < 16; ++i) { const float y = siluf_(a[i]); if (mat == 0) q[i] = y; else if (mat == 1) k[i] = y; else v[i] = y; } }
        float qs = 0.f, ks = 0.f;
#pragma unroll
        for (int i = 0; i < 16; ++i) { qs += q[i] * q[i]; ks += k[i] * k[i]; }
        qs += __shfl_xor(qs, 1); qs += __shfl_xor(qs, 2); qs += __shfl_xor(qs, 4); ks += __shfl_xor(ks, 1); ks += __shfl_xor(ks, 2); ks += __shfl_xor(ks, 4);
        const float qn = rsqrtf(qs + EPS) * 0.08838834764831845f, kn = rsqrtf(ks + EPS);
#pragma unroll
        for (int i = 0; i < 16; ++i) { q[i] *= qn; k[i] *= kn; }
        if (cb == 0) { GC[64 + r] = GB[(size_t)(t0 + r) * 16 + h]; GC[128 + r] = GB[(size_t)(t0 + r) * 16 + 8 + h]; }
        v4u w0, w1; w0.x = pk2(k[0], k[1]); w0.y = pk2(k[2], k[3]); w0.z = pk2(k[4], k[5]); w0.w = pk2(k[6], k[7]); w1.x = pk2(k[8], k[9]); w1.y = pk2(k[10], k[11]); w1.z = pk2(k[12], k[13]); w1.w = pk2(k[14], k[15]);
        *(LAS v4u*)(KB + r * 136 + cb * 16) = w0; *(LAS v4u*)(KB + r * 136 + cb * 16 + 8) = w1;
        w0.x = pk2(q[0], q[1]); w0.y = pk2(q[2], q[3]); w0.z = pk2(q[4], q[5]); w0.w = pk2(q[6], q[7]); w1.x = pk2(q[8], q[9]); w1.y = pk2(q[10], q[11]); w1.z = pk2(q[12], q[13]); w1.w = pk2(q[14], q[15]);
        *(LAS v4u*)(QB + r * 136 + cb * 16) = w0; *(LAS v4u*)(QB + r * 136 + cb * 16 + 8) = w1;
    }
    __syncthreads();
    if (wave == 0) { float x = GC[128 + lane];
#pragma unroll
        for (int o = 1; o < 64; o <<= 1) { const float y = __shfl_up(x, o); if (lane >= o) x += y; }
        GC[lane] = x; }
    __syncthreads();
    const float gcr = GC[r], betar = GC[64 + r], egr = __expf(gcr), gclast = GC[63];
    {
#pragma unroll
        for (int a = 0; a < 4; ++a) { *(LAS f32x4*)(RHS + r * 256 + cb * 16 + 4 * a) = (f32x4){v[4 * a] * betar, v[4 * a + 1] * betar, v[4 * a + 2] * betar, v[4 * a + 3] * betar};
            const float kb_ = betar * egr; *(LAS f32x4*)(RHS + r * 256 + 128 + cb * 16 + 4 * a) = (f32x4){k[4 * a] * kb_, k[4 * a + 1] * kb_, k[4 * a + 2] * kb_, k[4 * a + 3] * kb_}; }
        float qd[16];
#pragma unroll
        for (int i = 0; i < 16; ++i) qd[i] = q[i] * egr;
        store_frag_row16(rec + R_QD, r, cb, 4, qd);
    }
    {
        const int mat = wave >> 2, mt = wave & 3, fr = lane & 15, g = lane >> 4; const LAS bf16* AB = mat ? QB : KB;
        bf16x8 af[4];
#pragma unroll
        for (int kb = 0; kb < 4; ++kb) af[kb] = *(const LAS bf16x8*)(AB + (mt * 16 + fr) * 136 + kb * 32 + 8 * g);
#pragma unroll
        for (int nt = 0; nt < 4; ++nt) { f32x4 acc = (f32x4){0.f, 0.f, 0.f, 0.f};
            if (nt <= mt) {
#pragma unroll
                for (int kb = 0; kb < 4; ++kb) { const bf16x8 bfr = *(const LAS bf16x8*)(KB + (nt * 16 + fr) * 136 + kb * 32 + 8 * g); acc = __builtin_amdgcn_mfma_f32_16x16x32_bf16(af[kb], bfr, acc, 0, 0, 0); } }
            const int sc = nt * 16 + fr; const float gcs = GC[sc];
#pragma unroll
            for (int i = 0; i < 4; ++i) { const int c = mt * 16 + 4 * g + i; const float dcy = __expf(GC[c] - gcs);
                if (mat == 0) { if (nt <= mt) LM[c * 68 + sc] = (sc < c) ? GC[64 + c] * acc[i] * dcy : 0.f; }
                else *(bf16*)(rec + R_QK + frag_off(c, sc, 2)) = (bf16)f2bf((sc <= c && nt <= mt) ? acc[i] * dcy : 0.f); } }
    }
    __syncthreads();
    if (tid < 256) {
        float x[64];
#pragma unroll
        for (int i = 0; i < 64; ++i) { float acc = RHS[i * 256 + tid];
#pragma unroll
            for (int j4 = 0; j4 < (i + 3) / 4; ++j4) { const f32x4 l4 = *(const LAS f32x4*)(LM + i * 68 + 4 * j4);
#pragma unroll
                for (int e = 0; e < 4; ++e) if (4 * j4 + e < i) acc -= l4[e] * x[4 * j4 + e]; }
            x[i] = acc; }
#pragma unroll
        for (int i = 0; i < 64; ++i) RHS[i * 256 + tid] = x[i];
    } else {
        const int tt = tid - 256, d = tt >> 1, half = tt & 1;
#pragma unroll
        for (int cq = 0; cq < 8; ++cq) { float y[4];
#pragma unroll
            for (int e = 0; e < 4; ++e) { const int c = 32 * half + 4 * cq + e; y[e] = bf2f(KB[c * 136 + d]) * __expf(gclast - GC[c]); }
            v2u w; w.x = pk2(y[0], y[1]); w.y = pk2(y[2], y[3]); *(v2u*)(rec + R_KDT + frag_off(d, 32 * half + 4 * cq, 2)) = w; }
        if (tt < 128) ((float*)(rec + R_DEC))[tt] = __expf(gclast);
    }
    __syncthreads();
    {
        const int dv = tid >> 2, cq = (tid & 3) * 16;
#pragma unroll
        for (int a = 0; a < 4; ++a) { f32x4 o;
#pragma unroll
            for (int e = 0; e < 4; ++e) o[e] = RHS[(cq + 4 * a + e) * 256 + dv];
            *(f32x4*)(UT + dv * 64 + cq + 4 * a) = o; }
        float nw[16];
#pragma unroll
        for (int a = 0; a < 4; ++a) { const f32x4 t4 = *(const LAS f32x4*)(RHS + r * 256 + 128 + cb * 16 + 4 * a); nw[4 * a] = -t4.x; nw[4 * a + 1] = -t4.y; nw[4 * a + 2] = -t4.z; nw[4 * a + 3] = -t4.w; }
        store_frag_row16(rec + R_NW, r, cb, 4, nw);
    }
    __syncthreads();
}

__device__ __forceinline__ void hgrn_prep_unit(const Frame& F, int b, int h, int n) {
    const int tid = F.tid, lane = F.lane, wave = F.wave, r = tid >> 3, cb = tid & 7, t0 = b * SEQ + n * 64, seq = 16 + b * 8 + h;
    LAS float* LF = (LAS float*)F.lds;
    LAS bf16* QB = (LAS bf16*)(F.lds + 32768);
    LAS bf16* KB = (LAS bf16*)(F.lds + 50176);
    LAS bf16* KD = (LAS bf16*)(F.lds + 67584);
    LAS float* VT = (LAS float*)(F.lds + 84992);
    const bf16* P = (const bf16*)(F.ws + O_PROJ); const float* lbl = F.in[I_LBL];
    unsigned char* rec = F.ws + O_OPS + ((size_t)seq * 64 + n) * REC_BYTES; float* UT = (float*)(F.ws + O_UT) + ((size_t)seq * 64 + n) * 8192;
    float q[16], kk[16], lf[16];
    {
        const bf16* pq = P + (size_t)(t0 + r) * NPROJ + PQ_BQ + h * 128 + cb * 16; const bf16* pf = P + (size_t)(t0 + r) * NPROJ + PQ_BF + h * 128 + cb * 16; const bf16* pi = P + (size_t)(t0 + r) * NPROJ + PQ_BI + h * 128 + cb * 16;
        const v4u q0 = *(const v4u*)pq, q1 = *(const v4u*)(pq + 8), f0 = *(const v4u*)pf, f1 = *(const v4u*)(pf + 8), i0 = *(const v4u*)pi, i1 = *(const v4u*)(pi + 8);
        const unsigned qw[8] = {q0.x, q0.y, q0.z, q0.w, q1.x, q1.y, q1.z, q1.w}, fw[8] = {f0.x, f0.y, f0.z, f0.w, f1.x, f1.y, f1.z, f1.w}, iw[8] = {i0.x, i0.y, i0.z, i0.w, i1.x, i1.y, i1.z, i1.w};
#pragma unroll
        for (int i = 0; i < 16; ++i) { const int d = h * 128 + cb * 16 + i; const float lb = sigmoidf_(lbl[d] - lbl[1024 + d]);
            const float fl = (i & 1) ? bfhi(fw[i >> 1]) : bflo(fw[i >> 1]), ql = (i & 1) ? bfhi(qw[i >> 1]) : bflo(qw[i >> 1]), vl = (i & 1) ? bfhi(iw[i >> 1]) : bflo(iw[i >> 1]);
            const float fg = lb + (1.f - lb) * sigmoidf_(fl); lf[i] = __logf(fg); kk[i] = 1.f - fg; q[i] = siluf_(ql) * 0.08838834764831845f;
            VT[(cb * 16 + i) * 65 + r] = vl; }
#pragma unroll
        for (int a = 0; a < 4; ++a) *(LAS f32x4*)(LF + r * 128 + cb * 16 + 4 * a) = (f32x4){lf[4 * a], lf[4 * a + 1], lf[4 * a + 2], lf[4 * a + 3]};
    }
    __syncthreads();
    {
        const int d = tid & 127, qr = tid >> 7; float run = 0.f;
#pragma unroll
        for (int i = 0; i < 16; ++i) { run += LF[(16 * qr + i) * 128 + d]; LF[(16 * qr + i) * 128 + d] = run; }
    }
    __syncthreads();
    {
        float bb[16], bref[16], blast[16];
#pragma unroll
        for (int a = 0; a < 4; ++a) { const int co = cb * 16 + 4 * a;
            const f32x4 t15 = *(const LAS f32x4*)(LF + 15 * 128 + co), t31 = *(const LAS f32x4*)(LF + 31 * 128 + co), t47 = *(const LAS f32x4*)(LF + 47 * 128 + co), t63 = *(const LAS f32x4*)(LF + 63 * 128 + co), tr = *(const LAS f32x4*)(LF + r * 128 + co);
            const int qr = r >> 4;
#pragma unroll
            for (int e = 0; e < 4; ++e) { float off = 0.f; if (qr > 0) off += t15[e]; if (qr > 1) off += t31[e]; if (qr > 2) off += t47[e];
                bb[4 * a + e] = tr[e] + off; bref[4 * a + e] = t15[e] + t31[e]; blast[4 * a + e] = (t15[e] + t31[e]) + (t47[e] + t63[e]); } }
        float qt[16], kt[16], kd[16], qd[16];
#pragma unroll
        for (int i = 0; i < 16; ++i) { qt[i] = q[i] * __expf(bb[i] - bref[i]); kt[i] = kk[i] * __expf(bref[i] - bb[i]); kd[i] = kk[i] * __expf(blast[i] - bb[i]); qd[i] = q[i] * __expf(bb[i]); }
        v4u w0, w1;
        w0.x = pk2(qt[0], qt[1]); w0.y = pk2(qt[2], qt[3]); w0.z = pk2(qt[4], qt[5]); w0.w = pk2(qt[6], qt[7]); w1.x = pk2(qt[8], qt[9]); w1.y = pk2(qt[10], qt[11]); w1.z = pk2(qt[12], qt[13]); w1.w = pk2(qt[14], qt[15]);
        *(LAS v4u*)(QB + r * 136 + cb * 16) = w0; *(LAS v4u*)(QB + r * 136 + cb * 16 + 8) = w1;
        w0.x = pk2(kt[0], kt[1]); w0.y = pk2(kt[2], kt[3]); w0.z = pk2(kt[4], kt[5]); w0.w = pk2(kt[6], kt[7]); w1.x = pk2(kt[8], kt[9]); w1.y = pk2(kt[10], kt[11]); w1.z = pk2(kt[12], kt[13]); w1.w = pk2(kt[14], kt[15]);
        *(LAS v4u*)(KB + r * 136 + cb * 16) = w0; *(LAS v4u*)(KB + r * 136 + cb * 16 + 8) = w1;
        w0.x = pk2(kd[0], kd[1]); w0.y = pk2(kd[2], kd[3]); w0.z = pk2(kd[4], kd[5]); w0.w = pk2(kd[6], kd[7]); w1.x = pk2(kd[8], kd[9]); w1.y = pk2(kd[10], kd[11]); w1.z = pk2(kd[12], kd[13]); w1.w = pk2(kd[14], kd[15]);
        *(LAS v4u*)(KD + r * 136 + cb * 16) = w0; *(LAS v4u*)(KD + r * 136 + cb * 16 + 8) = w1;
        store_frag_row16(rec + R_QD, r, cb, 4, qd);
        if (r == 63) {
#pragma unroll
            for (int a = 0; a < 4; ++a) *(f32x4*)((float*)(rec + R_DEC) + cb * 16 + 4 * a) = (f32x4){__expf(blast[4 * a]), __expf(blast[4 * a + 1]), __expf(blast[4 * a + 2]), __expf(blast[4 * a + 3])}; }
    }
    __syncthreads();
    {
        const int mt = wave >> 1, fr = lane & 15, g = lane >> 4;
        bf16x8 af[4];
#pragma unroll
        for (int kb = 0; kb < 4; ++kb) af[kb] = *(const LAS bf16x8*)(QB + (mt * 16 + fr) * 136 + kb * 32 + 8 * g);
#pragma unroll
        for (int nn = 0; nn < 2; ++nn) { const int nt = 2 * (wave & 1) + nn; f32x4 acc = (f32x4){0.f, 0.f, 0.f, 0.f};
            if (nt <= mt) {
#pragma unroll
                for (int kb = 0; kb < 4; ++kb) { const bf16x8 bfr = *(const LAS bf16x8*)(KB + (nt * 16 + fr) * 136 + kb * 32 + 8 * g); acc = __builtin_amdgcn_mfma_f32_16x16x32_bf16(af[kb], bfr, acc, 0, 0, 0); } }
            const int sc = nt * 16 + fr;
#pragma unroll
            for (int i = 0; i < 4; ++i) { const int c = mt * 16 + 4 * g + i; *(bf16*)(rec + R_QK + frag_off(c, sc, 2)) = (bf16)f2bf((sc <= c && nt <= mt) ? acc[i] : 0.f); } }
        const int d = tid >> 2, cp = tid & 3;
#pragma unroll
        for (int a = 0; a < 4; ++a) { float y[4];
#pragma unroll
            for (int e = 0; e < 4; ++e) y[e] = bf2f(KD[(16 * cp + 4 * a + e) * 136 + d]);
            v2u w; w.x = pk2(y[0], y[1]); w.y = pk2(y[2], y[3]); *(v2u*)(rec + R_KDT + frag_off(d, 16 * cp + 4 * a, 2)) = w;
            f32x4 o;
#pragma unroll
            for (int e = 0; e < 4; ++e) o[e] = VT[d * 65 + 16 * cp + 4 * a + e];
            *(f32x4*)(UT + d * 64 + 16 * cp + 4 * a) = o; }
    }
    __syncthreads();
}

__device__ __forceinline__ void phase_mix_prep(const Frame& F) {
    for (int u = F.blk; u < 2048; u += F.G) { const int mixer = u & 1, rest = u >> 1, n = rest & 63, h = (rest >> 6) & 7, b = rest >> 9;
        if (mixer == 0) { if (FAST_GDN) gdn_prep_unit(F, b, h, n); } else { if (FAST_HGRN) hgrn_prep_unit(F, b, h, n); } }
}

__device__ __forceinline__ void phase_mix_scan(const Frame& F) {
    if (F.blk >= 32) return;
    const int seq = F.blk, mixer = seq >> 4, b = (seq >> 3) & 1, h = seq & 7, tid = F.tid, lane = F.lane, w = F.wave, n16 = lane & 15, g = lane >> 4;
    if (mixer == 0 && !FAST_GDN) return;
    if (mixer == 1 && !FAST_HGRN) return;
    LAS unsigned char* buf0 = F.lds; LAS unsigned char* buf1 = F.lds + REC_BYTES; LAS float* OT = (LAS float*)(F.lds + 2 * REC_BYTES);
    const unsigned char* rec = F.ws + O_OPS + (size_t)seq * 64 * REC_BYTES; const float* UTb = (const float*)(F.ws + O_UT) + (size_t)seq * 64 * 8192;
    const bf16* P = (const bf16*)(F.ws + O_PROJ); bf16* O = (bf16*)(F.ws + O_O); const float* nwp = mixer ? F.in[I_HNW] : F.in[I_GNW];
    const int er = tid >> 3, ec0 = (tid & 7) * 16, zcol = (mixer ? PQ_BG : PQ_AZ) + h * 128 + ec0;
    float nw[16];
#pragma unroll
    for (int i = 0; i < 16; ++i) nw[i] = nwp[ec0 + i];
    const int kb0 = mixer ? 16 : 0, nkb = mixer ? 5 : 7;
#define SCAN_ISSUE(st_, buf_) do { const unsigned char* rs_ = rec + (size_t)(st_) * REC_BYTES; \
        for (int i_ = 0; i_ < nkb; ++i_) { const int p_ = kb0 + w + 8 * i_; __builtin_amdgcn_global_load_lds((const unsigned*)(rs_ + p_ * 1024 + lane * 16), (LAS unsigned*)((buf_) + p_ * 1024), 16, 0, 0); } \
        if (w == 0) { __builtin_amdgcn_global_load_lds((const unsigned*)(rs_ + R_DEC + lane * 4), (LAS unsigned*)((buf_) + R_DEC), 4, 0, 0); \
                      __builtin_amdgcn_global_load_lds((const unsigned*)(rs_ + R_DEC + 256 + lane * 4), (LAS unsigned*)((buf_) + R_DEC + 256), 4, 0, 0); } } while (0)
    f32x4 Sacc[8]; bf16x8 Sb[4];
#pragma unroll
    for (int i = 0; i < 8; ++i) Sacc[i] = (f32x4){0.f, 0.f, 0.f, 0.f};
#pragma unroll
    for (int i = 0; i < 4; ++i) Sb[i] = (bf16x8){0, 0, 0, 0, 0, 0, 0, 0};
    SCAN_ISSUE(0, buf0);
    f32x4 Un[4];
#pragma unroll
    for (int mt = 0; mt < 4; ++mt) Un[mt] = *(const f32x4*)(UTb + (16 * w + n16) * 64 + 16 * mt + 4 * g);
    for (int st = 0; st < 64; ++st) {
        LAS unsigned char* cur = (st & 1) ? buf1 : buf0; LAS unsigned char* nxt = (st & 1) ? buf0 : buf1;
        asm volatile("s_waitcnt vmcnt(0)" ::: "memory"); SBAR();
        f32x4 U[4];
#pragma unroll
        for (int mt = 0; mt < 4; ++mt) U[mt] = Un[mt];
        if (st + 1 < 64) { SCAN_ISSUE(st + 1, nxt);
#pragma unroll
            for (int mt = 0; mt < 4; ++mt) Un[mt] = *(const f32x4*)(UTb + (size_t)(st + 1) * 8192 + (16 * w + n16) * 64 + 16 * mt + 4 * g); }
        const int t0 = b * SEQ + st * 64;
        const bf16* zp = P + (size_t)(t0 + er) * NPROJ + zcol; const v4u z0 = *(const v4u*)zp, z1 = *(const v4u*)(zp + 8);
#define AFR(base_, idx_) (*(const LAS bf16x8*)(cur + (base_) + (idx_) * 1024 + lane * 16))
        f32x4 vn[4];
#pragma unroll
        for (int mt = 0; mt < 4; ++mt) { vn[mt] = U[mt];
            if (mixer == 0) {
#pragma unroll
                for (int kb = 0; kb < 4; ++kb) vn[mt] = __builtin_amdgcn_mfma_f32_16x16x32_bf16(AFR(R_NW, mt * 4 + kb), Sb[kb], vn[mt], 0, 0, 0); } }
        bf16x8 Vb[2]; Vb[0] = pack8(vn[0], vn[1]); Vb[1] = pack8(vn[2], vn[3]);
        f32x4 o[4];
#pragma unroll
        for (int mt = 0; mt < 4; ++mt) { o[mt] = (f32x4){0.f, 0.f, 0.f, 0.f};
#pragma unroll
            for (int kb = 0; kb < 4; ++kb) o[mt] = __builtin_amdgcn_mfma_f32_16x16x32_bf16(AFR(R_QD, mt * 4 + kb), Sb[kb], o[mt], 0, 0, 0);
#pragma unroll
            for (int q2 = 0; q2 < 2; ++q2) o[mt] = __builtin_amdgcn_mfma_f32_16x16x32_bf16(AFR(R_QK, mt * 2 + q2), Vb[q2], o[mt], 0, 0, 0); }
#pragma unroll
        for (int m8 = 0; m8 < 8; ++m8) { const f32x4 dec = *(const LAS f32x4*)(cur + R_DEC + (16 * m8 + 4 * g) * 4); Sacc[m8] = Sacc[m8] * dec;
#pragma unroll
            for (int q2 = 0; q2 < 2; ++q2) Sacc[m8] = __builtin_amdgcn_mfma_f32_16x16x32_bf16(AFR(R_KDT, m8 * 2 + q2), Vb[q2], Sacc[m8], 0, 0, 0); }
#pragma unroll
        for (int kb = 0; kb < 4; ++kb) Sb[kb] = pack8(Sacc[2 * kb], Sacc[2 * kb + 1]);
#pragma unroll
        for (int mt = 0; mt < 4; ++mt)
#pragma unroll
            for (int i = 0; i < 4; ++i) OT[(16 * mt + 4 * g + i) * 132 + 16 * w + n16] = o[mt][i];
        SBAR();
        {
            float ov[16]; float ss = 0.f;
#pragma unroll
            for (int a = 0; a < 4; ++a) { const f32x4 t4 = *(const LAS f32x4*)(OT + er * 132 + ec0 + 4 * a); ov[4 * a] = t4.x; ov[4 * a + 1] = t4.y; ov[4 * a + 2] = t4.z; ov[4 * a + 3] = t4.w; ss += (t4.x * t4.x + t4.y * t4.y) + (t4.z * t4.z + t4.w * t4.w); }
            ss += __shfl_xor(ss, 1); ss += __shfl_xor(ss, 2); ss += __shfl_xor(ss, 4);
            const float rstd = rsqrtf(ss * (1.0f / 128.0f) + EPS);
            const unsigned zw[8] = {z0.x, z0.y, z0.z, z0.w, z1.x, z1.y, z1.z, z1.w}; unsigned ow[8];
#pragma unroll
            for (int i = 0; i < 8; ++i) ow[i] = pk2(ov[2 * i] * rstd * nw[2 * i] * siluf_(bflo(zw[i])), ov[2 * i + 1] * rstd * nw[2 * i + 1] * siluf_(bfhi(zw[i])));
            bf16* op = O + (size_t)(t0 + er) * D + mixer * 1024 + h * 128 + ec0;
            *(v4u*)op = (v4u){ow[0], ow[1], ow[2], ow[3]}; *(v4u*)(op + 8) = (v4u){ow[4], ow[5], ow[6], ow[7]};
        }
    }
    asm volatile("s_waitcnt vmcnt(0)" ::: "memory"); SBAR();
#undef AFR
#undef SCAN_ISSUE
}

__device__ __forceinline__ void phase_lru_conv(const Frame& F) {
    const bf16* XBR = (const bf16*)(F.ws + O_XBR); bf16* XC = (bf16*)(F.ws + O_XC);
    const float* cw = F.in[I_RGCW]; const float* cb = F.in[I_RGCB];
    for (int idx = F.blk * 512 + F.tid; idx < T * 256; idx += F.G * 512) {
        const int t = idx >> 8, c0 = (idx & 255) * 8, s = t & (SEQ - 1);
        float a[8];
        { const f32x4 b0 = *(const f32x4*)(cb + c0), b1 = *(const f32x4*)(cb + c0 + 4); a[0] = b0.x; a[1] = b0.y; a[2] = b0.z; a[3] = b0.w; a[4] = b1.x; a[5] = b1.y; a[6] = b1.z; a[7] = b1.w; }
#pragma unroll
        for (int j = 0; j < 4; ++j) { if (s - 3 + j >= 0) { const v4u w = *(const v4u*)(XBR + (size_t)(t - 3 + j) * D + c0);
                const f32x4 k0 = *(const f32x4*)(cw + j * D + c0), k1 = *(const f32x4*)(cw + j * D + c0 + 4);
                a[0] += k0.x * bflo(w.x); a[1] += k0.y * bfhi(w.x); a[2] += k0.z * bflo(w.y); a[3] += k0.w * bfhi(w.y);
                a[4] += k1.x * bflo(w.z); a[5] += k1.y * bfhi(w.z); a[6] += k1.z * bflo(w.w); a[7] += k1.w * bfhi(w.w); } }
        *(v4u*)(XC + (size_t)t * D + c0) = (v4u){pk2(a[0], a[1]), pk2(a[2], a[3]), pk2(a[4], a[5]), pk2(a[6], a[7])};
    }
}
__device__ __forceinline__ void phase_lru_scan1(const Frame& F) {
    const float* AA = (const float*)(F.ws + O_AA); const float* BB = (const float*)(F.ws + O_BB);
    float* SA = (float*)(F.ws + O_SUMA); float* SB = (float*)(F.ws + O_SUMB);
    for (int gid = F.blk * 512 + F.tid; gid < 2 * 32 * D; gid += F.G * 512) {
        const int ch = gid & 2047, chunk = (gid >> 11) & 31, b = gid >> 16; const size_t base = (size_t)(b * SEQ + chunk * 128) * D + ch;
        float hh = 0.f, pp = 1.f;
#pragma unroll 8
        for (int i = 0; i < 128; ++i) { const float a = AA[base + (size_t)i * D], bb = BB[base + (size_t)i * D]; hh = a * hh + bb; pp *= a; }
        SA[gid] = pp; SB[gid] = hh;
    }
}
__device__ __forceinline__ void phase_lru_scan2(const Frame& F) {
    const float* AA = (const float*)(F.ws + O_AA); const float* BB = (const float*)(F.ws + O_BB);
    const float* SA = (const float*)(F.ws + O_SUMA); const float* SB = (const float*)(F.ws + O_SUMB);
    const bf16* Y = (const bf16*)(F.ws + O_Y); bf16* YH = (bf16*)(F.ws + O_YH);
    for (int gid = F.blk * 512 + F.tid; gid < 2 * 32 * D; gid += F.G * 512) {
        const int ch = gid & 2047, chunk = (gid >> 11) & 31, b = gid >> 16; const size_t base = (size_t)(b * SEQ + chunk * 128) * D + ch;
        float hh = 0.f;
        for (int c = 0; c < chunk; ++c) { const int g2 = (b * 32 + c) * D + ch; hh = SA[g2] * hh + SB[g2]; }
#pragma unroll 8
        for (int i = 0; i < 128; ++i) { const float a = AA[base + (size_t)i * D], bb = BB[base + (size_t)i * D]; hh = a * hh + bb;
            YH[base + (size_t)i * D] = (bf16)f2bf(bf2f(Y[base + (size_t)i * D]) * hh); }
    }
}

__device__ __forceinline__ void phase_route1(const Frame& F) {
    const int gw = F.blk * 8 + F.wave, ngw = F.G * 8, lane = F.lane;
    LAS float* rwt = (LAS float*)F.lds;
    LAS unsigned* cntL = (LAS unsigned*)(F.lds + 8 * 2052 * 4);
    const float* RW = F.in[I_ROUTER];
    for (int idx = F.tid; idx < D * 8; idx += 512) { const int e = idx & 7, i = idx >> 3; rwt[e * 2052 + i] = RW[idx]; }
    if (F.tid < 8) cntL[F.tid] = 0u;
    __syncthreads();
    const float* X3 = (const float*)(F.ws + O_X3); const float* nw = F.in[I_NORMW] + 3 * D;
    bf16* XN = (bf16*)(F.ws + O_XN); unsigned* TOKE = (unsigned*)(F.ws + O_TOKE); float* TOKG = (float*)(F.ws + O_TOKG);
    for (int m = gw; m < T; m += ngw) {
        f32x4 v[8]; rms_load(X3 + (size_t)m * D, nw, lane, v);
        row_store_bf16(XN + (size_t)m * D, lane, v);
        float v0 = -3.0e38f, v1 = -3.0e38f; int i0 = 0, i1 = 0;
#pragma unroll 1
        for (int e = 0; e < 8; ++e) { float a = 0.f;
#pragma unroll
            for (int j = 0; j < 8; ++j) { const f32x4 w = *(const LAS f32x4*)(rwt + e * 2052 + 4 * lane + 256 * j); a += (v[j].x * w.x + v[j].y * w.y) + (v[j].z * w.z + v[j].w * w.w); }
            a = wave_sum(a);
            if (a > v0) { v1 = v0; i1 = i0; v0 = a; i0 = e; } else if (a > v1) { v1 = a; i1 = e; } }
        if (lane == 0) { const float g0 = 1.0f / (1.0f + __expf(v1 - v0)); TOKE[m] = (unsigned)i0 | ((unsigned)i1 << 8); TOKG[2 * m] = g0; TOKG[2 * m + 1] = 1.0f - g0;
            lds_add(cntL + i0, 1u); lds_add(cntL + i1, 1u); }
    }
    __syncthreads();
    if (F.tid < 8) ((unsigned*)(F.ws + O_WCNT))[F.blk * 8 + F.tid] = cntL[F.tid];
}
__device__ __forceinline__ void phase_route2(const Frame& F) {
    LAS unsigned* tot = (LAS unsigned*)F.lds; LAS unsigned* pre = tot + 8; LAS unsigned* eoff = tot + 16; LAS unsigned* basep = tot + 32; LAS unsigned* lpos = tot + 64; LAS unsigned* ltok = tot + 128;
    const unsigned* WCNT = (const unsigned*)(F.ws + O_WCNT); const unsigned* TOKE = (const unsigned*)(F.ws + O_TOKE);
    if (F.tid < 16) tot[F.tid] = 0u;
    if (F.tid < 32) ltok[F.tid] = TOKE[F.blk * 8 + (F.tid & 7) + 2048 * (F.tid >> 3)];
    __syncthreads();
    for (int idx = F.tid; idx < F.G * 8; idx += 512) { const int w = idx >> 3, e = idx & 7; const unsigned v = WCNT[idx]; lds_add(tot + e, v); if (w < F.blk) lds_add(pre + e, v); }
    __syncthreads();
    if (F.tid == 0) {
        unsigned off = 0;
        for (int e = 0; e < 8; ++e) { eoff[e] = off; basep[e] = off + pre[e]; off += (tot[e] + 255u) & ~255u; }
        eoff[8] = off;
        for (int i = 0; i < 32; ++i) { const unsigned te = ltok[i]; const unsigned e0 = te & 255u, e1 = te >> 8;
            lpos[2 * i] = basep[e0]; basep[e0] += 1; lpos[2 * i + 1] = basep[e1]; basep[e1] += 1; }
    }
    __syncthreads();
    if (F.blk == 0 && F.tid < 9) ((unsigned*)(F.ws + O_EOFF))[F.tid] = eoff[F.tid];
    if (F.tid < 32) { const int m = F.blk * 8 + (F.tid & 7) + 2048 * (F.tid >> 3); ((unsigned*)(F.ws + O_POS))[2 * m] = lpos[2 * F.tid]; ((unsigned*)(F.ws + O_POS))[2 * m + 1] = lpos[2 * F.tid + 1]; }
    const bf16* XN = (const bf16*)(F.ws + O_XN); bf16* HS = (bf16*)(F.ws + O_HS);
    for (int k = 0; k < 4; ++k) { const int li = k * 8 + F.wave, m = F.blk * 8 + F.wave + 2048 * k; const v4u* src = (const v4u*)(XN + (size_t)m * D);
        v4u a[4];
#pragma unroll
        for (int j = 0; j < 4; ++j) a[j] = src[F.lane + 64 * j];
#pragma unroll
        for (int sl = 0; sl < 2; ++sl) { v4u* dst = (v4u*)(HS + (size_t)lpos[2 * li + sl] * D);
#pragma unroll
            for (int j = 0; j < 4; ++j) dst[F.lane + 64 * j] = a[j]; } }
    if (F.blk < 8) {
        const unsigned r0 = eoff[F.blk] + tot[F.blk], r1 = eoff[F.blk + 1];
        for (unsigned idx = r0 * 256 + F.tid; idx < r1 * 256; idx += 512) ((v4u*)HS)[idx] = (v4u){0u, 0u, 0u, 0u};
    }
    __syncthreads();
}
struct SchedMoe {
    int nN, G, c, nrt; long aT, bT, bE; unsigned eo[9];
    __device__ __forceinline__ bool next(int i, pg8::Unit& u) const {
        if (!pg8::std_order(i, G, c, nrt, nN, u.pm, u.pn)) return false;
        int e = 0;
#pragma unroll
        for (int k = 1; k < 8; ++k) e += ((unsigned)(u.pm * 256) >= eo[k]) ? 1 : 0;
        u.aoff = (long)u.pm * aT; u.boff = (long)e * bE + (long)u.pn * bT; return true;
    }
};
struct SchedGates {
    int G, c;
    __device__ __forceinline__ bool next(int i, pg8::Unit& u) const {
        if (!pg8::std_order(i, G, c, 32, 16, u.pm, u.pn)) return false;
        u.aoff = ((long)u.pm * 256 * D + (u.pn >> 1) * 256) * 2; u.boff = (long)u.pn * 256 * 256 * 2; return true;
    }
};
__device__ __forceinline__ void phase_combine(const Frame& F) {
    const int gw = F.blk * 8 + F.wave, ngw = F.G * 8, lane = F.lane;
    const float* X3 = (const float*)(F.ws + O_X3); const float* YM = (const float*)(F.ws + O_YM);
    const unsigned* POS = (const unsigned*)(F.ws + O_POS); const float* TOKG = (const float*)(F.ws + O_TOKG); const float* fnw = F.in[I_FNW];
    for (int m = gw; m < T; m += ngw) {
        const unsigned p0 = POS[2 * m], p1 = POS[2 * m + 1]; const float g0 = TOKG[2 * m], g1 = TOKG[2 * m + 1];
        f32x4 v[8]; float s = 0.f;
#pragma unroll
        for (int j = 0; j < 8; ++j) { const f32x4 x = ((const f32x4*)(X3 + (size_t)m * D))[lane + 64 * j], y0 = ((const f32x4*)(YM + (size_t)p0 * D))[lane + 64 * j], y1 = ((const f32x4*)(YM + (size_t)p1 * D))[lane + 64 * j];
            v[j] = x + g0 * y0 + g1 * y1; s += (v[j].x * v[j].x + v[j].y * v[j].y) + (v[j].z * v[j].z + v[j].w * v[j].w); }
        const float rstd = rsqrtf(wave_sum(s) * (1.0f / D) + EPS);
#pragma unroll
        for (int j = 0; j < 8; ++j) { const f32x4 w = ((const f32x4*)fnw)[lane + 64 * j]; ((f32x4*)(F.out + (size_t)m * D))[lane + 64 * j] = v[j] * rstd * w; }
    }
}

constexpr int NPHASES = 20;
struct Args { const float* in[25]; float* out; unsigned char* ws; int ph_lo, ph_hi; };
__global__ void __launch_bounds__(512, 2) mk_fwd(Args args) {
    extern __shared__ __attribute__((aligned(16))) unsigned char lds_raw[];
    Frame F;
    F.lds = (LAS unsigned char*)lds_raw;
    F.tid = threadIdx.x; F.lane = F.tid & 63; F.wave = __builtin_amdgcn_readfirstlane(F.tid >> 6); F.G = gridDim.x; F.blk = blockIdx.x;
    F.ws = args.ws; F.out = args.out;
#pragma unroll
    for (int i = 0; i < 25; ++i) F.in[i] = args.in[i];
    volatile LAS unsigned* MISC = (volatile LAS unsigned*)(F.lds + MISC_OFF);
    if (F.tid < 64) MISC[F.tid] = 0u;
    __syncthreads();
    const int lo = args.ph_lo, hi = args.ph_hi;
    XcdBarrier bar; bar.bar = (unsigned*)(F.ws + O_CTL) + CW_BAR; bar.x = 0; bar.st = nullptr;
    if (hi - lo > 1) bar = xcd_barrier_post((unsigned*)(F.ws + O_CTL) + CW_BAR, MISC + 8);
#ifdef ONLY_PHASE
#define IN(k) ((k) == ONLY_PHASE && lo <= (k) && (k) < hi)
#else
#define IN(k) (lo <= (k) && (k) < hi)
#endif
#define SEAM(k) do { if (IN(k) && IN((k) + 1)) xcd_barrier(bar); } while (0)
#ifndef REP_PHASE
#define REP_PHASE -1
#endif
#ifndef REP_COUNT
#define REP_COUNT 2
#endif
#define PH_BEGIN(k) if (IN(k)) { for (int rep_ = 0; rep_ < ((k) == REP_PHASE ? REP_COUNT : 1); ++rep_) { if (rep_) xcd_barrier(bar);
#define PH_END(k) } } SEAM(k);
    unsigned char* ws = F.ws;
    bf16* XN = (bf16*)(ws + O_XN);

    PH_BEGIN(0) { phase_prologue(F); } PH_END(0)
    PH_BEGIN(1) {
        pg8::Gemm g{XN, (const bf16*)(ws + O_WMI), D, D, D}; pg8::SchedStd S{T / 256, NPROJ / 256, F.G, F.blk, (long)256 * D * 2, (long)256 * D * 2};
        pg8::EpiBf16 E{(bf16*)(ws + O_PROJ), NPROJ};
        pg8::gemm_phase(F.lds, g, S, E);
    } PH_END(1)
    PH_BEGIN(2) { if (!(FAST_GDN && FAST_HGRN)) phase_mix_pre(F); if (FAST_GDN || FAST_HGRN) phase_mix_prep(F); } PH_END(2)
    PH_BEGIN(3) { if (!(FAST_GDN && FAST_HGRN)) phase_mix_scan_slow(F); if (FAST_GDN || FAST_HGRN) phase_mix_scan(F); convert_queue(F, (unsigned*)(ws + O_CTL) + CW_Q); } PH_END(3)
    PH_BEGIN(4) {
        pg8::Gemm g{(const bf16*)(ws + O_O), (const bf16*)(ws + O_WMO), D, D, D}; pg8::SchedStd S{T / 256, D / 256, F.G, F.blk, (long)256 * D * 2, (long)256 * D * 2};
        pg8::EpiResF32 E{F.in[I_X], (float*)(ws + O_X1), D};
        pg8::gemm_phase(F.lds, g, S, E);
    } PH_END(4)
    PH_BEGIN(5) { phase_rms(F, (const float*)(ws + O_X1), F.in[I_NORMW] + D); } PH_END(5)
    PH_BEGIN(6) {
        pg8::Gemm g{XN, (const bf16*)(ws + O_WFG), D, D, D}; pg8::SchedStd S{T / 256, 2 * FF / 256, F.G, F.blk, (long)256 * D * 2, (long)256 * D * 2};
        pg8::EpiSwiglu E{(bf16*)(ws + O_ACT), FF};
        pg8::gemm_phase(F.lds, g, S, E);
    } PH_END(6)
    PH_BEGIN(7) {
        pg8::Gemm g{(const bf16*)(ws + O_ACT), (const bf16*)(ws + O_WFD), FF, FF, FF}; pg8::SchedStd S{T / 256, D / 256, F.G, F.blk, (long)256 * FF * 2, (long)256 * FF * 2};
        pg8::EpiResF32 E{(const float*)(ws + O_X1), (float*)(ws + O_X2), D};
        pg8::gemm_phase(F.lds, g, S, E);
    } PH_END(7)
    PH_BEGIN(8) { phase_rms(F, (const float*)(ws + O_X2), F.in[I_NORMW] + 2 * D); } PH_END(8)
    PH_BEGIN(9) {
        pg8::Gemm g{XN, (const bf16*)(ws + O_WRI), D, D, D}; pg8::SchedStd S{T / 256, 2 * D / 256, F.G, F.blk, (long)256 * D * 2, (long)256 * D * 2};
        pg8::EpiRgIn E{(bf16*)(ws + O_Y), (bf16*)(ws + O_XBR)};
        pg8::gemm_phase(F.lds, g, S, E);
    } PH_END(9)
    PH_BEGIN(10) { phase_lru_conv(F); } PH_END(10)
    PH_BEGIN(11) {
        pg8::Gemm g{(const bf16*)(ws + O_XC), (const bf16*)(ws + O_WRG), D, 256, 256}; SchedGates S{F.G, F.blk};
        pg8::EpiGates E{(const bf16*)(ws + O_XC), F.in[I_RGAB], F.in[I_RGXB], (const float*)(ws + O_SPL), (float*)(ws + O_AA), (float*)(ws + O_BB)};
        pg8::gemm_phase(F.lds, g, S, E);
    } PH_END(11)
    PH_BEGIN(12) { phase_lru_scan1(F); } PH_END(12)
    PH_BEGIN(13) { phase_lru_scan2(F); } PH_END(13)
    PH_BEGIN(14) {
        pg8::Gemm g{(const bf16*)(ws + O_YH), (const bf16*)(ws + O_WRO), D, D, D}; pg8::SchedStd S{T / 256, D / 256, F.G, F.blk, (long)256 * D * 2, (long)256 * D * 2};
        pg8::EpiResF32 E{(const float*)(ws + O_X2), (float*)(ws + O_X3), D};
        pg8::gemm_phase(F.lds, g, S, E);
    } PH_END(14)
    PH_BEGIN(15) { phase_route1(F); } PH_END(15)
    PH_BEGIN(16) { phase_route2(F); } PH_END(16)
    PH_BEGIN(17) {
        SchedMoe S; S.nN = 2 * FE / 256; S.G = F.G; S.c = F.blk; S.aT = (long)256 * D * 2; S.bT = (long)256 * D * 2; S.bE = (long)2 * FE * D * 2;
        const unsigned* eo = (const unsigned*)(ws + O_EOFF);
#pragma unroll
        for (int k = 0; k < 9; ++k) S.eo[k] = __builtin_amdgcn_readfirstlane(eo[k]);
        S.nrt = (int)(S.eo[8] >> 8);
        pg8::Gemm g{(const bf16*)(ws + O_HS), (const bf16*)(ws + O_WMG), D, D, D};
        pg8::EpiSwiglu E{(bf16*)(ws + O_ACTM), FE};
        pg8::gemm_phase(F.lds, g, S, E);
    } PH_END(17)
    PH_BEGIN(18) {
        SchedMoe S; S.nN = D / 256; S.G = F.G; S.c = F.blk; S.aT = (long)256 * FE * 2; S.bT = (long)256 * FE * 2; S.bE = (long)D * FE * 2;
        const unsigned* eo = (const unsigned*)(ws + O_EOFF);
#pragma unroll
        for (int k = 0; k < 9; ++k) S.eo[k] = __builtin_amdgcn_readfirstlane(eo[k]);
        S.nrt = (int)(S.eo[8] >> 8);
        pg8::Gemm g{(const bf16*)(ws + O_ACTM), (const bf16*)(ws + O_WMD), FE, FE, FE};
        pg8::EpiResF32 E{nullptr, (float*)(ws + O_YM), D};
        pg8::gemm_phase(F.lds, g, S, E);
    } PH_END(18)
    PH_BEGIN(19) { phase_combine(F); } } }
#undef IN
#undef SEAM
}

extern "C" void kernel_launch(void* const* d_in, const int* in_sizes, int n_in, void* d_out, int out_size, void* d_ws, size_t ws_size, hipStream_t stream) {
    static int grid = 0;
    if (grid == 0) {
        if (n_in != 25 || out_size != T * D || ws_size < WS_END) { fprintf(stderr, "kernel_launch: unexpected shapes (n_in %d out %d ws %zu need %zu)\n", n_in, out_size, ws_size, (size_t)WS_END); grid = -1; return; }
        int dev = 0, cus = 0, per_cu = 0;
        if (hipGetDevice(&dev) != hipSuccess || hipDeviceGetAttribute(&cus, hipDeviceAttributeMultiprocessorCount, dev) != hipSuccess) { grid = -1; return; }
        if (hipFuncSetAttribute((const void*)mk_fwd, hipFuncAttributeMaxDynamicSharedMemorySize, LDS_BYTES) != hipSuccess) { fprintf(stderr, "kernel_launch: hipFuncSetAttribute failed\n"); grid = -1; return; }
        if (hipOccupancyMaxActiveBlocksPerMultiprocessor(&per_cu, (const void*)mk_fwd, 512, LDS_BYTES) != hipSuccess || per_cu < 1) fprintf(stderr, "kernel_launch: occupancy query reports %d\n", per_cu);
        (void)hipGetLastError();
        grid = cus > 256 ? 256 : cus;
    }
    if (grid < 0) return;
    (void)hipMemsetAsync((char*)d_ws + O_CTL, 0, CTL_BYTES, stream);
    Args a{};
    for (int i = 0; i < 25; ++i) a.in[i] = (const float*)d_in[i];
    a.out = (float*)d_out; a.ws = (unsigned char*)d_ws;
#if MK_SPLIT
    for (int p = 0; p < NPHASES; ++p) { a.ph_lo = p; a.ph_hi = p + 1; hipLaunchKernelGGL(mk_fwd, dim3(grid), dim3(512), LDS_BYTES, stream, a); }
#else
    a.ph_lo = 0; a.ph_hi = NPHASES; hipLaunchKernelGGL(mk_fwd, dim3(grid), dim3(512), LDS_BYTES, stream, a);
#endif
}
```

```cpp
#include <hip/hip_runtime.h>
#include <cstdio>
#include <cstdint>

#ifndef MK_SPLIT
#define MK_SPLIT 0
#endif

#ifndef MOE_F8
#define MOE_F8 1
#endif
#define REP_PHASE -1
#define REP_COUNT 2
#ifndef FAST_GDN
#define FAST_GDN 1
#endif
#ifndef FAST_HGRN
#define FAST_HGRN 1
#endif
#define GAS __attribute__((address_space(1)))
#define LAS __attribute__((address_space(3)))
typedef unsigned short bf16;
typedef unsigned v4u __attribute__((ext_vector_type(4)));
typedef unsigned v2u __attribute__((ext_vector_type(2)));
typedef float f32x4 __attribute__((ext_vector_type(4)));
typedef float f32x2 __attribute__((ext_vector_type(2)));
typedef short bf16x8 __attribute__((ext_vector_type(8)));
#define RLX_AGENT __ATOMIC_RELAXED, __HIP_MEMORY_SCOPE_AGENT
#define LDS_WAIT() asm volatile("s_waitcnt lgkmcnt(0)" ::: "memory")
#define VM_WAIT() asm volatile("s_waitcnt vmcnt(0)" ::: "memory")

__device__ __forceinline__ unsigned f2bf(float f) { unsigned u = __builtin_bit_cast(unsigned, f); return (u + 0x7fffu + ((u >> 16) & 1u)) >> 16; }
__device__ __forceinline__ unsigned pk2(float lo, float hi) { return f2bf(lo) | (f2bf(hi) << 16); }
__device__ __forceinline__ float bf2f(unsigned short b) { return __builtin_bit_cast(float, ((unsigned)b) << 16); }
__device__ __forceinline__ float bflo(unsigned w) { return __builtin_bit_cast(float, w << 16); }
__device__ __forceinline__ float bfhi(unsigned w) { return __builtin_bit_cast(float, w & 0xffff0000u); }
__device__ __forceinline__ float clamp448(float x) { return __builtin_fminf(__builtin_fmaxf(x, -448.f), 448.f); }
__device__ __forceinline__ unsigned pk4_fp8(float a, float b, float c, float d) {
    unsigned w = 0; w = __builtin_amdgcn_cvt_pk_fp8_f32(clamp448(a), clamp448(b), w, false); w = __builtin_amdgcn_cvt_pk_fp8_f32(clamp448(c), clamp448(d), w, true); return w; }
__device__ __forceinline__ float sigmoidf_(float x) { return 1.0f / (1.0f + __expf(-x)); }
__device__ __forceinline__ float siluf_(float x) { return x / (1.0f + __expf(-x)); }
__device__ __forceinline__ float softplusf_(float x) { return x > 20.f ? x : log1pf(__expf(x)); }
__device__ __forceinline__ void lds_add(LAS unsigned* p, unsigned v) { (void)__hip_atomic_fetch_add(p, v, __ATOMIC_RELAXED, __HIP_MEMORY_SCOPE_WORKGROUP); }
__device__ __forceinline__ float wave_sum(float v) {
#pragma unroll
    for (int o = 1; o < 64; o <<= 1) v += __shfl_xor(v, o);
    return v;
}

constexpr int T = 8192, D = 2048, SEQ = 4096, NPROJ = 8192, FF = 5632, FE = 7168, NE = 8;
constexpr int MIXLD = 8208;
constexpr int PQ_AQ = 0, PQ_AK = 1024, PQ_AV = 2048, PQ_AZ = 3072, PQ_BQ = 4096, PQ_BF = 5120, PQ_BI = 6144, PQ_BG = 7168;
constexpr float EPS = 1e-6f;
constexpr int MOE_ROWS = 16384 + 8 * 256;

constexpr size_t al256(size_t x) { return (x + 255) & ~(size_t)255; }
constexpr size_t O_CTL = 0, CTL_BYTES = 1u << 20;
constexpr size_t O_WMI = CTL_BYTES;
constexpr size_t O_WMO = O_WMI + (size_t)NPROJ * D * 2;
constexpr size_t O_WFG = O_WMO + (size_t)D * D * 2;
constexpr size_t O_WFD = O_WFG + (size_t)2 * FF * D * 2;
constexpr size_t O_WRI = O_WFD + (size_t)D * FF * 2;
constexpr size_t O_WRG = O_WRI + (size_t)2 * D * D * 2;
constexpr size_t O_WRO = O_WRG + (size_t)16 * 256 * 256 * 2;
constexpr size_t O_WMG = O_WRO + (size_t)D * D * 2;
constexpr size_t O_WMD = O_WMG + (size_t)NE * 2 * FE * D * 2;
constexpr size_t O_XN = O_WMD + (size_t)NE * D * FE * 2;
constexpr size_t O_PROJ = O_XN + (size_t)T * D * 2;
constexpr size_t O_GB = O_PROJ + (size_t)T * NPROJ * 2;
constexpr size_t O_O = O_GB + (size_t)T * 16 * 4;
constexpr size_t O_X1 = O_O + (size_t)T * D * 2;
constexpr size_t O_X2 = O_X1 + (size_t)T * D * 4;
constexpr size_t O_X3 = O_X2 + (size_t)T * D * 4;
constexpr size_t O_ACT = O_X3 + (size_t)T * D * 4;
constexpr size_t O_Y = O_ACT + (size_t)T * FF * 2;
constexpr size_t O_XBR = O_Y + (size_t)T * D * 2;
constexpr size_t O_XC = O_XBR + (size_t)T * D * 2;
constexpr size_t O_AA = O_XC + (size_t)T * D * 2;
constexpr size_t O_BB = O_AA + (size_t)T * D * 4;
constexpr size_t O_YH = O_BB + (size_t)T * D * 4;
constexpr size_t O_SUMA = O_YH + (size_t)T * D * 2;
constexpr size_t O_SUMB = O_SUMA + (size_t)2 * 32 * D * 4;
constexpr size_t O_TOKE = O_SUMB + (size_t)2 * 32 * D * 4;
constexpr size_t O_TOKG = O_TOKE + (size_t)T * 4;
constexpr size_t O_POS = O_TOKG + (size_t)T * 8;
constexpr size_t O_WCNT = O_POS + (size_t)T * 8;
constexpr size_t O_EOFF = O_WCNT + 256 * 8 * 4;
constexpr size_t O_SPL = al256(O_EOFF + 64);
constexpr size_t O_HS = O_SPL + 2048 * 4;
constexpr size_t O_ACTM = O_HS + (size_t)MOE_ROWS * D * 2;
constexpr size_t O_YM = O_ACTM + (size_t)MOE_ROWS * FE * 2;
constexpr size_t O_QF = O_YM + (size_t)MOE_ROWS * D * 4;
constexpr size_t O_KF = O_QF + (size_t)T * 1024 * 4;
constexpr size_t O_VF = O_KF + (size_t)T * 1024 * 4;
constexpr size_t O_FH = O_VF + (size_t)T * 1024 * 4;
constexpr size_t O_QH = O_FH + (size_t)T * 1024 * 4;
constexpr size_t REC_BYTES = 57856;
constexpr size_t O_OPS = al256(O_QH + (size_t)T * 1024 * 4);
constexpr size_t O_UT = O_OPS + (size_t)32 * 64 * REC_BYTES;
constexpr size_t WS_END = O_UT + (size_t)32 * 64 * 8192 * 4;

constexpr int CW_BAR = 4096, CW_Q = 64;

constexpr int LDS_BYTES = 155648;
constexpr int MISC_OFF = 155648 - 256;

namespace pg8 {
constexpr int BM = 256, BK = 64, HALF = 128, HTB = HALF * BK * 2, STAGE_BYTES = 8 * HTB, NXCD = 8, WGM = 8;
__host__ __device__ __forceinline__ int lds_byte(int r, int c) { const int st = (r >> 4) * 2 + (c >> 5), rr = r & 15, cc = c & 31, ob = rr * 64 + cc * 2; return st * 1024 + (ob ^ (((ob >> 9) & 1) << 5)); }
__host__ __device__ __forceinline__ void stage_rc(int b, int& R, int& C) { const int st = b / 1024, sb = b % 1024, swz = sb ^ (((sb >> 9) & 1) << 5); R = (st >> 1) * 16 + swz / 64; C = (st & 1) * 32 + (swz % 64) / 2; }
__host__ __device__ __forceinline__ int perm32(int rho) { const int n = rho >> 4, i = rho & 15; return 8 * (i >> 2) + 4 * n + (i & 3); }

struct Unit { int pm, pn; unsigned aoff, boff; };
struct Gemm { const bf16* A; const bf16* Bt; int lda, ldb, K; };

__device__ __forceinline__ bool std_order(int i, int G, int c, int nM, int nN, int& pm, int& pn) {
    const int nwg = nM * nN; const long L = (long)i * G + c; if (L >= nwg) return false;
    int wgid = (int)L; { const int q = nwg / NXCD, r = nwg % NXCD, xcd = wgid % NXCD, off = wgid / NXCD; wgid = (xcd < r ? xcd * (q + 1) : r * (q + 1) + (xcd - r) * q) + off; }
    const int nig = WGM * nN, gid = wgid / nig, fm = gid * WGM, gsz = (nM - fm) < WGM ? (nM - fm) : WGM;
    pm = fm + ((wgid % nig) % gsz); pn = (wgid % nig) / gsz; return true;
}
struct SchedStd {
    int nM, nN, G, c; long aT, bT;
    __device__ __forceinline__ bool next(int i, Unit& u) const { if (!std_order(i, G, c, nM, nN, u.pm, u.pn)) return false; u.aoff = (unsigned)(u.pm * aT); u.boff = (unsigned)(u.pn * bT); return true; }
};

typedef int v4i_t __attribute__((ext_vector_type(4)));
typedef int v8i_t __attribute__((ext_vector_type(8)));
__device__ __forceinline__ v8i_t cat8(const bf16x8 lo, const bf16x8 hi) { const v4i_t a = __builtin_bit_cast(v4i_t, lo), b = __builtin_bit_cast(v4i_t, hi); return __builtin_shufflevector(a, b, 0, 1, 2, 3, 4, 5, 6, 7); }
template <class Epi, class Sched, bool F8 = false, int SW = 127, int SX = 127>
__device__ __forceinline__ void gemm_phase(LAS unsigned char* lds, const Gemm g, const Sched& S, const Epi& E) {
    const int tid = threadIdx.x, wid = __builtin_amdgcn_readfirstlane(tid >> 6), lane = tid & 63, wr = wid >> 2, wc = wid & 3, fr = lane & 15, fq = lane >> 4;
    const int K = g.K, nt = K / BK;
    unsigned voffA[2], voffB[2];
#pragma unroll
    for (int i = 0; i < 2; ++i) { int R, C; stage_rc(tid * 16 + i * 8192, R, C); const int Rb = Epi::PERM ? ((R & ~31) + perm32(R & 31)) : R;
        voffA[i] = (unsigned)(R * g.lda + C) * 2u; voffB[i] = (unsigned)(Rb * g.ldb + C) * 2u; }
    const unsigned kstep = (unsigned)(BK * 2);
    const unsigned hstepA = (unsigned)HALF * g.lda * 2, hstepB = (unsigned)HALF * g.ldb * 2;
    const __amdgpu_buffer_rsrc_t A_rs = __builtin_amdgcn_make_buffer_rsrc((void*)g.A, 0, -1, 0x00020000), B_rs = __builtin_amdgcn_make_buffer_rsrc((void*)g.Bt, 0, -1, 0x00020000);
    const unsigned ldsw = (unsigned)wid * 1024u;
    const int aoff = lds_byte(wr * 64 + fr, fq * 8), boff = lds_byte(wc * 32 + fr, fq * 8);
#define PG8_SA(b, h) (((b) * 2 + (h)) * HTB)
#define PG8_SB(b, h) ((4 + (b) * 2 + (h)) * HTB)
#define PG8_STAGE2(bufoff, rs, soff, voff) do { _Pragma("unroll") for (int _i = 0; _i < 2; ++_i) \
        __builtin_amdgcn_raw_ptr_buffer_load_lds(rs, (LAS void*)(lds + (bufoff) + ldsw + _i * 8192), 16, (int)(voff)[_i], (int)(soff), 0, 0); } while (0)
#define PG8_LDA(dst, b, h) do { _Pragma("unroll") for (int m = 0; m < 4; ++m) dst[m] = __builtin_shufflevector(*(const LAS v4i_t*)(lds + PG8_SA(b, h) + aoff + m * 2048), *(const LAS v4i_t*)(lds + PG8_SA(b, h) + aoff + m * 2048 + 1024), 0, 1, 2, 3, 4, 5, 6, 7); } while (0)
#define PG8_LDB(dst, b, h) do { _Pragma("unroll") for (int n = 0; n < 2; ++n) dst[n] = __builtin_shufflevector(*(const LAS v4i_t*)(lds + PG8_SB(b, h) + boff + n * 2048), *(const LAS v4i_t*)(lds + PG8_SB(b, h) + boff + n * 2048 + 1024), 0, 1, 2, 3, 4, 5, 6, 7); } while (0)
#define PG8_LO(v) __builtin_bit_cast(bf16x8, __builtin_shufflevector(v, v, 0, 1, 2, 3))
#define PG8_HI(v) __builtin_bit_cast(bf16x8, __builtin_shufflevector(v, v, 4, 5, 6, 7))
#define PG8_MMA(ai, bj, At, Bt) do { __builtin_amdgcn_s_setprio(1); _Pragma("unroll") for (int m = 0; m < 4; ++m) _Pragma("unroll") for (int n = 0; n < 2; ++n) { \
        if constexpr (F8) acc[ai][bj][m][n] = __builtin_amdgcn_mfma_scale_f32_16x16x128_f8f6f4(Bt[n], At[m], acc[ai][bj][m][n], 0, 0, 0, SW * 0x01010101, 0, SX * 0x01010101); \
        else { acc[ai][bj][m][n] = __builtin_amdgcn_mfma_f32_16x16x32_bf16(PG8_LO(Bt[n]), PG8_LO(At[m]), acc[ai][bj][m][n], 0, 0, 0); \
               acc[ai][bj][m][n] = __builtin_amdgcn_mfma_f32_16x16x32_bf16(PG8_HI(Bt[n]), PG8_HI(At[m]), acc[ai][bj][m][n], 0, 0, 0); } } __builtin_amdgcn_s_setprio(0); } while (0)
#define PG8_WAIT_V(n) asm volatile("s_waitcnt vmcnt(" #n ")" ::: "memory")
#define PG8_WAIT_L(n) asm volatile("s_waitcnt lgkmcnt(" #n ")" ::: "memory")
#define PG8_BAR __builtin_amdgcn_s_barrier()
#define PG8_SCHED __builtin_amdgcn_sched_barrier(0)
    Unit cur, nxt; int ui = 0;
    if (!S.next(0, cur)) return;
    f32x4 acc[2][2][4][2];
#pragma unroll
    for (int a = 0; a < 2; ++a)
#pragma unroll
        for (int b = 0; b < 2; ++b)
#pragma unroll
            for (int m = 0; m < 4; ++m)
#pragma unroll
                for (int n = 0; n < 2; ++n) acc[a][b][m][n] = (f32x4){0.f, 0.f, 0.f, 0.f};
    v8i_t At[4], B0[2], B1[2];
    unsigned A_c = cur.aoff, B_c = cur.boff;
    { const unsigned B_0 = B_c, B_1 = B_c + hstepB, A_0 = A_c, A_1 = A_c + hstepA;
      PG8_STAGE2(PG8_SB(0, 0), B_rs, B_0, voffB); PG8_STAGE2(PG8_SB(0, 1), B_rs, B_1, voffB); PG8_STAGE2(PG8_SA(0, 0), A_rs, A_0, voffA); PG8_STAGE2(PG8_SA(0, 1), A_rs, A_1, voffA); }
    if (wr == 1) PG8_BAR;
    PG8_WAIT_V(2); PG8_BAR;
    PG8_STAGE2(PG8_SB(1, 0), B_rs, B_c + kstep, voffB); PG8_STAGE2(PG8_SA(1, 0), A_rs, A_c + kstep, voffA); PG8_STAGE2(PG8_SB(1, 1), B_rs, B_c + hstepB + kstep, voffB);
    PG8_WAIT_V(6); PG8_BAR;
    for (;;) {
        const bool has_next = S.next(ui + 1, nxt);
        const unsigned A_n = has_next ? nxt.aoff : A_c, B_n = has_next ? nxt.boff : B_c;
#pragma unroll 1
        for (int t = 0; t < nt; t += 2) {
            const bool last = (t == nt - 2);
            const unsigned a1 = A_c + (unsigned)(t + 1) * kstep;
            const unsigned a2 = last ? A_n : A_c + (unsigned)(t + 2) * kstep, b2 = last ? B_n : B_c + (unsigned)(t + 2) * kstep;
            const unsigned a3 = a2 + kstep, b3 = b2 + kstep;
            PG8_LDB(B0, 0, 0); PG8_LDB(B1, 0, 1); PG8_SCHED; PG8_LDA(At, 0, 0); PG8_STAGE2(PG8_SA(1, 1), A_rs, a1 + hstepA, voffA);
            PG8_WAIT_V(8); PG8_WAIT_L(0); PG8_BAR; PG8_MMA(0, 0, At, B0); PG8_MMA(0, 1, At, B1); PG8_BAR; PG8_SCHED;
            PG8_LDA(At, 0, 1); PG8_STAGE2(PG8_SB(0, 0), B_rs, b2, voffB); PG8_STAGE2(PG8_SB(0, 1), B_rs, b2 + hstepB, voffB); PG8_STAGE2(PG8_SA(0, 0), A_rs, a2, voffA);
            PG8_WAIT_V(8); PG8_WAIT_L(0); PG8_BAR; PG8_MMA(1, 0, At, B0); PG8_MMA(1, 1, At, B1); PG8_BAR; PG8_SCHED;
            PG8_LDB(B0, 1, 0); PG8_LDB(B1, 1, 1); PG8_SCHED; PG8_LDA(At, 1, 0); PG8_STAGE2(PG8_SA(0, 1), A_rs, a2 + hstepA, voffA);
            PG8_WAIT_V(8); PG8_WAIT_L(0); PG8_BAR; PG8_MMA(0, 0, At, B0); PG8_MMA(0, 1, At, B1); PG8_BAR; PG8_SCHED;
            PG8_LDA(At, 1, 1); PG8_STAGE2(PG8_SB(1, 0), B_rs, b3, voffB); PG8_STAGE2(PG8_SB(1, 1), B_rs, b3 + hstepB, voffB); PG8_STAGE2(PG8_SA(1, 0), A_rs, a3, voffA);
            PG8_WAIT_V(8); PG8_WAIT_L(0); PG8_BAR; PG8_MMA(1, 0, At, B0); PG8_MMA(1, 1, At, B1); PG8_BAR; PG8_SCHED;
        }
        if (wr == 0) PG8_BAR;
        E(acc, cur, wr, wc, fr, fq);
        if (!has_next) break;
#pragma unroll
        for (int a = 0; a < 2; ++a)
#pragma unroll
            for (int b = 0; b < 2; ++b)
#pragma unroll
                for (int m = 0; m < 4; ++m)
#pragma unroll
                    for (int n = 0; n < 2; ++n) acc[a][b][m][n] = (f32x4){0.f, 0.f, 0.f, 0.f};
        cur = nxt; A_c = A_n; B_c = B_n; ++ui;
        if (wr == 1) PG8_BAR;
    }
    PG8_WAIT_V(0);
    PG8_BAR;
#undef PG8_SA
#undef PG8_SB
#undef PG8_STAGE2
#undef PG8_LDA
#undef PG8_LDB
#undef PG8_LO
#undef PG8_HI
#undef PG8_MMA
#undef PG8_WAIT_V
#undef PG8_WAIT_L
#undef PG8_BAR
#undef PG8_SCHED
}

struct EpiBf16 {
    static constexpr bool PERM = true;
    bf16* O; int ldc;
    __device__ __forceinline__ void operator()(const f32x4 (&acc)[2][2][4][2], const Unit& u, int wr, int wc, int fr, int fq) const {
        const int row0 = u.pm * BM + wr * 64 + fr, col0 = u.pn * BM + wc * 32 + 8 * fq;
#pragma unroll
        for (int ai = 0; ai < 2; ++ai)
#pragma unroll
            for (int m = 0; m < 4; ++m) { bf16* rowp = O + (size_t)(row0 + ai * HALF + m * 16) * ldc + col0;
#pragma unroll
                for (int bj = 0; bj < 2; ++bj) { const f32x4 v0 = acc[ai][bj][m][0], v1 = acc[ai][bj][m][1];
                    v4u w; w.x = pk2(v0[0], v0[1]); w.y = pk2(v0[2], v0[3]); w.z = pk2(v1[0], v1[1]); w.w = pk2(v1[2], v1[3]);
                    *(v4u*)(rowp + bj * HALF) = w; } }
    }
};
struct EpiSwiglu {
    static constexpr bool PERM = true;
    bf16* O; int ldc;
    __device__ __forceinline__ void operator()(const f32x4 (&acc)[2][2][4][2], const Unit& u, int wr, int wc, int fr, int fq) const {
        const int row0 = u.pm * BM + wr * 64 + fr, col0 = u.pn * HALF + wc * 32 + 8 * fq;
#pragma unroll
        for (int ai = 0; ai < 2; ++ai)
#pragma unroll
            for (int m = 0; m < 4; ++m) { bf16* rowp = O + (size_t)(row0 + ai * HALF + m * 16) * ldc + col0;
                float o[8];
#pragma unroll
                for (int n = 0; n < 2; ++n)
#pragma unroll
                    for (int j = 0; j < 4; ++j) { const float gt = acc[ai][0][m][n][j], up = acc[ai][1][m][n][j]; o[n * 4 + j] = gt * __builtin_amdgcn_rcpf(1.0f + __expf(-gt)) * up; }
                v4u w; w.x = pk2(o[0], o[1]); w.y = pk2(o[2], o[3]); w.z = pk2(o[4], o[5]); w.w = pk2(o[6], o[7]);
                *(v4u*)rowp = w; }
    }
};
struct EpiSwigluF8 {
    static constexpr bool PERM = true;
    unsigned char* O; int ldc; float scale;
    __device__ __forceinline__ void operator()(const f32x4 (&acc)[2][2][4][2], const Unit& u, int wr, int wc, int fr, int fq) const {
        const int row0 = u.pm * BM + wr * 64 + fr, col0 = u.pn * HALF + wc * 32 + 8 * fq;
#pragma unroll
        for (int ai = 0; ai < 2; ++ai)
#pragma unroll
            for (int m = 0; m < 4; ++m) { unsigned char* rowp = O + (size_t)(row0 + ai * HALF + m * 16) * ldc + col0;
                float o[8];
#pragma unroll
                for (int n = 0; n < 2; ++n)
#pragma unroll
                    for (int j = 0; j < 4; ++j) { const float gt = acc[ai][0][m][n][j], up = acc[ai][1][m][n][j]; o[n * 4 + j] = gt * __builtin_amdgcn_rcpf(1.0f + __expf(-gt)) * up * scale; }
                v2u w; w.x = pk4_fp8(o[0], o[1], o[2], o[3]); w.y = pk4_fp8(o[4], o[5], o[6], o[7]);
                *(v2u*)rowp = w; }
    }
};
struct EpiResF32 {
    static constexpr bool PERM = false;
    const float* base; float* out; int ldc;
    __device__ __forceinline__ void operator()(const f32x4 (&acc)[2][2][4][2], const Unit& u, int wr, int wc, int fr, int fq) const {
        const int row0 = u.pm * BM + wr * 64 + fr, col0 = u.pn * BM + wc * 32 + 4 * fq;
#pragma unroll
        for (int ai = 0; ai < 2; ++ai)
#pragma unroll
            for (int m = 0; m < 4; ++m) { const size_t off = (size_t)(row0 + ai * HALF + m * 16) * ldc + col0;
#pragma unroll
                for (int bj = 0; bj < 2; ++bj)
#pragma unroll
                    for (int n = 0; n < 2; ++n) { f32x4 v = acc[ai][bj][m][n]; if (base) v += *(const f32x4*)(base + off + bj * HALF + n * 16); *(f32x4*)(out + off + bj * HALF + n * 16) = v; } }
    }
};
struct EpiRgIn {
    static constexpr bool PERM = true;
    bf16* Y; bf16* XBR;
    __device__ __forceinline__ void operator()(const f32x4 (&acc)[2][2][4][2], const Unit& u, int wr, int wc, int fr, int fq) const {
        const bool isy = u.pn < 8; bf16* O = isy ? Y : XBR;
        const int row0 = u.pm * BM + wr * 64 + fr, col0 = (u.pn & 7) * BM + wc * 32 + 8 * fq;
#pragma unroll
        for (int ai = 0; ai < 2; ++ai)
#pragma unroll
            for (int m = 0; m < 4; ++m) { bf16* rowp = O + (size_t)(row0 + ai * HALF + m * 16) * D + col0;
#pragma unroll
                for (int bj = 0; bj < 2; ++bj) { float o[8];
#pragma unroll
                    for (int n = 0; n < 2; ++n)
#pragma unroll
                        for (int j = 0; j < 4; ++j) { float x = acc[ai][bj][m][n][j];
                            if (isy) { const float y2 = 1.5957691216f * (x + 0.044715f * x * x * x); x = x * __builtin_amdgcn_rcpf(1.0f + __expf(-y2)); }
                            o[n * 4 + j] = x; }
                    v4u w; w.x = pk2(o[0], o[1]); w.y = pk2(o[2], o[3]); w.z = pk2(o[4], o[5]); w.w = pk2(o[6], o[7]);
                    *(v4u*)(rowp + bj * HALF) = w; } }
    }
};
struct EpiGates {
    static constexpr bool PERM = false;
    const bf16* XC; const float* ba; const float* bx; const float* lam; float* AA; float* BB;
    __device__ __forceinline__ void operator()(const f32x4 (&acc)[2][2][4][2], const Unit& u, int wr, int wc, int fr, int fq) const {
        const int row0 = u.pm * BM + wr * 64 + fr, col0 = u.pn * HALF + wc * 32 + 4 * fq;
#pragma unroll
        for (int n = 0; n < 2; ++n) { const int col = col0 + n * 16;
            const f32x4 vba = *(const f32x4*)(ba + col), vbx = *(const f32x4*)(bx + col), sp = *(const f32x4*)(lam + col);
#pragma unroll
            for (int ai = 0; ai < 2; ++ai)
#pragma unroll
                for (int m = 0; m < 4; ++m) { const size_t off = (size_t)(row0 + ai * HALF + m * 16) * D + col;
                    const v2u xw = *(const v2u*)(XC + off); const float xc[4] = {bflo(xw.x), bfhi(xw.x), bflo(xw.y), bfhi(xw.y)};
                    f32x4 oa, ob;
#pragma unroll
                    for (int j = 0; j < 4; ++j) { const float r = sigmoidf_(acc[ai][0][m][n][j] + vba[j]), gi = sigmoidf_(acc[ai][1][m][n][j] + vbx[j]);
                        const float la = sp[j] * r, t2 = 2.0f * la; oa[j] = __expf(la);
                        const float em = (t2 > -0.01f) ? -t2 * (1.0f + 0.5f * t2 * (1.0f + 0.33333334f * t2)) : 1.0f - __expf(t2);
                        ob[j] = sqrtf(fmaxf(em, 0.f)) * (gi * xc[j]); }
                    *(f32x4*)(AA + off) = oa; *(f32x4*)(BB + off) = ob; asm volatile("" ::: "memory"); } }
    }
};
}

#define XB_TMO      128
#define XB_XCNT(j)  (256  + 64 * (j))
#define XB_XSUB(j)  (1280 + 64 * (j))
#define XB_XGEN(j)  (2304 + 64 * (j))
#define XB_TOP      3328
#define XB_TOPGEN   3392
#define XCD_BAR_WORDS 3456
#define XB_SPIN_CAP (1u << 22)
__device__ __forceinline__ unsigned xb_ld(unsigned* p)              { return __hip_atomic_load(p, __ATOMIC_RELAXED, __HIP_MEMORY_SCOPE_AGENT); }
__device__ __forceinline__ unsigned xb_add(unsigned* p, unsigned v) { return __hip_atomic_fetch_add(p, v, __ATOMIC_RELAXED, __HIP_MEMORY_SCOPE_AGENT); }
__device__ __forceinline__ unsigned xb_xcc_id() { return (unsigned)__builtin_amdgcn_s_getreg((3 << 11) | 20) & 0xFu; }
#define XB_SPIN(cond, bar) do { unsigned _sp = 0; while (cond) { __builtin_amdgcn_s_sleep(1); \
    if ((++_sp & 255u) == 0u) { if (xb_ld(&(bar)[XB_TMO])) break; if (_sp > XB_SPIN_CAP) { atomicAdd(&(bar)[XB_TMO], 1u); break; } } } } while (0)
struct XcdBarrier { unsigned* bar; unsigned x; volatile LAS unsigned* st; };
__device__ __forceinline__ XcdBarrier xcd_barrier_post(unsigned* bar, volatile LAS unsigned* st) {
    XcdBarrier b; b.bar = bar; b.x = xb_xcc_id(); b.st = st;
    if (threadIdx.x == 0) (void)xb_add(&bar[XB_XCNT(b.x)], 1u);
    return b;
}
__device__ __forceinline__ void xcd_barrier_complete(unsigned* bar, unsigned x, unsigned& nloc, unsigned& nx) {
    const unsigned G = gridDim.x * gridDim.y * gridDim.z;
    unsigned sum, cnt, mine, sp = 0u;
    for (;;) {
        sum = 0u; cnt = 0u; mine = 0u;
#pragma unroll
        for (unsigned j = 0; j < 16; ++j) { const unsigned c = xb_ld(&bar[XB_XCNT(j)]); sum += c; cnt += (c > 0u) ? 1u : 0u; mine = (j == x) ? c : mine; }
        if (sum == G) break;
        __builtin_amdgcn_s_sleep(1);
        if ((++sp & 255u) == 0u) { if (xb_ld(&bar[XB_TMO])) break; if (sp > XB_SPIN_CAP) { atomicAdd(&bar[XB_TMO], 1u); break; } }
    }
    nloc = mine > 0u ? mine : 1u; nx = cnt > 0u ? cnt : 1u;
}
__device__ __forceinline__ void xcd_barrier(const XcdBarrier& b) {
    asm volatile("s_waitcnt vmcnt(0)" ::: "memory");
    __syncthreads();
    if (threadIdx.x == 0) {
        unsigned* bar = b.bar;
        __builtin_amdgcn_s_waitcnt(0);
        unsigned nloc = b.st[0], nx = b.st[1];
        if (nloc == 0u) { xcd_barrier_complete(bar, b.x, nloc, nx); b.st[0] = nloc; b.st[1] = nx; }
        const unsigned old = xb_add(&bar[XB_XSUB(b.x)], 1u);
        const unsigned gen = old / nloc;
        if (old + 1u == (gen + 1u) * nloc) {
            __builtin_amdgcn_fence(__ATOMIC_RELEASE, "agent");
            asm volatile("s_waitcnt vmcnt(0)" ::: "memory");
            const unsigned og = xb_add(&bar[XB_TOP], 1u);
            const unsigned tg = og / nx;
            if (og + 1u == (tg + 1u) * nx) xb_add(&bar[XB_TOPGEN], 1u);
            else XB_SPIN(xb_ld(&bar[XB_TOPGEN]) == tg, bar);
            __builtin_amdgcn_fence(__ATOMIC_ACQUIRE, "agent");
            xb_add(&bar[XB_XGEN(b.x)], 1u);
            asm volatile("s_waitcnt vmcnt(0)" ::: "memory");
        } else {
            XB_SPIN(xb_ld(&bar[XB_XGEN(b.x)]) == gen, bar);
            __builtin_amdgcn_fence(__ATOMIC_ACQUIRE, "agent");
            asm volatile("s_waitcnt vmcnt(0)" ::: "memory");
        }
    }
    __syncthreads();
}

struct Frame {
    LAS unsigned char* lds;
    int tid, lane, wave, G, blk;
    unsigned char* ws;
    const float* in[25];
    float* out;
};
enum { I_X = 0, I_NORMW, I_FNW, I_MIXIN, I_GCONV, I_ALOG, I_DTB, I_GNW, I_LBL, I_HNW, I_MIXOUT, I_FGU, I_FD, I_RGIN, I_RGCW, I_RGCB, I_RGAW, I_RGAB, I_RGXW, I_RGXB, I_LAM, I_RGOUT, I_ROUTER, I_MGU, I_MD };

struct Job { const float* src; bf16* dst; int ld, K, n0, ncols, drow0, mode, nbatch; long sbs; int dbs; int f8; float scale; };
__device__ __forceinline__ void conv_item(const Job& jb, LAS float* scr, int item, int lane) {
    const int nblk = jb.ncols / 32, per = (jb.K / 64) * nblk, b = item / per, r = item % per, kb = r / nblk, nb = r % nblk, k0 = 64 * kb, n0l = 32 * nb;
    const float* sp = jb.src + (size_t)b * jb.sbs + (size_t)k0 * jb.ld + jb.n0 + n0l;
#pragma unroll 8
    for (int i = 0; i < 32; ++i) { const int kk = 2 * i + (lane >> 5); scr[kk * 33 + (lane & 31)] = sp[(size_t)kk * jb.ld + (lane & 31)]; }
    LDS_WAIT(); asm volatile("" ::: "memory");
    const int c = lane & 7;
#pragma unroll
    for (int j = 0; j < 4; ++j) { const int n = (lane >> 3) + 8 * j, nl = n0l + n; const LAS float* s = scr + (8 * c) * 33 + n;
        const int drow = jb.drow0 + b * jb.dbs + (jb.mode ? ((nl >> 7) * 256 + (nl & 127)) : nl);
        if (jb.f8) { const float sc = jb.scale; v2u o; o.x = pk4_fp8(s[0 * 33] * sc, s[1 * 33] * sc, s[2 * 33] * sc, s[3 * 33] * sc); o.y = pk4_fp8(s[4 * 33] * sc, s[5 * 33] * sc, s[6 * 33] * sc, s[7 * 33] * sc);
            *(v2u*)((unsigned char*)jb.dst + (size_t)drow * jb.K + k0 + 8 * c) = o; }
        else { v4u o; o.x = pk2(s[0 * 33], s[1 * 33]); o.y = pk2(s[2 * 33], s[3 * 33]); o.z = pk2(s[4 * 33], s[5 * 33]); o.w = pk2(s[6 * 33], s[7 * 33]);
            *(v4u*)(jb.dst + (size_t)drow * jb.K + k0 + 8 * c) = o; } }
    LDS_WAIT(); asm volatile("" ::: "memory");
}
constexpr int NJOBS = 13;
__device__ __forceinline__ Job get_job(const Frame& F, int j) {
    Job b; b.n0 = 0; b.drow0 = 0; b.mode = 0; b.nbatch = 1; b.sbs = 0; b.dbs = 0; b.f8 = 0; b.scale = 1.0f;
    unsigned char* ws = F.ws;
    switch (j) {
    case 0:  b.src = F.in[I_MIXIN]; b.dst = (bf16*)(ws + O_WMI); b.ld = MIXLD; b.K = D; b.ncols = 4096; break;
    case 1:  b.src = F.in[I_MIXIN]; b.dst = (bf16*)(ws + O_WMI); b.ld = MIXLD; b.K = D; b.n0 = 4112; b.ncols = 4096; b.drow0 = 4096; break;
    case 2:  b.src = F.in[I_MIXOUT]; b.dst = (bf16*)(ws + O_WMO); b.ld = D; b.K = D; b.ncols = D; break;
    case 3:  b.src = F.in[I_FGU]; b.dst = (bf16*)(ws + O_WFG); b.ld = 2 * FF; b.K = D; b.ncols = FF; b.mode = 1; break;
    case 4:  b.src = F.in[I_FGU]; b.dst = (bf16*)(ws + O_WFG); b.ld = 2 * FF; b.K = D; b.n0 = FF; b.ncols = FF; b.drow0 = 128; b.mode = 1; break;
    case 5:  b.src = F.in[I_FD]; b.dst = (bf16*)(ws + O_WFD); b.ld = D; b.K = FF; b.ncols = D; break;
    case 6:  b.src = F.in[I_RGIN]; b.dst = (bf16*)(ws + O_WRI); b.ld = 2 * D; b.K = D; b.ncols = 2 * D; break;
    case 7:  b.src = F.in[I_RGAW]; b.dst = (bf16*)(ws + O_WRG); b.ld = 256; b.K = 256; b.ncols = 256; b.mode = 1; b.nbatch = 8; b.sbs = 65536; b.dbs = 512; break;
    case 8:  b.src = F.in[I_RGXW]; b.dst = (bf16*)(ws + O_WRG); b.ld = 256; b.K = 256; b.ncols = 256; b.drow0 = 128; b.mode = 1; b.nbatch = 8; b.sbs = 65536; b.dbs = 512; break;
    case 9:  b.src = F.in[I_RGOUT]; b.dst = (bf16*)(ws + O_WRO); b.ld = D; b.K = D; b.ncols = D; break;
    case 10: b.src = F.in[I_MGU]; b.dst = (bf16*)(ws + O_WMG); b.ld = 2 * FE; b.K = D; b.ncols = FE; b.mode = 1; b.nbatch = 8; b.sbs = (long)D * 2 * FE; b.dbs = 2 * FE; b.f8 = MOE_F8; b.scale = MOE_F8 ? 64.0f : 1.0f; break;
    case 11: b.src = F.in[I_MGU]; b.dst = (bf16*)(ws + O_WMG); b.ld = 2 * FE; b.K = D; b.n0 = FE; b.ncols = FE; b.drow0 = 128; b.mode = 1; b.nbatch = 8; b.sbs = (long)D * 2 * FE; b.dbs = 2 * FE; b.f8 = MOE_F8; b.scale = MOE_F8 ? 64.0f : 1.0f; break;
    default: b.src = F.in[I_MD]; b.dst = (bf16*)(ws + O_WMD); b.ld = D; b.K = FE; b.ncols = D; b.nbatch = 8; b.sbs = (long)FE * D; b.dbs = D; b.f8 = MOE_F8; b.scale = MOE_F8 ? 128.0f : 1.0f; break;
    }
    return b;
}
constexpr int job_items(int j) { return j == 0 || j == 1 ? 32 * 128 : j == 2 ? 32 * 64 : j == 3 || j == 4 ? 32 * 176 : j == 5 ? 88 * 64 : j == 6 ? 32 * 128 : j == 7 || j == 8 ? 8 * 4 * 8 : j == 9 ? 32 * 64 : j == 10 || j == 11 ? 8 * 32 * 224 : 8 * 112 * 64; }
constexpr int job_cum(int j) { int s = 0; for (int k = 2; k < j; ++k) s += job_items(k); return s; }
__device__ __forceinline__ void convert_queue(const Frame& F, unsigned* qhead) {
    LAS float* scr = (LAS float*)(F.lds + F.wave * 16384);
    constexpr int total = job_cum(NJOBS);
    for (;;) {
        unsigned base = 0;
        if (F.lane == 0) base = __hip_atomic_fetch_add(qhead, 16u, __ATOMIC_RELAXED, __HIP_MEMORY_SCOPE_AGENT);
        base = (unsigned)__builtin_amdgcn_readfirstlane((int)base);
        if ((int)base >= total) break;
        for (int i = 0; i < 16; ++i) { const int it = (int)base + i; if (it >= total) break;
            int j = 2;
#pragma unroll
            for (int k = 3; k < NJOBS; ++k) j += (it >= job_cum(k)) ? 1 : 0;
            int c = 0;
#pragma unroll
            for (int k = 3; k < NJOBS; ++k) c = (it >= job_cum(k)) ? job_cum(k) : c;
            const Job jb = get_job(F, j);
            conv_item(jb, scr, it - c, F.lane); }
    }
}
__device__ __forceinline__ void convert_jobs(const Frame& F, int j0, int j1, int gw, int ngw) {
    LAS float* scr = (LAS float*)(F.lds + F.wave * 16384);
    for (int j = j0; j < j1; ++j) { const Job jb = get_job(F, j); const int nitems = jb.nbatch * (jb.K / 64) * (jb.ncols / 32);
        for (int it = gw; it < nitems; it += ngw) conv_item(jb, scr, it, F.lane); }
}

__device__ __forceinline__ void rms_load(const float* xrow, const float* nw, int lane, f32x4 (&v)[8]) {
    float s = 0.f;
#pragma unroll
    for (int j = 0; j < 8; ++j) { v[j] = ((const f32x4*)xrow)[lane + 64 * j]; s += (v[j].x * v[j].x + v[j].y * v[j].y) + (v[j].z * v[j].z + v[j].w * v[j].w); }
    const float rstd = rsqrtf(wave_sum(s) * (1.0f / D) + EPS);
#pragma unroll
    for (int j = 0; j < 8; ++j) { const f32x4 w = ((const f32x4*)nw)[lane + 64 * j]; v[j] = v[j] * rstd * w; }
}
__device__ __forceinline__ void row_store_bf16(bf16* orow, int lane, const f32x4 (&v)[8]) {
#pragma unroll
    for (int j = 0; j < 8; ++j) { v2u w; w.x = pk2(v[j].x, v[j].y); w.y = pk2(v[j].z, v[j].w); ((v2u*)orow)[lane + 64 * j] = w; }
}

__device__ __forceinline__ void phase_prologue(const Frame& F) {
    const int gw = F.blk * 8 + F.wave, ngw = F.G * 8;
    convert_jobs(F, 0, 2, gw, ngw);
    if (F.blk == 0) for (int i = F.tid; i < D; i += 512) ((float*)(F.ws + O_SPL))[i] = -8.0f * log1pf(__expf(-F.in[I_LAM][i]));
    __syncthreads();
    LAS float* w16 = (LAS float*)F.lds;
    const float* W = F.in[I_MIXIN];
    for (int idx = F.tid; idx < D * 16; idx += 512) { const int c = idx & 15, i = idx >> 4; w16[c * 2052 + i] = W[(size_t)i * MIXLD + 4096 + c]; }
    __syncthreads();
    const float* nw = F.in[I_NORMW];
    bf16* XN = (bf16*)(F.ws + O_XN); float* GB = (float*)(F.ws + O_GB);
    for (int m = gw; m < T; m += ngw) {
        f32x4 v[8]; rms_load(F.in[I_X] + (size_t)m * D, nw, F.lane, v);
        row_store_bf16(XN + (size_t)m * D, F.lane, v);
        float mine = 0.f;
#pragma unroll 1
        for (int c = 0; c < 16; ++c) { float a = 0.f;
#pragma unroll
            for (int j = 0; j < 8; ++j) { const f32x4 w = *(const LAS f32x4*)(w16 + c * 2052 + 4 * F.lane + 256 * j); a += (v[j].x * w.x + v[j].y * w.y) + (v[j].z * w.z + v[j].w * w.w); }
            a = wave_sum(a); if (F.lane == c) mine = a; }
        if (F.lane < 8) GB[(size_t)m * 16 + F.lane] = sigmoidf_(mine);
        else if (F.lane < 16) { const int h = F.lane - 8; GB[(size_t)m * 16 + F.lane] = -__expf(F.in[I_ALOG][h]) * softplusf_(mine + F.in[I_DTB][h]); }
    }
    __syncthreads();
}

__device__ __forceinline__ void phase_rms(const Frame& F, const float* X, const float* nw) {
    const int gw = F.blk * 8 + F.wave, ngw = F.G * 8; bf16* XN = (bf16*)(F.ws + O_XN);
    for (int m = gw; m < T; m += ngw) { f32x4 v[8]; rms_load(X + (size_t)m * D, nw, F.lane, v); row_store_bf16(XN + (size_t)m * D, F.lane, v); }
}

__device__ __forceinline__ void phase_mix_pre(const Frame& F) {
    const int gw = F.blk * 8 + F.wave, ngw = F.G * 8, lane = F.lane;
    const bf16* P = (const bf16*)(F.ws + O_PROJ);
    float* QF = (float*)(F.ws + O_QF); float* KF = (float*)(F.ws + O_KF); float* VF = (float*)(F.ws + O_VF); float* FH = (float*)(F.ws + O_FH); float* QH = (float*)(F.ws + O_QH);
    const float* cw = F.in[I_GCONV];
    const float* lbl = F.in[I_LBL];
    for (int it = gw; it < T * 8; it += ngw) {
        const int t = it >> 3, h = it & 7, s = t & (SEQ - 1), d = h * 128 + 2 * lane;
        float r[3][2];
#pragma unroll
        for (int mat = 0; mat < 3; ++mat) { float a0 = 0.f, a1 = 0.f;
#pragma unroll
            for (int j = 0; j < 4; ++j) { if (s - 3 + j >= 0) { const unsigned w = *(const unsigned*)(P + (size_t)(t - 3 + j) * NPROJ + mat * 1024 + d);
                    const f32x2 c = *(const f32x2*)(cw + j * 3072 + mat * 1024 + d); a0 += c.x * bflo(w); a1 += c.y * bfhi(w); } }
            r[mat][0] = siluf_(a0); r[mat][1] = siluf_(a1); }
        const float qs = wave_sum(r[0][0] * r[0][0] + r[0][1] * r[0][1]), ks = wave_sum(r[1][0] * r[1][0] + r[1][1] * r[1][1]);
        const float qn = rsqrtf(qs + EPS) * 0.08838834764831845f, kn = rsqrtf(ks + EPS);
        const size_t o = (size_t)t * 1024 + d;
        *(f32x2*)(QF + o) = (f32x2){r[0][0] * qn, r[0][1] * qn}; *(f32x2*)(KF + o) = (f32x2){r[1][0] * kn, r[1][1] * kn}; *(f32x2*)(VF + o) = (f32x2){r[2][0], r[2][1]};
        const unsigned wq = *(const unsigned*)(P + (size_t)t * NPROJ + PQ_BQ + d), wf = *(const unsigned*)(P + (size_t)t * NPROJ + PQ_BF + d);
        const f32x2 l0 = *(const f32x2*)(lbl + d), l1 = *(const f32x2*)(lbl + 1024 + d);
        const float lb0 = sigmoidf_(l0.x - l1.x), lb1 = sigmoidf_(l0.y - l1.y);
        *(f32x2*)(FH + o) = (f32x2){lb0 + (1.f - lb0) * sigmoidf_(bflo(wf)), lb1 + (1.f - lb1) * sigmoidf_(bfhi(wf))};
        *(f32x2*)(QH + o) = (f32x2){siluf_(bflo(wq)) * 0.08838834764831845f, siluf_(bfhi(wq)) * 0.08838834764831845f};
    }
}

__device__ __forceinline__ void phase_mix_scan_slow(const Frame& F) {
    if (F.blk >= 32) return;
    const int mixer = F.blk >> 4, b = (F.blk >> 3) & 1, h = F.blk & 7, tid = F.tid;
    if (mixer == 0 && FAST_GDN) return;
    if (mixer == 1 && FAST_HGRN) return;
    LAS float* ks = (LAS float*)F.lds;
    LAS float* qs = ks + 8192; LAS float* vs = qs + 8192; LAS float* ot = vs + 8192;
    LAS float* red1 = ot + 8192; LAS float* red2 = red1 + 512; LAS float* ab = red2 + 512;
    const float* KSRC = (const float*)(F.ws + (mixer ? O_FH : O_KF)); const float* QSRC = (const float*)(F.ws + (mixer ? O_QH : O_QF)); const float* VSRC = (const float*)(F.ws + O_VF);
    const bf16* P = (const bf16*)(F.ws + O_PROJ); const float* GB = (const float*)(F.ws + O_GB);
    bf16* O = (bf16*)(F.ws + O_O);
    const float* nw = mixer ? F.in[I_HNW] : F.in[I_GNW];
    const int e = tid & 127, qd = tid >> 7;
    float S[32];
#pragma unroll
    for (int i = 0; i < 32; ++i) S[i] = 0.f;
    for (int n = 0; n < 64; ++n) {
        const int t0 = b * SEQ + n * 64;
        for (int idx = tid; idx < 64 * 32; idx += 512) { const int r = idx >> 5, c4 = (idx & 31) * 4; const size_t go = (size_t)(t0 + r) * 1024 + h * 128 + c4;
            *(LAS f32x4*)(ks + r * 128 + c4) = *(const f32x4*)(KSRC + go); *(LAS f32x4*)(qs + r * 128 + c4) = *(const f32x4*)(QSRC + go);
            f32x4 vv; if (mixer) { const v2u w = *(const v2u*)(P + (size_t)(t0 + r) * NPROJ + PQ_BI + h * 128 + c4); vv = (f32x4){bflo(w.x), bfhi(w.x), bflo(w.y), bfhi(w.y)}; } else vv = *(const f32x4*)(VSRC + go);
            *(LAS f32x4*)(vs + r * 128 + c4) = vv; }
        if (tid < 64) { ab[tid * 2] = __expf(GB[(size_t)(t0 + tid) * 16 + 8 + h]); ab[tid * 2 + 1] = GB[(size_t)(t0 + tid) * 16 + h]; }
        __syncthreads();
        for (int r = 0; r < 64; ++r) {
            const LAS float* kr = ks + r * 128 + qd * 32; const LAS float* qr = qs + r * 128 + qd * 32; const float ve = vs[r * 128 + e];
            float osum = 0.f;
            if (mixer == 0) {
                const float a = ab[r * 2], bt = ab[r * 2 + 1];
                float p = 0.f;
#pragma unroll
                for (int i = 0; i < 32; ++i) p += kr[i] * S[i];
                red1[qd * 128 + e] = p;
                __syncthreads();
                const float kS = (red1[e] + red1[128 + e]) + (red1[256 + e] + red1[384 + e]);
                const float c1 = bt * (ve - a * kS);
#pragma unroll
                for (int i = 0; i < 32; ++i) { S[i] = a * S[i] + kr[i] * c1; osum += qr[i] * S[i]; }
            } else {
#pragma unroll
                for (int i = 0; i < 32; ++i) { const float f = kr[i]; S[i] = f * S[i] + (1.f - f) * ve; osum += qr[i] * S[i]; }
            }
            red2[qd * 128 + e] = osum;
            __syncthreads();
            if (tid < 128) ot[r * 128 + e] = (red2[e] + red2[128 + e]) + (red2[256 + e] + red2[384 + e]);
        }
        __syncthreads();
        {
            const int r = tid >> 3, c0 = (tid & 7) * 16; float o[16]; float ss = 0.f;
#pragma unroll
            for (int i = 0; i < 16; ++i) { o[i] = ot[r * 128 + c0 + i]; ss += o[i] * o[i]; }
            ss += __shfl_xor(ss, 1); ss += __shfl_xor(ss, 2); ss += __shfl_xor(ss, 4);
            const float rstd = rsqrtf(ss * (1.0f / 128.0f) + EPS);
            const bf16* zp = P + (size_t)(t0 + r) * NPROJ + (mixer ? PQ_BG : PQ_AZ) + h * 128 + c0;
            const v4u z0 = *(const v4u*)zp, z1 = *(const v4u*)(zp + 8);
            const unsigned zw[8] = {z0.x, z0.y, z0.z, z0.w, z1.x, z1.y, z1.z, z1.w};
            unsigned ow[8];
#pragma unroll
            for (int i = 0; i < 8; ++i) { const float za = bflo(zw[i]), zb = bfhi(zw[i]);
                ow[i] = pk2(o[2 * i] * rstd * nw[c0 + 2 * i] * siluf_(za), o[2 * i + 1] * rstd * nw[c0 + 2 * i + 1] * siluf_(zb)); }
            bf16* op = O + (size_t)(t0 + r) * D + mixer * 1024 + h * 128 + c0;
            *(v4u*)op = (v4u){ow[0], ow[1], ow[2], ow[3]}; *(v4u*)(op + 8) = (v4u){ow[4], ow[5], ow[6], ow[7]};
        }
        __syncthreads();
    }
}


constexpr int R_NW = 0, R_QD = 16384, R_QK = 32768, R_KDT = 40960, R_DEC = 57344;
__device__ __forceinline__ int frag_off(int row, int k, int nkb) { const int mt = row >> 4, kb = k >> 5, r = row & 15, k5 = k & 31, g = (k5 >> 2) & 3, j = (k5 >> 4) * 4 + (k5 & 3); return ((mt * nkb + kb) * 64 + g * 16 + r) * 16 + j * 2; }
__device__ __forceinline__ bf16x8 pack8(const f32x4 a, const f32x4 b) { v4u w; w.x = pk2(a[0], a[1]); w.y = pk2(a[2], a[3]); w.z = pk2(b[0], b[1]); w.w = pk2(b[2], b[3]); return __builtin_bit_cast(bf16x8, w); }
#define SBAR() do { asm volatile("s_waitcnt lgkmcnt(0)" ::: "memory"); __builtin_amdgcn_s_barrier(); asm volatile("" ::: "memory"); } while (0)

__device__ __forceinline__ void store_frag_row16(unsigned char* base, int row, int cb, int nkb, const float (&x)[16]) {
#pragma unroll
    for (int a = 0; a < 4; ++a) { v2u w; w.x = pk2(x[4 * a], x[4 * a + 1]); w.y = pk2(x[4 * a + 2], x[4 * a + 3]); *(v2u*)(base + frag_off(row, cb * 16 + 4 * a, nkb)) = w; }
}

__device__ __forceinline__ void gdn_prep_unit(const Frame& F, int b, int h, int n) {
    const int tid = F.tid, lane = F.lane, wave = F.wave, r = tid >> 3, cb = tid & 7, t0 = b * SEQ + n * 64, seq = b * 8 + h;
    LAS bf16* KB = (LAS bf16*)F.lds;
    LAS bf16* QB = (LAS bf16*)(F.lds + 17408);
    LAS float* LM = (LAS float*)(F.lds + 34816);
    LAS float* RHS = (LAS float*)(F.lds + 52224);
    LAS float* GC = (LAS float*)(F.lds + 117760);
    const bf16* P = (const bf16*)(F.ws + O_PROJ); const float* GB = (const float*)(F.ws + O_GB); const float* cw = F.in[I_GCONV];
    unsigned char* rec = F.ws + O_OPS + ((size_t)seq * 64 + n) * REC_BYTES; float* UT = (float*)(F.ws + O_UT) + ((size_t)seq * 64 + n) * 8192;
    float q[16], k[16], v[16];
    {
        const int s = n * 64 + r;
#pragma unroll
        for (int mat = 0; mat < 3; ++mat) { float a[16];
#pragma unroll
            for (int i = 0; i < 16; ++i) a[i] = 0.f;
#pragma unroll
            for (int j = 0; j < 4; ++j) { if (s - 3 + j >= 0) { const bf16* pp = P + (size_t)(t0 + r - 3 + j) * NPROJ + mat * 1024 + h * 128 + cb * 16; const v4u w0 = *(const v4u*)pp, w1 = *(const v4u*)(pp + 8);
                    const float* cp = cw + j * 3072 + mat * 1024 + h * 128 + cb * 16; const f32x4 c0 = *(const f32x4*)cp, c1 = *(const f32x4*)(cp + 4), c2 = *(const f32x4*)(cp + 8), c3 = *(const f32x4*)(cp + 12);
                    a[0] += c0.x * bflo(w0.x); a[1] += c0.y * bfhi(w0.x); a[2] += c0.z * bflo(w0.y); a[3] += c0.w * bfhi(w0.y); a[4] += c1.x * bflo(w0.z); a[5] += c1.y * bfhi(w0.z); a[6] += c1.z * bflo(w0.w); a[7] += c1.w * bfhi(w0.w);
                    a[8] += c2.x * bflo(w1.x); a[9] += c2.y * bfhi(w1.x); a[10] += c2.z * bflo(w1.y); a[11] += c2.w * bfhi(w1.y); a[12] += c3.x * bflo(w1.z); a[13] += c3.y * bfhi(w1.z); a[14] += c3.z * bflo(w1.w); a[15] += c3.w * bfhi(w1.w); } }
#pragma unroll
            for (int i = 0; i < 16; ++i) { const float y = siluf_(a[i]); if (mat == 0) q[i] = y; else if (mat == 1) k[i] = y; else v[i] = y; } }
        float qs = 0.f, ks = 0.f;
#pragma unroll
        for (int i = 0; i < 16; ++i) { qs += q[i] * q[i]; ks += k[i] * k[i]; }
        qs += __shfl_xor(qs, 1); qs += __shfl_xor(qs, 2); qs += __shfl_xor(qs, 4); ks += __shfl_xor(ks, 1); ks += __shfl_xor(ks, 2); ks += __shfl_xor(ks, 4);
        const float qn = rsqrtf(qs + EPS) * 0.08838834764831845f, kn = rsqrtf(ks + EPS);
#pragma unroll
        for (int i = 0; i < 16; ++i) { q[i] *= qn; k[i] *= kn; }
        if (cb == 0) { GC[64 + r] = GB[(size_t)(t0 + r) * 16 + h]; GC[128 + r] = GB[(size_t)(t0 + r) * 16 + 8 + h]; }
        v4u w0, w1; w0.x = pk2(k[0], k[1]); w0.y = pk2(k[2], k[3]); w0.z = pk2(k[4], k[5]); w0.w = pk2(k[6], k[7]); w1.x = pk2(k[8], k[9]); w1.y = pk2(k[10], k[11]); w1.z = pk2(k[12], k[13]); w1.w = pk2(k[14], k[15]);
        *(LAS v4u*)(KB + r * 136 + cb * 16) = w0; *(LAS v4u*)(KB + r * 136 + cb * 16 + 8) = w1;
        w0.x = pk2(q[0], q[1]); w0.y = pk2(q[2], q[3]); w0.z = pk2(q[4], q[5]); w0.w = pk2(q[6], q[7]); w1.x = pk2(q[8], q[9]); w1.y = pk2(q[10], q[11]); w1.z = pk2(q[12], q[13]); w1.w = pk2(q[14], q[15]);
        *(LAS v4u*)(QB + r * 136 + cb * 16) = w0; *(LAS v4u*)(QB + r * 136 + cb * 16 + 8) = w1;
    }
    __syncthreads();
    if (wave == 0) { float x = GC[128 + lane];
#pragma unroll
        for (int o = 1; o < 64; o <<= 1) { const float y = __shfl_up(x, o); if (lane >= o) x += y; }
        GC[lane] = x; }
    __syncthreads();
    const float gcr = GC[r], betar = GC[64 + r], egr = __expf(gcr), gclast = GC[63];
    {
#pragma unroll
        for (int a = 0; a < 4; ++a) { *(LAS f32x4*)(RHS + r * 256 + cb * 16 + 4 * a) = (f32x4){v[4 * a] * betar, v[4 * a + 1] * betar, v[4 * a + 2] * betar, v[4 * a + 3] * betar};
            const float kb_ = betar * egr; *(LAS f32x4*)(RHS + r * 256 + 128 + cb * 16 + 4 * a) = (f32x4){k[4 * a] * kb_, k[4 * a + 1] * kb_, k[4 * a + 2] * kb_, k[4 * a + 3] * kb_}; }
        float qd[16];
#pragma unroll
        for (int i = 0; i < 16; ++i) qd[i] = q[i] * egr;
        store_frag_row16(rec + R_QD, r, cb, 4, qd);
    }
    {
        const int mat = wave >> 2, mt = wave & 3, fr = lane & 15, g = lane >> 4; const LAS bf16* AB = mat ? QB : KB;
        bf16x8 af[4];
#pragma unroll
        for (int kb = 0; kb < 4; ++kb) af[kb] = *(const LAS bf16x8*)(AB + (mt * 16 + fr) * 136 + kb * 32 + 8 * g);
#pragma unroll
        for (int nt = 0; nt < 4; ++nt) { f32x4 acc = (f32x4){0.f, 0.f, 0.f, 0.f};
            if (nt <= mt) {
#pragma unroll
                for (int kb = 0; kb < 4; ++kb) { const bf16x8 bfr = *(const LAS bf16x8*)(KB + (nt * 16 + fr) * 136 + kb * 32 + 8 * g); acc = __builtin_amdgcn_mfma_f32_16x16x32_bf16(af[kb], bfr, acc, 0, 0, 0); } }
            const int sc = nt * 16 + fr; const float gcs = GC[sc];
#pragma unroll
            for (int i = 0; i < 4; ++i) { const int c = mt * 16 + 4 * g + i; const float dcy = __expf(GC[c] - gcs);
                if (mat == 0) { if (nt <= mt) LM[c * 68 + sc] = (sc < c) ? GC[64 + c] * acc[i] * dcy : 0.f; }
                else *(bf16*)(rec + R_QK + frag_off(c, sc, 2)) = (bf16)f2bf((sc <= c && nt <= mt) ? acc[i] * dcy : 0.f); } }
    }
    __syncthreads();
    if (tid < 256) {
        float x[64];
#pragma unroll
        for (int i = 0; i < 64; ++i) { float acc = RHS[i * 256 + tid];
#pragma unroll
            for (int j4 = 0; j4 < (i + 3) / 4; ++j4) { const f32x4 l4 = *(const LAS f32x4*)(LM + i * 68 + 4 * j4);
#pragma unroll
                for (int e = 0; e < 4; ++e) if (4 * j4 + e < i) acc -= l4[e] * x[4 * j4 + e]; }
            x[i] = acc; }
#pragma unroll
        for (int i = 0; i < 64; ++i) RHS[i * 256 + tid] = x[i];
    } else {
        const int tt = tid - 256, d = tt >> 1, half = tt & 1;
#pragma unroll
        for (int cq = 0; cq < 8; ++cq) { float y[4];
#pragma unroll
            for (int e = 0; e < 4; ++e) { const int c = 32 * half + 4 * cq + e; y[e] = bf2f(KB[c * 136 + d]) * __expf(gclast - GC[c]); }
            v2u w; w.x = pk2(y[0], y[1]); w.y = pk2(y[2], y[3]); *(v2u*)(rec + R_KDT + frag_off(d, 32 * half + 4 * cq, 2)) = w; }
        if (tt < 128) ((float*)(rec + R_DEC))[tt] = __expf(gclast);
    }
    __syncthreads();
    {
        const int dv = tid >> 2, cq = (tid & 3) * 16;
#pragma unroll
        for (int a = 0; a < 4; ++a) { f32x4 o;
#pragma unroll
            for (int e = 0; e < 4; ++e) o[e] = RHS[(cq + 4 * a + e) * 256 + dv];
            *(f32x4*)(UT + dv * 64 + cq + 4 * a) = o; }
        float nw[16];
#pragma unroll
        for (int a = 0; a < 4; ++a) { const f32x4 t4 = *(const LAS f32x4*)(RHS + r * 256 + 128 + cb * 16 + 4 * a); nw[4 * a] = -t4.x; nw[4 * a + 1] = -t4.y; nw[4 * a + 2] = -t4.z; nw[4 * a + 3] = -t4.w; }
        store_frag_row16(rec + R_NW, r, cb, 4, nw);
    }
    __syncthreads();
}

__device__ __forceinline__ void hgrn_prep_unit(const Frame& F, int b, int h, int n) {
    const int tid = F.tid, lane = F.lane, wave = F.wave, r = tid >> 3, cb = tid & 7, t0 = b * SEQ + n * 64, seq = 16 + b * 8 + h;
    LAS float* LF = (LAS float*)F.lds;
    LAS bf16* QB = (LAS bf16*)(F.lds + 32768);
    LAS bf16* KB = (LAS bf16*)(F.lds + 50176);
    LAS bf16* KD = (LAS bf16*)(F.lds + 67584);
    LAS float* VT = (LAS float*)(F.lds + 84992);
    const bf16* P = (const bf16*)(F.ws + O_PROJ); const float* lbl = F.in[I_LBL];
    unsigned char* rec = F.ws + O_OPS + ((size_t)seq * 64 + n) * REC_BYTES; float* UT = (float*)(F.ws + O_UT) + ((size_t)seq * 64 + n) * 8192;
    float q[16], kk[16], lf[16];
    {
        const bf16* pq = P + (size_t)(t0 + r) * NPROJ + PQ_BQ + h * 128 + cb * 16; const bf16* pf = P + (size_t)(t0 + r) * NPROJ + PQ_BF + h * 128 + cb * 16; const bf16* pi = P + (size_t)(t0 + r) * NPROJ + PQ_BI + h * 128 + cb * 16;
        const v4u q0 = *(const v4u*)pq, q1 = *(const v4u*)(pq + 8), f0 = *(const v4u*)pf, f1 = *(const v4u*)(pf + 8), i0 = *(const v4u*)pi, i1 = *(const v4u*)(pi + 8);
        const unsigned qw[8] = {q0.x, q0.y, q0.z, q0.w, q1.x, q1.y, q1.z, q1.w}, fw[8] = {f0.x, f0.y, f0.z, f0.w, f1.x, f1.y, f1.z, f1.w}, iw[8] = {i0.x, i0.y, i0.z, i0.w, i1.x, i1.y, i1.z, i1.w};
#pragma unroll
        for (int i = 0; i < 16; ++i) { const int d = h * 128 + cb * 16 + i; const float lb = sigmoidf_(lbl[d] - lbl[1024 + d]);
            const float fl = (i & 1) ? bfhi(fw[i >> 1]) : bflo(fw[i >> 1]), ql = (i & 1) ? bfhi(qw[i >> 1]) : bflo(qw[i >> 1]), vl = (i & 1) ? bfhi(iw[i >> 1]) : bflo(iw[i >> 1]);
            const float fg = lb + (1.f - lb) * sigmoidf_(fl); lf[i] = __logf(fg); kk[i] = 1.f - fg; q[i] = siluf_(ql) * 0.08838834764831845f;
            VT[(cb * 16 + i) * 65 + r] = vl; }
#pragma unroll
        for (int a = 0; a < 4; ++a) *(LAS f32x4*)(LF + r * 128 + cb * 16 + 4 * a) = (f32x4){lf[4 * a], lf[4 * a + 1], lf[4 * a + 2], lf[4 * a + 3]};
    }
    __syncthreads();
    {
        const int d = tid & 127, qr = tid >> 7; float run = 0.f;
#pragma unroll
        for (int i = 0; i < 16; ++i) { run += LF[(16 * qr + i) * 128 + d]; LF[(16 * qr + i) * 128 + d] = run; }
    }
    __syncthreads();
    {
        float bb[16], bref[16], blast[16];
#pragma unroll
        for (int a = 0; a < 4; ++a) { const int co = cb * 16 + 4 * a;
            const f32x4 t15 = *(const LAS f32x4*)(LF + 15 * 128 + co), t31 = *(const LAS f32x4*)(LF + 31 * 128 + co), t47 = *(const LAS f32x4*)(LF + 47 * 128 + co), t63 = *(const LAS f32x4*)(LF + 63 * 128 + co), tr = *(const LAS f32x4*)(LF + r * 128 + co);
            const int qr = r >> 4;
#pragma unroll
            for (int e = 0; e < 4; ++e) { float off = 0.f; if (qr > 0) off += t15[e]; if (qr > 1) off += t31[e]; if (qr > 2) off += t47[e];
                bb[4 * a + e] = tr[e] + off; bref[4 * a + e] = t15[e] + t31[e]; blast[4 * a + e] = (t15[e] + t31[e]) + (t47[e] + t63[e]); } }
        float qt[16], kt[16], kd[16], qd[16];
#pragma unroll
        for (int i = 0; i < 16; ++i) { qt[i] = q[i] * __expf(bb[i] - bref[i]); kt[i] = kk[i] * __expf(bref[i] - bb[i]); kd[i] = kk[i] * __expf(blast[i] - bb[i]); qd[i] = q[i] * __expf(bb[i]); }
        v4u w0, w1;
        w0.x = pk2(qt[0], qt[1]); w0.y = pk2(qt[2], qt[3]); w0.z = pk2(qt[4], qt[5]); w0.w = pk2(qt[6], qt[7]); w1.x = pk2(qt[8], qt[9]); w1.y = pk2(qt[10], qt[11]); w1.z = pk2(qt[12], qt[13]); w1.w = pk2(qt[14], qt[15]);
        *(LAS v4u*)(QB + r * 136 + cb * 16) = w0; *(LAS v4u*)(QB + r * 136 + cb * 16 + 8) = w1;
        w0.x = pk2(kt[0], kt[1]); w0.y = pk2(kt[2], kt[3]); w0.z = pk2(kt[4], kt[5]); w0.w = pk2(kt[6], kt[7]); w1.x = pk2(kt[8], kt[9]); w1.y = pk2(kt[10], kt[11]); w1.z = pk2(kt[12], kt[13]); w1.w = pk2(kt[14], kt[15]);
        *(LAS v4u*)(KB + r * 136 + cb * 16) = w0; *(LAS v4u*)(KB + r * 136 + cb * 16 + 8) = w1;
        w0.x = pk2(kd[0], kd[1]); w0.y = pk2(kd[2], kd[3]); w0.z = pk2(kd[4], kd[5]); w0.w = pk2(kd[6], kd[7]); w1.x = pk2(kd[8], kd[9]); w1.y = pk2(kd[10], kd[11]); w1.z = pk2(kd[12], kd[13]); w1.w = pk2(kd[14], kd[15]);
        *(LAS v4u*)(KD + r * 136 + cb * 16) = w0; *(LAS v4u*)(KD + r * 136 + cb * 16 + 8) = w1;
        store_frag_row16(rec + R_QD, r, cb, 4, qd);
        if (r == 63) {
#pragma unroll
            for (int a = 0; a < 4; ++a) *(f32x4*)((float*)(rec + R_DEC) + cb * 16 + 4 * a) = (f32x4){__expf(blast[4 * a]), __expf(blast[4 * a + 1]), __expf(blast[4 * a + 2]), __expf(blast[4 * a + 3])}; }
    }
    __syncthreads();
    {
        const int mt = wave >> 1, fr = lane & 15, g = lane >> 4;
        bf16x8 af[4];
#pragma unroll
        for (int kb = 0; kb < 4; ++kb) af[kb] = *(const LAS bf16x8*)(QB + (mt * 16 + fr) * 136 + kb * 32 + 8 * g);
#pragma unroll
        for (int nn = 0; nn < 2; ++nn) { const int nt = 2 * (wave & 1) + nn; f32x4 acc = (f32x4){0.f, 0.f, 0.f, 0.f};
            if (nt <= mt) {
#pragma unroll
                for (int kb = 0; kb < 4; ++kb) { const bf16x8 bfr = *(const LAS bf16x8*)(KB + (nt * 16 + fr) * 136 + kb * 32 + 8 * g); acc = __builtin_amdgcn_mfma_f32_16x16x32_bf16(af[kb], bfr, acc, 0, 0, 0); } }
            const int sc = nt * 16 + fr;
#pragma unroll
            for (int i = 0; i < 4; ++i) { const int c = mt * 16 + 4 * g + i; *(bf16*)(rec + R_QK + frag_off(c, sc, 2)) = (bf16)f2bf((sc <= c && nt <= mt) ? acc[i] : 0.f); } }
        const int d = tid >> 2, cp = tid & 3;
#pragma unroll
        for (int a = 0; a < 4; ++a) { float y[4];
#pragma unroll
            for (int e = 0; e < 4; ++e) y[e] = bf2f(KD[(16 * cp + 4 * a + e) * 136 + d]);
            v2u w; w.x = pk2(y[0], y[1]); w.y = pk2(y[2], y[3]); *(v2u*)(rec + R_KDT + frag_off(d, 16 * cp + 4 * a, 2)) = w;
            f32x4 o;
#pragma unroll
            for (int e = 0; e < 4; ++e) o[e] = VT[d * 65 + 16 * cp + 4 * a + e];
            *(f32x4*)(UT + d * 64 + 16 * cp + 4 * a) = o; }
    }
    __syncthreads();
}

__device__ __forceinline__ void phase_mix_prep(const Frame& F) {
    for (int u = F.blk; u < 2048; u += F.G) { const int mixer = u & 1, rest = u >> 1, n = rest & 63, h = (rest >> 6) & 7, b = rest >> 9;
        if (mixer == 0) { if (FAST_GDN) gdn_prep_unit(F, b, h, n); } else { if (FAST_HGRN) hgrn_prep_unit(F, b, h, n); } }
}

__device__ __forceinline__ void phase_mix_scan(const Frame& F) {
    if (F.blk >= 32) return;
    const int seq = F.blk, mixer = seq >> 4, b = (seq >> 3) & 1, h = seq & 7, tid = F.tid, lane = F.lane, w = F.wave, n16 = lane & 15, g = lane >> 4;
    if (mixer == 0 && !FAST_GDN) return;
    if (mixer == 1 && !FAST_HGRN) return;
    LAS unsigned char* buf0 = F.lds; LAS unsigned char* buf1 = F.lds + REC_BYTES; LAS float* OT = (LAS float*)(F.lds + 2 * REC_BYTES);
    const unsigned char* rec = F.ws + O_OPS + (size_t)seq * 64 * REC_BYTES; const float* UTb = (const float*)(F.ws + O_UT) + (size_t)seq * 64 * 8192;
    const bf16* P = (const bf16*)(F.ws + O_PROJ); bf16* O = (bf16*)(F.ws + O_O); const float* nwp = mixer ? F.in[I_HNW] : F.in[I_GNW];
    const int er = tid >> 3, ec0 = (tid & 7) * 16, zcol = (mixer ? PQ_BG : PQ_AZ) + h * 128 + ec0;
    float nw[16];
#pragma unroll
    for (int i = 0; i < 16; ++i) nw[i] = nwp[ec0 + i];
    const int kb0 = mixer ? 16 : 0, nkb = mixer ? 5 : 7;
#define SCAN_ISSUE(st_, buf_) do { const unsigned char* rs_ = rec + (size_t)(st_) * REC_BYTES; \
        for (int i_ = 0; i_ < nkb; ++i_) { const int p_ = kb0 + w + 8 * i_; __builtin_amdgcn_global_load_lds((const unsigned*)(rs_ + p_ * 1024 + lane * 16), (LAS unsigned*)((buf_) + p_ * 1024), 16, 0, 0); } \
        if (w == 0) { __builtin_amdgcn_global_load_lds((const unsigned*)(rs_ + R_DEC + lane * 4), (LAS unsigned*)((buf_) + R_DEC), 4, 0, 0); \
                      __builtin_amdgcn_global_load_lds((const unsigned*)(rs_ + R_DEC + 256 + lane * 4), (LAS unsigned*)((buf_) + R_DEC + 256), 4, 0, 0); } } while (0)
    f32x4 Sacc[8]; bf16x8 Sb[4];
#pragma unroll
    for (int i = 0; i < 8; ++i) Sacc[i] = (f32x4){0.f, 0.f, 0.f, 0.f};
#pragma unroll
    for (int i = 0; i < 4; ++i) Sb[i] = (bf16x8){0, 0, 0, 0, 0, 0, 0, 0};
    SCAN_ISSUE(0, buf0);
    f32x4 Un[4];
#pragma unroll
    for (int mt = 0; mt < 4; ++mt) Un[mt] = *(const f32x4*)(UTb + (16 * w + n16) * 64 + 16 * mt + 4 * g);
    for (int st = 0; st < 64; ++st) {
        LAS unsigned char* cur = (st & 1) ? buf1 : buf0; LAS unsigned char* nxt = (st & 1) ? buf0 : buf1;
        asm volatile("s_waitcnt vmcnt(0)" ::: "memory"); SBAR();
        f32x4 U[4];
#pragma unroll
        for (int mt = 0; mt < 4; ++mt) U[mt] = Un[mt];
        if (st + 1 < 64) { SCAN_ISSUE(st + 1, nxt);
#pragma unroll
            for (int mt = 0; mt < 4; ++mt) Un[mt] = *(const f32x4*)(UTb + (size_t)(st + 1) * 8192 + (16 * w + n16) * 64 + 16 * mt + 4 * g); }
        const int t0 = b * SEQ + st * 64;
        const bf16* zp = P + (size_t)(t0 + er) * NPROJ + zcol; const v4u z0 = *(const v4u*)zp, z1 = *(const v4u*)(zp + 8);
#define AFR(base_, idx_) (*(const LAS bf16x8*)(cur + (base_) + (idx_) * 1024 + lane * 16))
        f32x4 vn[4];
#pragma unroll
        for (int mt = 0; mt < 4; ++mt) { vn[mt] = U[mt];
            if (mixer == 0) {
#pragma unroll
                for (int kb = 0; kb < 4; ++kb) vn[mt] = __builtin_amdgcn_mfma_f32_16x16x32_bf16(AFR(R_NW, mt * 4 + kb), Sb[kb], vn[mt], 0, 0, 0); } }
        bf16x8 Vb[2]; Vb[0] = pack8(vn[0], vn[1]); Vb[1] = pack8(vn[2], vn[3]);
        f32x4 o[4];
#pragma unroll
        for (int mt = 0; mt < 4; ++mt) { o[mt] = (f32x4){0.f, 0.f, 0.f, 0.f};
#pragma unroll
            for (int kb = 0; kb < 4; ++kb) o[mt] = __builtin_amdgcn_mfma_f32_16x16x32_bf16(AFR(R_QD, mt * 4 + kb), Sb[kb], o[mt], 0, 0, 0);
#pragma unroll
            for (int q2 = 0; q2 < 2; ++q2) o[mt] = __builtin_amdgcn_mfma_f32_16x16x32_bf16(AFR(R_QK, mt * 2 + q2), Vb[q2], o[mt], 0, 0, 0); }
#pragma unroll
        for (int m8 = 0; m8 < 8; ++m8) { const f32x4 dec = *(const LAS f32x4*)(cur + R_DEC + (16 * m8 + 4 * g) * 4); Sacc[m8] = Sacc[m8] * dec;
#pragma unroll
            for (int q2 = 0; q2 < 2; ++q2) Sacc[m8] = __builtin_amdgcn_mfma_f32_16x16x32_bf16(AFR(R_KDT, m8 * 2 + q2), Vb[q2], Sacc[m8], 0, 0, 0); }
#pragma unroll
        for (int kb = 0; kb < 4; ++kb) Sb[kb] = pack8(Sacc[2 * kb], Sacc[2 * kb + 1]);
#pragma unroll
        for (int mt = 0; mt < 4; ++mt)
#pragma unroll
            for (int i = 0; i < 4; ++i) OT[(16 * mt + 4 * g + i) * 132 + 16 * w + n16] = o[mt][i];
        SBAR();
        {
            float ov[16]; float ss = 0.f;
#pragma unroll
            for (int a = 0; a < 4; ++a) { const f32x4 t4 = *(const LAS f32x4*)(OT + er * 132 + ec0 + 4 * a); ov[4 * a] = t4.x; ov[4 * a + 1] = t4.y; ov[4 * a + 2] = t4.z; ov[4 * a + 3] = t4.w; ss += (t4.x * t4.x + t4.y * t4.y) + (t4.z * t4.z + t4.w * t4.w); }
            ss += __shfl_xor(ss, 1); ss += __shfl_xor(ss, 2); ss += __shfl_xor(ss, 4);
            const float rstd = rsqrtf(ss * (1.0f / 128.0f) + EPS);
            const unsigned zw[8] = {z0.x, z0.y, z0.z, z0.w, z1.x, z1.y, z1.z, z1.w}; unsigned ow[8];
#pragma unroll
            for (int i = 0; i < 8; ++i) ow[i] = pk2(ov[2 * i] * rstd * nw[2 * i] * siluf_(bflo(zw[i])), ov[2 * i + 1] * rstd * nw[2 * i + 1] * siluf_(bfhi(zw[i])));
            bf16* op = O + (size_t)(t0 + er) * D + mixer * 1024 + h * 128 + ec0;
            *(v4u*)op = (v4u){ow[0], ow[1], ow[2], ow[3]}; *(v4u*)(op + 8) = (v4u){ow[4], ow[5], ow[6], ow[7]};
        }
    }
    asm volatile("s_waitcnt vmcnt(0)" ::: "memory"); SBAR();
#undef AFR
#undef SCAN_ISSUE
}

__device__ __forceinline__ void phase_lru_conv(const Frame& F) {
    const bf16* XBR = (const bf16*)(F.ws + O_XBR); bf16* XC = (bf16*)(F.ws + O_XC);
    const float* cw = F.in[I_RGCW]; const float* cb = F.in[I_RGCB];
    for (int idx = F.blk * 512 + F.tid; idx < T * 256; idx += F.G * 512) {
        const int t = idx >> 8, c0 = (idx & 255) * 8, s = t & (SEQ - 1);
        float a[8];
        { const f32x4 b0 = *(const f32x4*)(cb + c0), b1 = *(const f32x4*)(cb + c0 + 4); a[0] = b0.x; a[1] = b0.y; a[2] = b0.z; a[3] = b0.w; a[4] = b1.x; a[5] = b1.y; a[6] = b1.z; a[7] = b1.w; }
#pragma unroll
        for (int j = 0; j < 4; ++j) { if (s - 3 + j >= 0) { const v4u w = *(const v4u*)(XBR + (size_t)(t - 3 + j) * D + c0);
                const f32x4 k0 = *(const f32x4*)(cw + j * D + c0), k1 = *(const f32x4*)(cw + j * D + c0 + 4);
                a[0] += k0.x * bflo(w.x); a[1] += k0.y * bfhi(w.x); a[2] += k0.z * bflo(w.y); a[3] += k0.w * bfhi(w.y);
                a[4] += k1.x * bflo(w.z); a[5] += k1.y * bfhi(w.z); a[6] += k1.z * bflo(w.w); a[7] += k1.w * bfhi(w.w); } }
        *(v4u*)(XC + (size_t)t * D + c0) = (v4u){pk2(a[0], a[1]), pk2(a[2], a[3]), pk2(a[4], a[5]), pk2(a[6], a[7])};
    }
}
__device__ __forceinline__ void phase_lru_scan1(const Frame& F) {
    const float* AA = (const float*)(F.ws + O_AA); const float* BB = (const float*)(F.ws + O_BB);
    float* SA = (float*)(F.ws + O_SUMA); float* SB = (float*)(F.ws + O_SUMB);
    for (int gid = F.blk * 512 + F.tid; gid < 2 * 32 * D; gid += F.G * 512) {
        const int ch = gid & 2047, chunk = (gid >> 11) & 31, b = gid >> 16; const size_t base = (size_t)(b * SEQ + chunk * 128) * D + ch;
        float hh = 0.f, pp = 1.f;
#pragma unroll 8
        for (int i = 0; i < 128; ++i) { const float a = AA[base + (size_t)i * D], bb = BB[base + (size_t)i * D]; hh = a * hh + bb; pp *= a; }
        SA[gid] = pp; SB[gid] = hh;
    }
}
__device__ __forceinline__ void phase_lru_scan2(const Frame& F) {
    const float* AA = (const float*)(F.ws + O_AA); const float* BB = (const float*)(F.ws + O_BB);
    const float* SA = (const float*)(F.ws + O_SUMA); const float* SB = (const float*)(F.ws + O_SUMB);
    const bf16* Y = (const bf16*)(F.ws + O_Y); bf16* YH = (bf16*)(F.ws + O_YH);
    for (int gid = F.blk * 512 + F.tid; gid < 2 * 32 * D; gid += F.G * 512) {
        const int ch = gid & 2047, chunk = (gid >> 11) & 31, b = gid >> 16; const size_t base = (size_t)(b * SEQ + chunk * 128) * D + ch;
        float hh = 0.f;
        for (int c = 0; c < chunk; ++c) { const int g2 = (b * 32 + c) * D + ch; hh = SA[g2] * hh + SB[g2]; }
#pragma unroll 8
        for (int i = 0; i < 128; ++i) { const float a = AA[base + (size_t)i * D], bb = BB[base + (size_t)i * D]; hh = a * hh + bb;
            YH[base + (size_t)i * D] = (bf16)f2bf(bf2f(Y[base + (size_t)i * D]) * hh); }
    }
}

__device__ __forceinline__ void phase_route1(const Frame& F) {
    const int gw = F.blk * 8 + F.wave, ngw = F.G * 8, lane = F.lane;
    LAS float* rwt = (LAS float*)F.lds;
    LAS unsigned* cntL = (LAS unsigned*)(F.lds + 8 * 2052 * 4);
    const float* RW = F.in[I_ROUTER];
    for (int idx = F.tid; idx < D * 8; idx += 512) { const int e = idx & 7, i = idx >> 3; rwt[e * 2052 + i] = RW[idx]; }
    if (F.tid < 8) cntL[F.tid] = 0u;
    __syncthreads();
    const float* X3 = (const float*)(F.ws + O_X3); const float* nw = F.in[I_NORMW] + 3 * D;
    bf16* XN = (bf16*)(F.ws + O_XN); unsigned* TOKE = (unsigned*)(F.ws + O_TOKE); float* TOKG = (float*)(F.ws + O_TOKG);
    for (int m = gw; m < T; m += ngw) {
        f32x4 v[8]; rms_load(X3 + (size_t)m * D, nw, lane, v);
        row_store_bf16(XN + (size_t)m * D, lane, v);
        float v0 = -3.0e38f, v1 = -3.0e38f; int i0 = 0, i1 = 0;
#pragma unroll 1
        for (int e = 0; e < 8; ++e) { float a = 0.f;
#pragma unroll
            for (int j = 0; j < 8; ++j) { const f32x4 w = *(const LAS f32x4*)(rwt + e * 2052 + 4 * lane + 256 * j); a += (v[j].x * w.x + v[j].y * w.y) + (v[j].z * w.z + v[j].w * w.w); }
            a = wave_sum(a);
            if (a > v0) { v1 = v0; i1 = i0; v0 = a; i0 = e; } else if (a > v1) { v1 = a; i1 = e; } }
        if (lane == 0) { const float g0 = 1.0f / (1.0f + __expf(v1 - v0)); TOKE[m] = (unsigned)i0 | ((unsigned)i1 << 8); TOKG[2 * m] = g0; TOKG[2 * m + 1] = 1.0f - g0;
            lds_add(cntL + i0, 1u); lds_add(cntL + i1, 1u); }
    }
    __syncthreads();
    if (F.tid < 8) ((unsigned*)(F.ws + O_WCNT))[F.blk * 8 + F.tid] = cntL[F.tid];
}
__device__ __forceinline__ void phase_route2(const Frame& F) {
    LAS unsigned* tot = (LAS unsigned*)F.lds; LAS unsigned* pre = tot + 8; LAS unsigned* eoff = tot + 16; LAS unsigned* basep = tot + 32; LAS unsigned* lpos = tot + 64; LAS unsigned* ltok = tot + 128;
    const unsigned* WCNT = (const unsigned*)(F.ws + O_WCNT); const unsigned* TOKE = (const unsigned*)(F.ws + O_TOKE);
    if (F.tid < 16) tot[F.tid] = 0u;
    if (F.tid < 32) ltok[F.tid] = TOKE[F.blk * 8 + (F.tid & 7) + 2048 * (F.tid >> 3)];
    __syncthreads();
    for (int idx = F.tid; idx < F.G * 8; idx += 512) { const int w = idx >> 3, e = idx & 7; const unsigned v = WCNT[idx]; lds_add(tot + e, v); if (w < F.blk) lds_add(pre + e, v); }
    __syncthreads();
    if (F.tid == 0) {
        unsigned off = 0;
        for (int e = 0; e < 8; ++e) { eoff[e] = off; basep[e] = off + pre[e]; off += (tot[e] + 255u) & ~255u; }
        eoff[8] = off;
        for (int i = 0; i < 32; ++i) { const unsigned te = ltok[i]; const unsigned e0 = te & 255u, e1 = te >> 8;
            lpos[2 * i] = basep[e0]; basep[e0] += 1; lpos[2 * i + 1] = basep[e1]; basep[e1] += 1; }
    }
    __syncthreads();
    if (F.blk == 0 && F.tid < 9) ((unsigned*)(F.ws + O_EOFF))[F.tid] = eoff[F.tid];
    if (F.tid < 32) { const int m = F.blk * 8 + (F.tid & 7) + 2048 * (F.tid >> 3); ((unsigned*)(F.ws + O_POS))[2 * m] = lpos[2 * F.tid]; ((unsigned*)(F.ws + O_POS))[2 * m + 1] = lpos[2 * F.tid + 1]; }
    const bf16* XN = (const bf16*)(F.ws + O_XN); bf16* HS = (bf16*)(F.ws + O_HS);
    for (int k = 0; k < 4; ++k) { const int li = k * 8 + F.wave, m = F.blk * 8 + F.wave + 2048 * k; const v4u* src = (const v4u*)(XN + (size_t)m * D);
        if (MOE_F8) {
            v4u a[4];
#pragma unroll
            for (int j = 0; j < 4; ++j) a[j] = src[4 * F.lane + j];
            unsigned o[8];
#pragma unroll
            for (int j = 0; j < 4; ++j) { o[2 * j] = pk4_fp8(bflo(a[j].x), bfhi(a[j].x), bflo(a[j].y), bfhi(a[j].y)); o[2 * j + 1] = pk4_fp8(bflo(a[j].z), bfhi(a[j].z), bflo(a[j].w), bfhi(a[j].w)); }
#pragma unroll
            for (int sl = 0; sl < 2; ++sl) { v4u* dst = (v4u*)((unsigned char*)HS + (size_t)lpos[2 * li + sl] * D);
                dst[2 * F.lane] = (v4u){o[0], o[1], o[2], o[3]}; dst[2 * F.lane + 1] = (v4u){o[4], o[5], o[6], o[7]}; }
        } else {
        v4u a[4];
#pragma unroll
        for (int j = 0; j < 4; ++j) a[j] = src[F.lane + 64 * j];
#pragma unroll
        for (int sl = 0; sl < 2; ++sl) { v4u* dst = (v4u*)(HS + (size_t)lpos[2 * li + sl] * D);
#pragma unroll
            for (int j = 0; j < 4; ++j) dst[F.lane + 64 * j] = a[j]; } } }
    if (F.blk < 8) {
        const unsigned r0 = eoff[F.blk] + tot[F.blk], r1 = eoff[F.blk + 1]; const unsigned per = MOE_F8 ? 128u : 256u;
        for (unsigned idx = r0 * per + F.tid; idx < r1 * per; idx += 512) ((v4u*)HS)[idx] = (v4u){0u, 0u, 0u, 0u};
    }
    __syncthreads();
}
struct SchedMoe {
    int nN, G, c, nrt; long aT, bT, bE; unsigned eo[9];
    __device__ __forceinline__ bool next(int i, pg8::Unit& u) const {
        if (!pg8::std_order(i, G, c, nrt, nN, u.pm, u.pn)) return false;
        int e = 0;
#pragma unroll
        for (int k = 1; k < 8; ++k) e += ((unsigned)(u.pm * 256) >= eo[k]) ? 1 : 0;
        u.aoff = (unsigned)(u.pm * aT); u.boff = (unsigned)(e * bE + u.pn * bT); return true;
    }
};
struct SchedGates {
    int G, c;
    __device__ __forceinline__ bool next(int i, pg8::Unit& u) const {
        if (!pg8::std_order(i, G, c, 32, 16, u.pm, u.pn)) return false;
        u.aoff = (unsigned)(((long)u.pm * 256 * D + (u.pn >> 1) * 256) * 2); u.boff = (unsigned)(u.pn * 256 * 256 * 2); return true;
    }
};
__device__ __forceinline__ void phase_combine(const Frame& F) {
    const int gw = F.blk * 8 + F.wave, ngw = F.G * 8, lane = F.lane;
    const float* X3 = (const float*)(F.ws + O_X3); const float* YM = (const float*)(F.ws + O_YM);
    const unsigned* POS = (const unsigned*)(F.ws + O_POS); const float* TOKG = (const float*)(F.ws + O_TOKG); const float* fnw = F.in[I_FNW];
    for (int m = gw; m < T; m += ngw) {
        const unsigned p0 = POS[2 * m], p1 = POS[2 * m + 1]; const float g0 = TOKG[2 * m], g1 = TOKG[2 * m + 1];
        f32x4 v[8]; float s = 0.f;
#pragma unroll
        for (int j = 0; j < 8; ++j) { const f32x4 x = ((const f32x4*)(X3 + (size_t)m * D))[lane + 64 * j], y0 = ((const f32x4*)(YM + (size_t)p0 * D))[lane + 64 * j], y1 = ((const f32x4*)(YM + (size_t)p1 * D))[lane + 64 * j];
            v[j] = x + g0 * y0 + g1 * y1; s += (v[j].x * v[j].x + v[j].y * v[j].y) + (v[j].z * v[j].z + v[j].w * v[j].w); }
        const float rstd = rsqrtf(wave_sum(s) * (1.0f / D) + EPS);
#pragma unroll
        for (int j = 0; j < 8; ++j) { const f32x4 w = ((const f32x4*)fnw)[lane + 64 * j]; ((f32x4*)(F.out + (size_t)m * D))[lane + 64 * j] = v[j] * rstd * w; }
    }
}

constexpr int NPHASES = 20;
struct Args { const float* in[25]; float* out; unsigned char* ws; int ph_lo, ph_hi; };
__global__ void __launch_bounds__(512, 2) mk_fwd(Args args) {
    extern __shared__ __attribute__((aligned(16))) unsigned char lds_raw[];
    Frame F;
    F.lds = (LAS unsigned char*)lds_raw;
    F.tid = threadIdx.x; F.lane = F.tid & 63; F.wave = __builtin_amdgcn_readfirstlane(F.tid >> 6); F.G = gridDim.x; F.blk = blockIdx.x;
    F.ws = args.ws; F.out = args.out;
#pragma unroll
    for (int i = 0; i < 25; ++i) F.in[i] = args.in[i];
    volatile LAS unsigned* MISC = (volatile LAS unsigned*)(F.lds + MISC_OFF);
    if (F.tid < 64) MISC[F.tid] = 0u;
    __syncthreads();
    const int lo = args.ph_lo, hi = args.ph_hi;
    XcdBarrier bar; bar.bar = (unsigned*)(F.ws + O_CTL) + CW_BAR; bar.x = 0; bar.st = nullptr;
    if (hi - lo > 1) bar = xcd_barrier_post((unsigned*)(F.ws + O_CTL) + CW_BAR, MISC + 8);
#ifdef ONLY_PHASE
#define IN(k) ((k) == ONLY_PHASE && lo <= (k) && (k) < hi)
#else
#define IN(k) (lo <= (k) && (k) < hi)
#endif
#define SEAM(k) do { if (IN(k) && IN((k) + 1)) xcd_barrier(bar); } while (0)
#ifndef REP_PHASE
#define REP_PHASE -1
#endif
#ifndef REP_COUNT
#define REP_COUNT 2
#endif
#define PH_BEGIN(k) if (IN(k)) { for (int rep_ = 0; rep_ < ((k) == REP_PHASE ? REP_COUNT : 1); ++rep_) { if (rep_) xcd_barrier(bar);
#define PH_END(k) } } SEAM(k);
    unsigned char* ws = F.ws;
    bf16* XN = (bf16*)(ws + O_XN);

    PH_BEGIN(0) { phase_prologue(F); } PH_END(0)
    PH_BEGIN(1) {
        pg8::Gemm g{XN, (const bf16*)(ws + O_WMI), D, D, D}; pg8::SchedStd S{T / 256, NPROJ / 256, F.G, F.blk, (long)256 * D * 2, (long)256 * D * 2};
        pg8::EpiBf16 E{(bf16*)(ws + O_PROJ), NPROJ};
        pg8::gemm_phase(F.lds, g, S, E);
    } PH_END(1)
    PH_BEGIN(2) { if (!(FAST_GDN && FAST_HGRN)) phase_mix_pre(F); if (FAST_GDN || FAST_HGRN) phase_mix_prep(F); } PH_END(2)
    PH_BEGIN(3) { if (!(FAST_GDN && FAST_HGRN)) phase_mix_scan_slow(F); if (FAST_GDN || FAST_HGRN) phase_mix_scan(F); convert_queue(F, (unsigned*)(ws + O_CTL) + CW_Q); } PH_END(3)
    PH_BEGIN(4) {
        pg8::Gemm g{(const bf16*)(ws + O_O), (const bf16*)(ws + O_WMO), D, D, D}; pg8::SchedStd S{T / 256, D / 256, F.G, F.blk, (long)256 * D * 2, (long)256 * D * 2};
        pg8::EpiResF32 E{F.in[I_X], (float*)(ws + O_X1), D};
        pg8::gemm_phase(F.lds, g, S, E);
    } PH_END(4)
    PH_BEGIN(5) { phase_rms(F, (const float*)(ws + O_X1), F.in[I_NORMW] + D); } PH_END(5)
    PH_BEGIN(6) {
        pg8::Gemm g{XN, (const bf16*)(ws + O_WFG), D, D, D}; pg8::SchedStd S{T / 256, 2 * FF / 256, F.G, F.blk, (long)256 * D * 2, (long)256 * D * 2};
        pg8::EpiSwiglu E{(bf16*)(ws + O_ACT), FF};
        pg8::gemm_phase(F.lds, g, S, E);
    } PH_END(6)
    PH_BEGIN(7) {
        pg8::Gemm g{(const bf16*)(ws + O_ACT), (const bf16*)(ws + O_WFD), FF, FF, FF}; pg8::SchedStd S{T / 256, D / 256, F.G, F.blk, (long)256 * FF * 2, (long)256 * FF * 2};
        pg8::EpiResF32 E{(const float*)(ws + O_X1), (float*)(ws + O_X2), D};
        pg8::gemm_phase(F.lds, g, S, E);
    } PH_END(7)
    PH_BEGIN(8) { phase_rms(F, (const float*)(ws + O_X2), F.in[I_NORMW] + 2 * D); } PH_END(8)
    PH_BEGIN(9) {
        pg8::Gemm g{XN, (const bf16*)(ws + O_WRI), D, D, D}; pg8::SchedStd S{T / 256, 2 * D / 256, F.G, F.blk, (long)256 * D * 2, (long)256 * D * 2};
        pg8::EpiRgIn E{(bf16*)(ws + O_Y), (bf16*)(ws + O_XBR)};
        pg8::gemm_phase(F.lds, g, S, E);
    } PH_END(9)
    PH_BEGIN(10) { phase_lru_conv(F); } PH_END(10)
    PH_BEGIN(11) {
        pg8::Gemm g{(const bf16*)(ws + O_XC), (const bf16*)(ws + O_WRG), D, 256, 256}; SchedGates S{F.G, F.blk};
        pg8::EpiGates E{(const bf16*)(ws + O_XC), F.in[I_RGAB], F.in[I_RGXB], (const float*)(ws + O_SPL), (float*)(ws + O_AA), (float*)(ws + O_BB)};
        pg8::gemm_phase(F.lds, g, S, E);
    } PH_END(11)
    PH_BEGIN(12) { phase_lru_scan1(F); } PH_END(12)
    PH_BEGIN(13) { phase_lru_scan2(F); } PH_END(13)
    PH_BEGIN(14) {
        pg8::Gemm g{(const bf16*)(ws + O_YH), (const bf16*)(ws + O_WRO), D, D, D}; pg8::SchedStd S{T / 256, D / 256, F.G, F.blk, (long)256 * D * 2, (long)256 * D * 2};
        pg8::EpiResF32 E{(const float*)(ws + O_X2), (float*)(ws + O_X3), D};
        pg8::gemm_phase(F.lds, g, S, E);
    } PH_END(14)
    PH_BEGIN(15) { phase_route1(F); } PH_END(15)
    PH_BEGIN(16) { phase_route2(F); } PH_END(16)
    PH_BEGIN(17) {
        constexpr int EB = MOE_F8 ? 1 : 2;
        SchedMoe S; S.nN = 2 * FE / 256; S.G = F.G; S.c = F.blk; S.aT = (long)256 * D * EB; S.bT = (long)256 * D * EB; S.bE = (long)2 * FE * D * EB;
        const unsigned* eo = (const unsigned*)(ws + O_EOFF);
#pragma unroll
        for (int k = 0; k < 9; ++k) S.eo[k] = __builtin_amdgcn_readfirstlane(eo[k]);
        S.nrt = (int)(S.eo[8] >> 8);
        if constexpr (MOE_F8) { pg8::Gemm g{(const bf16*)(ws + O_HS), (const bf16*)(ws + O_WMG), D / 2, D / 2, D / 2};
            pg8::EpiSwigluF8 E{(unsigned char*)(ws + O_ACTM), FE, 8.0f};
            pg8::gemm_phase<pg8::EpiSwigluF8, SchedMoe, true, 121, 127>(F.lds, g, S, E); }
        else { pg8::Gemm g{(const bf16*)(ws + O_HS), (const bf16*)(ws + O_WMG), D, D, D};
            pg8::EpiSwiglu E{(bf16*)(ws + O_ACTM), FE};
            pg8::gemm_phase(F.lds, g, S, E); }
    } PH_END(17)
    PH_BEGIN(18) {
        constexpr int EB = MOE_F8 ? 1 : 2;
        SchedMoe S; S.nN = D / 256; S.G = F.G; S.c = F.blk; S.aT = (long)256 * FE * EB; S.bT = (long)256 * FE * EB; S.bE = (long)D * FE * EB;
        const unsigned* eo = (const unsigned*)(ws + O_EOFF);
#pragma unroll
        for (int k = 0; k < 9; ++k) S.eo[k] = __builtin_amdgcn_readfirstlane(eo[k]);
        S.nrt = (int)(S.eo[8] >> 8);
        pg8::EpiResF32 E{nullptr, (float*)(ws + O_YM), D};
        if constexpr (MOE_F8) { pg8::Gemm g{(const bf16*)(ws + O_ACTM), (const bf16*)(ws + O_WMD), FE / 2, FE / 2, FE / 2};
            pg8::gemm_phase<pg8::EpiResF32, SchedMoe, true, 120, 124>(F.lds, g, S, E); }
        else { pg8::Gemm g{(const bf16*)(ws + O_ACTM), (const bf16*)(ws + O_WMD), FE, FE, FE};
            pg8::gemm_phase(F.lds, g, S, E); }
    } PH_END(18)
    PH_BEGIN(19) { phase_combine(F); } } }
#undef IN
#undef SEAM
}

extern "C" void kernel_launch(void* const* d_in, const int* in_sizes, int n_in, void* d_out, int out_size, void* d_ws, size_t ws_size, hipStream_t stream) {
    static int grid = 0;
    if (grid == 0) {
        if (n_in != 25 || out_size != T * D || ws_size < WS_END) { fprintf(stderr, "kernel_launch: unexpected shapes (n_in %d out %d ws %zu need %zu)\n", n_in, out_size, ws_size, (size_t)WS_END); grid = -1; return; }
        int dev = 0, cus = 0, per_cu = 0;
        if (hipGetDevice(&dev) != hipSuccess || hipDeviceGetAttribute(&cus, hipDeviceAttributeMultiprocessorCount, dev) != hipSuccess) { grid = -1; return; }
        if (hipFuncSetAttribute((const void*)mk_fwd, hipFuncAttributeMaxDynamicSharedMemorySize, LDS_BYTES) != hipSuccess) { fprintf(stderr, "kernel_launch: hipFuncSetAttribute failed\n"); grid = -1; return; }
        if (hipOccupancyMaxActiveBlocksPerMultiprocessor(&per_cu, (const void*)mk_fwd, 512, LDS_BYTES) != hipSuccess || per_cu < 1) fprintf(stderr, "kernel_launch: occupancy query reports %d\n", per_cu);
        (void)hipGetLastError();
        grid = cus > 256 ? 256 : cus;
    }
    if (grid < 0) return;
    (void)hipMemsetAsync((char*)d_ws + O_CTL, 0, CTL_BYTES, stream);
    Args a{};
    for (int i = 0; i < 25; ++i) a.in[i] = (const float*)d_in[i];
    a.out = (float*)d_out; a.ws = (unsigned char*)d_ws;
#if MK_SPLIT
    for (int p = 0; p < NPHASES; ++p) { a.ph_lo = p; a.ph_hi = p + 1; hipLaunchKernelGGL(mk_fwd, dim3(grid), dim3(512), LDS_BYTES, stream, a); }
#else
    a.ph_lo = 0; a.ph_hi = NPHASES; hipLaunchKernelGGL(mk_fwd, dim3(grid), dim3(512), LDS_BYTES, stream, a);
#endif
}
```

```cpp
#include <hip/hip_runtime.h>
#include <cstdio>
#include <cstdint>

#ifndef MK_SPLIT
#define MK_SPLIT 0
#endif

#ifndef MOE_F8
#define MOE_F8 1
#endif
#define PREP_ONLY 0
#define TIME_MASK 0u
#define TIME_SEC 0
#ifndef FFND_F8
#define FFND_F8 0
#endif
#ifndef X3_BF16
#define X3_BF16 1
#endif
#ifndef FFNG_F8
#define FFNG_F8 0
#endif
#define REP_PHASE -1
#define REP_COUNT 2
#ifndef FAST_GDN
#define FAST_GDN 1
#endif
#ifndef FAST_HGRN
#define FAST_HGRN 1
#endif
#define GAS __attribute__((address_space(1)))
#define LAS __attribute__((address_space(3)))
typedef unsigned short bf16;
typedef unsigned v4u __attribute__((ext_vector_type(4)));
typedef unsigned v2u __attribute__((ext_vector_type(2)));
typedef float f32x4 __attribute__((ext_vector_type(4)));
typedef float f32x2 __attribute__((ext_vector_type(2)));
typedef short bf16x8 __attribute__((ext_vector_type(8)));
#define RLX_AGENT __ATOMIC_RELAXED, __HIP_MEMORY_SCOPE_AGENT
#define LDS_WAIT() asm volatile("s_waitcnt lgkmcnt(0)" ::: "memory")
#define VM_WAIT() asm volatile("s_waitcnt vmcnt(0)" ::: "memory")
#define SBAR() do { asm volatile("s_waitcnt lgkmcnt(0)" ::: "memory"); __builtin_amdgcn_s_barrier(); asm volatile("" ::: "memory"); } while (0)

#define TS_LDS_OFF (155648 - 256 + 64)
#define TS_BEGIN(id) unsigned long long ts_##id = 0ull; if (TIME_SEC == (id) && blockIdx.x == 0 && threadIdx.x == 0) ts_##id = __builtin_amdgcn_s_memrealtime();
#define TS_END(id) if (TIME_SEC == (id) && blockIdx.x == 0 && threadIdx.x == 0) { extern __shared__ __attribute__((aligned(16))) unsigned char lds_raw[]; *(volatile LAS unsigned long long*)((LAS unsigned char*)lds_raw + TS_LDS_OFF) += __builtin_amdgcn_s_memrealtime() - ts_##id; }
typedef __bf16 hwbf16x2 __attribute__((ext_vector_type(2)));
__device__ __forceinline__ unsigned pk2(float lo, float hi) { const f32x2 v = {lo, hi}; return __builtin_bit_cast(unsigned, __builtin_convertvector(v, hwbf16x2)); }
__device__ __forceinline__ unsigned f2bf(float f) { return pk2(f, 0.f) & 0xffffu; }
__device__ __forceinline__ int fresh_tid(int t) { asm volatile("" : "+v"(t)); return t; }
__device__ __forceinline__ float bf2f(unsigned short b) { return __builtin_bit_cast(float, ((unsigned)b) << 16); }
__device__ __forceinline__ float bflo(unsigned w) { return __builtin_bit_cast(float, w << 16); }
__device__ __forceinline__ float bfhi(unsigned w) { return __builtin_bit_cast(float, w & 0xffff0000u); }
__device__ __forceinline__ float clamp448(float x) { return __builtin_amdgcn_fmed3f(x, -448.f, 448.f); }
__device__ __forceinline__ unsigned pk4_fp8(float a, float b, float c, float d) {
    unsigned w = 0; w = __builtin_amdgcn_cvt_pk_fp8_f32(clamp448(a), clamp448(b), w, false); w = __builtin_amdgcn_cvt_pk_fp8_f32(clamp448(c), clamp448(d), w, true); return w; }
__device__ __forceinline__ float sigmoidf_(float x) { return __builtin_amdgcn_rcpf(1.0f + __expf(-x)); }
__device__ __forceinline__ float siluf_(float x) { return x * __builtin_amdgcn_rcpf(1.0f + __expf(-x)); }
__device__ __forceinline__ float softplusf_(float x) { return x > 20.f ? x : log1pf(__expf(x)); }
__device__ __forceinline__ void lds_add(LAS unsigned* p, unsigned v) { (void)__hip_atomic_fetch_add(p, v, __ATOMIC_RELAXED, __HIP_MEMORY_SCOPE_WORKGROUP); }
__device__ __forceinline__ float wave_sum(float v) {
#pragma unroll
    for (int o = 1; o < 64; o <<= 1) v += __shfl_xor(v, o);
    return v;
}

constexpr int T = 8192, D = 2048, SEQ = 4096, NPROJ = 8192, FF = 5632, FE = 7168, NE = 8;
constexpr int MIXLD = 8208;
constexpr int PQ_AQ = 0, PQ_AK = 1024, PQ_AV = 2048, PQ_AZ = 3072, PQ_BQ = 4096, PQ_BF = 5120, PQ_BI = 6144, PQ_BG = 7168;
constexpr float EPS = 1e-6f;
constexpr int MOE_ROWS = 16384 + 8 * 256;

constexpr size_t al256(size_t x) { return (x + 255) & ~(size_t)255; }
constexpr size_t O_CTL = 0, CTL_BYTES = 1u << 20;
constexpr size_t O_WMI = CTL_BYTES;
constexpr size_t O_WMO = O_WMI + (size_t)NPROJ * D * 2;
constexpr size_t O_WFG = O_WMO + (size_t)D * D * 2;
constexpr size_t O_WFD = O_WFG + (size_t)2 * FF * D * 2;
constexpr size_t O_WRI = O_WFD + (size_t)D * FF * 2;
constexpr size_t O_WRG = O_WRI + (size_t)2 * D * D * 2;
constexpr size_t O_WRO = O_WRG + (size_t)16 * 256 * 256 * 2;
constexpr size_t O_WMG = O_WRO + (size_t)D * D * 2;
constexpr size_t O_WMD = O_WMG + (size_t)NE * 2 * FE * D * 2;
constexpr size_t O_XN = O_WMD + (size_t)NE * D * FE * 2;
constexpr size_t O_PROJ = O_XN + (size_t)T * D * 2;
constexpr size_t O_GB = O_PROJ + (size_t)T * NPROJ * 2;
constexpr size_t O_O = O_GB + (size_t)T * 16 * 4;
constexpr size_t O_X1 = O_O + (size_t)T * D * 2;
constexpr size_t O_X2 = O_X1 + (size_t)T * D * 4;
constexpr size_t O_X3 = O_X2 + (size_t)T * D * 4;
constexpr size_t O_ACT = O_X3 + (size_t)T * D * 4;
constexpr size_t O_Y = O_ACT + (size_t)T * FF * 2;
constexpr size_t O_XBR = O_Y + (size_t)T * D * 2;
constexpr size_t O_XC = O_XBR + (size_t)T * D * 2;
constexpr size_t O_AA = O_XC + (size_t)T * D * 2;
constexpr size_t O_BB = O_AA + (size_t)T * D * 4;
constexpr size_t O_YH = O_BB + (size_t)T * D * 4;
constexpr size_t O_SUMA = O_YH + (size_t)T * D * 2;
constexpr size_t O_SUMB = O_SUMA + (size_t)2 * 32 * D * 4;
constexpr size_t O_TOKE = O_SUMB + (size_t)2 * 32 * D * 4;
constexpr size_t O_TOKG = O_TOKE + (size_t)T * 4;
constexpr size_t O_POS = O_TOKG + (size_t)T * 8;
constexpr size_t O_WCNT = O_POS + (size_t)T * 8;
constexpr size_t O_EOFF = O_WCNT + 256 * 8 * 4;
constexpr size_t O_SPL = al256(O_EOFF + 64);
constexpr size_t O_UTAB = O_SPL + 2048 * 4;
constexpr size_t O_X1F8 = al256(O_UTAB + 72 * 56 * 4);
constexpr size_t O_PART1 = O_X1F8 + (size_t)T * D;
constexpr size_t O_PART2 = O_PART1 + (size_t)T * 8 * 4;
constexpr size_t O_HS = O_PART2 + (size_t)T * 8 * 4;
constexpr size_t O_ACTM = O_HS + (size_t)MOE_ROWS * D * 2;
constexpr size_t O_YM = O_ACTM + (size_t)MOE_ROWS * FE * 2;
constexpr size_t O_QF = O_YM + (size_t)4 * MOE_ROWS * D * 4;
constexpr size_t O_KF = O_QF + (size_t)T * 1024 * 4;
constexpr size_t O_VF = O_KF + (size_t)T * 1024 * 4;
constexpr size_t O_FH = O_VF + (size_t)T * 1024 * 4;
constexpr size_t O_QH = O_FH + (size_t)T * 1024 * 4;
constexpr size_t REC_BYTES = 58368;
constexpr size_t O_OPS = al256(O_QH + (size_t)T * 1024 * 4);
constexpr size_t O_UT = O_OPS + (size_t)32 * 64 * REC_BYTES;
constexpr size_t WS_END = O_UT + (size_t)32 * 64 * 8192 * 4;

constexpr int CW_BAR = 4096, CW_Q = 64, CW_Q0 = 128, CW_Q2 = 192;

constexpr int LDS_BYTES = 155648;
constexpr int MISC_OFF = 155648 - 256;

namespace pg8 {
constexpr int BM = 256, BK = 64, HALF = 128, HTB = HALF * BK * 2, STAGE_BYTES = 8 * HTB, NXCD = 8, WGM = 8;
__host__ __device__ __forceinline__ int lds_byte(int r, int c) { const int st = (r >> 4) * 2 + (c >> 5), rr = r & 15, cc = c & 31, ob = rr * 64 + cc * 2; return st * 1024 + (ob ^ (((ob >> 9) & 1) << 5)); }
__host__ __device__ __forceinline__ void stage_rc(int b, int& R, int& C) { const int st = b / 1024, sb = b % 1024, swz = sb ^ (((sb >> 9) & 1) << 5); R = (st >> 1) * 16 + swz / 64; C = (st & 1) * 32 + (swz % 64) / 2; }
__host__ __device__ __forceinline__ int perm32(int rho) { const int n = rho >> 4, i = rho & 15; return 8 * (i >> 2) + 4 * n + (i & 3); }

struct Unit { int pm, pn; unsigned aoff, boff; int z; };
struct Gemm { const bf16* A; const bf16* Bt; int lda, ldb, K; };

__device__ __forceinline__ bool std_order(int i, int G, int c, int nM, int nN, int& pm, int& pn) {
    const int nwg = nM * nN; const long L = (long)i * G + c; if (L >= nwg) return false;
    int wgid = (int)L; { const int q = nwg / NXCD, r = nwg % NXCD, xcd = wgid % NXCD, off = wgid / NXCD; wgid = (xcd < r ? xcd * (q + 1) : r * (q + 1) + (xcd - r) * q) + off; }
    const int nig = WGM * nN, gid = wgid / nig, fm = gid * WGM, gsz = (nM - fm) < WGM ? (nM - fm) : WGM;
    pm = fm + ((wgid % nig) % gsz); pn = (wgid % nig) / gsz; return true;
}
struct SchedStd {
    int nM, nN, G, c; long aT, bT;
    __device__ __forceinline__ bool next(int i, Unit& u) const { if (!std_order(i, G, c, nM, nN, u.pm, u.pn)) return false; u.aoff = (unsigned)(u.pm * aT); u.boff = (unsigned)(u.pn * bT); u.z = 0; return true; }
};

typedef int v4i_t __attribute__((ext_vector_type(4)));
typedef int v8i_t __attribute__((ext_vector_type(8)));
__device__ __forceinline__ v8i_t cat8(const bf16x8 lo, const bf16x8 hi) { const v4i_t a = __builtin_bit_cast(v4i_t, lo), b = __builtin_bit_cast(v4i_t, hi); return __builtin_shufflevector(a, b, 0, 1, 2, 3, 4, 5, 6, 7); }
template <class Epi, class Sched, bool F8 = false, int SW = 127, int SX = 127>
__device__ __forceinline__ void gemm_phase(LAS unsigned char* lds, const Gemm g, const Sched& S, const Epi& E) {
    const int tid = fresh_tid((int)threadIdx.x), wid = __builtin_amdgcn_readfirstlane(tid >> 6), lane = tid & 63, wr = wid >> 2, wc = wid & 3, fr = lane & 15, fq = lane >> 4;
    const int K = g.K, nt = K / BK;
    unsigned voffA[2], voffB[2];
#pragma unroll
    for (int i = 0; i < 2; ++i) { int R, C; stage_rc(tid * 16 + i * 8192, R, C); const int Rb = Epi::PERM ? ((R & ~31) + perm32(R & 31)) : R;
        voffA[i] = (unsigned)(R * g.lda + C) * 2u; voffB[i] = (unsigned)(Rb * g.ldb + C) * 2u; }
    const unsigned kstep = (unsigned)(BK * 2);
    const unsigned hstepA = (unsigned)HALF * g.lda * 2, hstepB = (unsigned)HALF * g.ldb * 2;
    const __amdgpu_buffer_rsrc_t A_rs = __builtin_amdgcn_make_buffer_rsrc((void*)g.A, 0, -1, 0x00020000), B_rs = __builtin_amdgcn_make_buffer_rsrc((void*)g.Bt, 0, -1, 0x00020000);
    const unsigned ldsw = (unsigned)wid * 1024u;
    const int aoff = lds_byte(wr * 64 + fr, fq * 8), boff = lds_byte(wc * 32 + fr, fq * 8);
#define PG8_SA(b, h) (((b) * 2 + (h)) * HTB)
#define PG8_SB(b, h) ((4 + (b) * 2 + (h)) * HTB)
#define PG8_STAGE2(bufoff, rs, soff, voff) do { _Pragma("unroll") for (int _i = 0; _i < 2; ++_i) \
        __builtin_amdgcn_raw_ptr_buffer_load_lds(rs, (LAS void*)(lds + (bufoff) + ldsw + _i * 8192), 16, (int)(voff)[_i], (int)(soff), 0, 0); } while (0)
#define PG8_LDA(dst, b, h) do { _Pragma("unroll") for (int m = 0; m < 4; ++m) dst[m] = __builtin_shufflevector(*(const LAS v4i_t*)(lds + PG8_SA(b, h) + aoff + m * 2048), *(const LAS v4i_t*)(lds + PG8_SA(b, h) + aoff + m * 2048 + 1024), 0, 1, 2, 3, 4, 5, 6, 7); } while (0)
#define PG8_LDB(dst, b, h) do { _Pragma("unroll") for (int n = 0; n < 2; ++n) dst[n] = __builtin_shufflevector(*(const LAS v4i_t*)(lds + PG8_SB(b, h) + boff + n * 2048), *(const LAS v4i_t*)(lds + PG8_SB(b, h) + boff + n * 2048 + 1024), 0, 1, 2, 3, 4, 5, 6, 7); } while (0)
#define PG8_LO(v) __builtin_bit_cast(bf16x8, __builtin_shufflevector(v, v, 0, 1, 2, 3))
#define PG8_HI(v) __builtin_bit_cast(bf16x8, __builtin_shufflevector(v, v, 4, 5, 6, 7))
#define PG8_MMA(ai, bj, At, Bt) do { __builtin_amdgcn_s_setprio(1); _Pragma("unroll") for (int m = 0; m < 4; ++m) _Pragma("unroll") for (int n = 0; n < 2; ++n) { \
        if constexpr (F8) acc[ai][bj][m][n] = __builtin_amdgcn_mfma_scale_f32_16x16x128_f8f6f4(Bt[n], At[m], acc[ai][bj][m][n], 0, 0, 0, SW * 0x01010101, 0, SX * 0x01010101); \
        else { acc[ai][bj][m][n] = __builtin_amdgcn_mfma_f32_16x16x32_bf16(PG8_LO(Bt[n]), PG8_LO(At[m]), acc[ai][bj][m][n], 0, 0, 0); \
               acc[ai][bj][m][n] = __builtin_amdgcn_mfma_f32_16x16x32_bf16(PG8_HI(Bt[n]), PG8_HI(At[m]), acc[ai][bj][m][n], 0, 0, 0); } } __builtin_amdgcn_s_setprio(0); } while (0)
#define PG8_WAIT_V(n) asm volatile("s_waitcnt vmcnt(" #n ")" ::: "memory")
#define PG8_WAIT_L(n) asm volatile("s_waitcnt lgkmcnt(" #n ")" ::: "memory")
#define PG8_BAR __builtin_amdgcn_s_barrier()
#define PG8_SCHED __builtin_amdgcn_sched_barrier(0)
    Unit cur, nxt; int ui = 0;
    if (!S.next(0, cur)) return;
    f32x4 acc[2][2][4][2];
#pragma unroll
    for (int a = 0; a < 2; ++a)
#pragma unroll
        for (int b = 0; b < 2; ++b)
#pragma unroll
            for (int m = 0; m < 4; ++m)
#pragma unroll
                for (int n = 0; n < 2; ++n) acc[a][b][m][n] = (f32x4){0.f, 0.f, 0.f, 0.f};
    v8i_t At[4], B0[2], B1[2];
    unsigned A_c = cur.aoff, B_c = cur.boff;
    { const unsigned B_0 = B_c, B_1 = B_c + hstepB, A_0 = A_c, A_1 = A_c + hstepA;
      PG8_STAGE2(PG8_SB(0, 0), B_rs, B_0, voffB); PG8_STAGE2(PG8_SB(0, 1), B_rs, B_1, voffB); PG8_STAGE2(PG8_SA(0, 0), A_rs, A_0, voffA); PG8_STAGE2(PG8_SA(0, 1), A_rs, A_1, voffA); }
    if (wr == 1) PG8_BAR;
    PG8_WAIT_V(2); PG8_BAR;
    PG8_STAGE2(PG8_SB(1, 0), B_rs, B_c + kstep, voffB); PG8_STAGE2(PG8_SA(1, 0), A_rs, A_c + kstep, voffA); PG8_STAGE2(PG8_SB(1, 1), B_rs, B_c + hstepB + kstep, voffB);
    PG8_WAIT_V(6); PG8_BAR;
    for (;;) {
        const bool has_next = S.next(ui + 1, nxt);
        const unsigned A_n = has_next ? nxt.aoff : A_c, B_n = has_next ? nxt.boff : B_c;
#pragma unroll 1
        for (int t = 0; t < nt; t += 2) {
            const bool last = (t == nt - 2);
            const unsigned a1 = A_c + (unsigned)(t + 1) * kstep;
            const unsigned a2 = last ? A_n : A_c + (unsigned)(t + 2) * kstep, b2 = last ? B_n : B_c + (unsigned)(t + 2) * kstep;
            const unsigned a3 = a2 + kstep, b3 = b2 + kstep;
            PG8_LDB(B0, 0, 0); PG8_LDB(B1, 0, 1); PG8_SCHED; PG8_LDA(At, 0, 0); PG8_STAGE2(PG8_SA(1, 1), A_rs, a1 + hstepA, voffA);
            PG8_WAIT_V(8); PG8_WAIT_L(0); PG8_BAR; PG8_MMA(0, 0, At, B0); PG8_MMA(0, 1, At, B1); PG8_BAR; PG8_SCHED;
            PG8_LDA(At, 0, 1); PG8_STAGE2(PG8_SB(0, 0), B_rs, b2, voffB); PG8_STAGE2(PG8_SB(0, 1), B_rs, b2 + hstepB, voffB); PG8_STAGE2(PG8_SA(0, 0), A_rs, a2, voffA);
            PG8_WAIT_V(8); PG8_WAIT_L(0); PG8_BAR; PG8_MMA(1, 0, At, B0); PG8_MMA(1, 1, At, B1); PG8_BAR; PG8_SCHED;
            PG8_LDB(B0, 1, 0); PG8_LDB(B1, 1, 1); PG8_SCHED; PG8_LDA(At, 1, 0); PG8_STAGE2(PG8_SA(0, 1), A_rs, a2 + hstepA, voffA);
            PG8_WAIT_V(8); PG8_WAIT_L(0); PG8_BAR; PG8_MMA(0, 0, At, B0); PG8_MMA(0, 1, At, B1); PG8_BAR; PG8_SCHED;
            PG8_LDA(At, 1, 1); PG8_STAGE2(PG8_SB(1, 0), B_rs, b3, voffB); PG8_STAGE2(PG8_SB(1, 1), B_rs, b3 + hstepB, voffB); PG8_STAGE2(PG8_SA(1, 0), A_rs, a3, voffA);
            PG8_WAIT_V(8); PG8_WAIT_L(0); PG8_BAR; PG8_MMA(1, 0, At, B0); PG8_MMA(1, 1, At, B1); PG8_BAR; PG8_SCHED;
        }
        { TS_BEGIN(1) if (wr == 0) PG8_BAR;
        { const int tl = fresh_tid((int)threadIdx.x) & 63; E(acc, cur, wr, wc, tl & 15, tl >> 4); } TS_END(1) }
        if (!has_next) break;
#pragma unroll
        for (int a = 0; a < 2; ++a)
#pragma unroll
            for (int b = 0; b < 2; ++b)
#pragma unroll
                for (int m = 0; m < 4; ++m)
#pragma unroll
                    for (int n = 0; n < 2; ++n) acc[a][b][m][n] = (f32x4){0.f, 0.f, 0.f, 0.f};
        cur = nxt; A_c = A_n; B_c = B_n; ++ui;
        if (wr == 1) PG8_BAR;
    }
    PG8_WAIT_V(0);
    PG8_BAR;
#undef PG8_SA
#undef PG8_SB
#undef PG8_STAGE2
#undef PG8_LDA
#undef PG8_LDB
#undef PG8_LO
#undef PG8_HI
#undef PG8_MMA
#undef PG8_WAIT_V
#undef PG8_WAIT_L
#undef PG8_BAR
#undef PG8_SCHED
}

__device__ __forceinline__ void load_rstd(const float* part, const Unit& u, int wr, int fr, float (&rs)[2][4]) {
#pragma unroll
    for (int ai = 0; ai < 2; ++ai)
#pragma unroll
        for (int m = 0; m < 4; ++m) { const float* p = part + (size_t)(u.pm * BM + ai * HALF + wr * 64 + m * 16 + fr) * 8; const f32x4 a = *(const f32x4*)p, b = *(const f32x4*)(p + 4);
            rs[ai][m] = rsqrtf((((a[0] + a[1]) + (a[2] + a[3])) + ((b[0] + b[1]) + (b[2] + b[3]))) * (1.0f / 2048.0f) + 1e-6f); }
}
struct EpiBf16 {
    static constexpr bool PERM = true;
    bf16* O; int ldc;
    __device__ __forceinline__ void operator()(const f32x4 (&acc)[2][2][4][2], const Unit& u, int wr, int wc, int fr, int fq) const {
        const int row0 = u.pm * BM + wr * 64 + fr, col0 = u.pn * BM + wc * 32 + 8 * fq;
#pragma unroll
        for (int ai = 0; ai < 2; ++ai)
#pragma unroll
            for (int m = 0; m < 4; ++m) { bf16* rowp = O + (size_t)(row0 + ai * HALF + m * 16) * ldc + col0;
#pragma unroll
                for (int bj = 0; bj < 2; ++bj) { const f32x4 v0 = acc[ai][bj][m][0], v1 = acc[ai][bj][m][1];
                    v4u w; w.x = pk2(v0[0], v0[1]); w.y = pk2(v0[2], v0[3]); w.z = pk2(v1[0], v1[1]); w.w = pk2(v1[2], v1[3]);
                    *(v4u*)(rowp + bj * HALF) = w; } }
    }
};
struct EpiSwiglu {
    static constexpr bool PERM = true;
    bf16* O; int ldc; const float* part;
    __device__ __forceinline__ void operator()(const f32x4 (&acc)[2][2][4][2], const Unit& u, int wr, int wc, int fr, int fq) const {
        const int row0 = u.pm * BM + wr * 64 + fr, col0 = u.pn * HALF + wc * 32 + 8 * fq;
        float rs[2][4];
        if (part) load_rstd(part, u, wr, fr, rs); else {
#pragma unroll
            for (int i = 0; i < 8; ++i) rs[i >> 2][i & 3] = 1.0f; }
#pragma unroll
        for (int ai = 0; ai < 2; ++ai)
#pragma unroll
            for (int m = 0; m < 4; ++m) { bf16* rowp = O + (size_t)(row0 + ai * HALF + m * 16) * ldc + col0;
                float o[8];
#pragma unroll
                for (int n = 0; n < 2; ++n)
#pragma unroll
                    for (int j = 0; j < 4; ++j) { const float gt = acc[ai][0][m][n][j] * rs[ai][m], up = acc[ai][1][m][n][j] * rs[ai][m]; o[n * 4 + j] = gt * __builtin_amdgcn_rcpf(1.0f + __expf(-gt)) * up; }
                v4u w; w.x = pk2(o[0], o[1]); w.y = pk2(o[2], o[3]); w.z = pk2(o[4], o[5]); w.w = pk2(o[6], o[7]);
                *(v4u*)rowp = w; }
    }
};
template <bool FOLDED>
struct EpiSwigluF8R {
    static constexpr bool PERM = true;
    unsigned char* O; int ldc; const float* part;
    __device__ __forceinline__ void operator()(const f32x4 (&acc)[2][2][4][2], const Unit& u, int wr, int wc, int fr, int fq) const {
        const int row0 = u.pm * BM + wr * 64 + fr, col0 = u.pn * HALF + wc * 32 + 8 * fq;
        float rs[2][4]; load_rstd(part, u, wr, fr, rs);
#pragma unroll
        for (int ai = 0; ai < 2; ++ai)
#pragma unroll
            for (int m = 0; m < 4; ++m) { unsigned char* rowp = O + (size_t)(row0 + ai * HALF + m * 16) * ldc + col0;
                float o[8];
#pragma unroll
                for (int n = 0; n < 2; ++n)
#pragma unroll
                    for (int j = 0; j < 4; ++j) {
                        if constexpr (FOLDED) { const float gt = acc[ai][0][m][n][j] * rs[ai][m], up = acc[ai][1][m][n][j] * rs[ai][m]; o[n * 4 + j] = gt * __builtin_amdgcn_rcpf(1.0f + __builtin_amdgcn_exp2f(-gt)) * up; }
                        else { const float gt = acc[ai][0][m][n][j] * rs[ai][m], up = acc[ai][1][m][n][j] * (rs[ai][m] * 8.0f); o[n * 4 + j] = gt * __builtin_amdgcn_rcpf(1.0f + __expf(-gt)) * up; } }
                v2u w; w.x = pk4_fp8(o[0], o[1], o[2], o[3]); w.y = pk4_fp8(o[4], o[5], o[6], o[7]);
                *(v2u*)rowp = w; }
    }
};
struct EpiSwigluF8 {
    static constexpr bool PERM = true;
    unsigned char* O; int ldc; float scale;
    __device__ __forceinline__ void operator()(const f32x4 (&acc)[2][2][4][2], const Unit& u, int wr, int wc, int fr, int fq) const {
        const int row0 = u.pm * BM + wr * 64 + fr, col0 = u.pn * HALF + wc * 32 + 8 * fq;
#pragma unroll
        for (int ai = 0; ai < 2; ++ai)
#pragma unroll
            for (int m = 0; m < 4; ++m) { unsigned char* rowp = O + (size_t)(row0 + ai * HALF + m * 16) * ldc + col0;
                float o[8];
#pragma unroll
                for (int n = 0; n < 2; ++n)
#pragma unroll
                    for (int j = 0; j < 4; ++j) { const float gt = acc[ai][0][m][n][j], up = acc[ai][1][m][n][j]; o[n * 4 + j] = gt * __builtin_amdgcn_rcpf(1.0f + __builtin_amdgcn_exp2f(-gt)) * up; }
                v2u w; w.x = pk4_fp8(o[0], o[1], o[2], o[3]); w.y = pk4_fp8(o[4], o[5], o[6], o[7]);
                *(v2u*)rowp = w; }
    }
};
template <bool BASE_BF16, bool OUT_BF16, bool STATS, bool OUT_F8 = false>
struct EpiRes {
    static constexpr bool PERM = true;
    const void* base; void* out; float* part; LAS float* tbl; unsigned char* out8 = nullptr;
    __device__ __forceinline__ void operator()(const f32x4 (&acc)[2][2][4][2], const Unit& u, int wr, int wc, int fr, int fq) const {
        const int row0 = u.pm * BM + wr * 64 + fr, col0 = u.pn * BM + wc * 32 + 8 * fq;
        v4u bw[2][4][2];
        if (BASE_BF16) {
#pragma unroll
            for (int ai = 0; ai < 2; ++ai)
#pragma unroll
                for (int m = 0; m < 4; ++m)
#pragma unroll
                    for (int bj = 0; bj < 2; ++bj) bw[ai][m][bj] = *(const v4u*)((const bf16*)base + (size_t)(row0 + ai * HALF + m * 16) * D + col0 + bj * HALF);
        }
#pragma unroll
        for (int ai = 0; ai < 2; ++ai) {
            f32x4 bf[4][2][2];
            if (!BASE_BF16) {
#pragma unroll
                for (int m = 0; m < 4; ++m)
#pragma unroll
                    for (int bj = 0; bj < 2; ++bj) { const float* bp = (const float*)base + (size_t)(row0 + ai * HALF + m * 16) * D + col0 + bj * HALF; bf[m][bj][0] = *(const f32x4*)bp; bf[m][bj][1] = *(const f32x4*)(bp + 4); }
            }
#pragma unroll
            for (int m = 0; m < 4; ++m) { const size_t off = (size_t)(row0 + ai * HALF + m * 16) * D + col0; float ss = 0.f;
#pragma unroll
                for (int bj = 0; bj < 2; ++bj) { f32x4 v0 = acc[ai][bj][m][0], v1 = acc[ai][bj][m][1];
                    if (BASE_BF16) { const v4u w = bw[ai][m][bj]; v0 += (f32x4){bflo(w.x), bfhi(w.x), bflo(w.y), bfhi(w.y)}; v1 += (f32x4){bflo(w.z), bfhi(w.z), bflo(w.w), bfhi(w.w)}; }
                    else { v0 += bf[m][bj][0]; v1 += bf[m][bj][1]; }
                    if (STATS) ss += ((v0[0] * v0[0] + v0[1] * v0[1]) + (v0[2] * v0[2] + v0[3] * v0[3])) + ((v1[0] * v1[0] + v1[1] * v1[1]) + (v1[2] * v1[2] + v1[3] * v1[3]));
                    if (OUT_F8) { v2u w8; w8.x = pk4_fp8(v0[0], v0[1], v0[2], v0[3]); w8.y = pk4_fp8(v1[0], v1[1], v1[2], v1[3]); *(v2u*)(out8 + off + bj * HALF) = w8; }
                    if (OUT_BF16) { v4u w; w.x = pk2(v0[0], v0[1]); w.y = pk2(v0[2], v0[3]); w.z = pk2(v1[0], v1[1]); w.w = pk2(v1[2], v1[3]); *(v4u*)((bf16*)out + off + bj * HALF) = w; }
                    else { *(f32x4*)((float*)out + off + bj * HALF) = v0; *(f32x4*)((float*)out + off + bj * HALF + 4) = v1; } }
                if (STATS) { ss += __shfl_xor(ss, 16); ss += __shfl_xor(ss, 32); if (fq == 0) tbl[(ai * HALF + wr * 64 + m * 16 + fr) * 4 + wc] = ss; }
                asm volatile("" ::: "memory"); } }
        if (STATS) {
            asm volatile("s_waitcnt lgkmcnt(0)" ::: "memory"); __builtin_amdgcn_s_barrier(); asm volatile("" ::: "memory");
            const int t = threadIdx.x; if (t < 256) { const f32x4 p4 = *(const LAS f32x4*)(tbl + t * 4); part[(size_t)(u.pm * BM + t) * 8 + u.pn] = (p4[0] + p4[1]) + (p4[2] + p4[3]); }
            asm volatile("s_waitcnt lgkmcnt(0)" ::: "memory"); __builtin_amdgcn_s_barrier(); asm volatile("" ::: "memory");
        }
    }
};
struct EpiPartBf16 {
    static constexpr bool PERM = true;
    bf16* out; int ldc; size_t pstride;
    __device__ __forceinline__ void operator()(const f32x4 (&acc)[2][2][4][2], const Unit& u, int wr, int wc, int fr, int fq) const {
        const int row0 = u.pm * BM + wr * 64 + fr, col0 = u.pn * BM + wc * 32 + 8 * fq; bf16* o = out + (size_t)u.z * pstride;
#pragma unroll
        for (int ai = 0; ai < 2; ++ai)
#pragma unroll
            for (int m = 0; m < 4; ++m) { bf16* rowp = o + (size_t)(row0 + ai * HALF + m * 16) * ldc + col0;
#pragma unroll
                for (int bj = 0; bj < 2; ++bj) { const f32x4 v0 = acc[ai][bj][m][0], v1 = acc[ai][bj][m][1];
                    v4u w; w.x = pk2(v0[0], v0[1]); w.y = pk2(v0[2], v0[3]); w.z = pk2(v1[0], v1[1]); w.w = pk2(v1[2], v1[3]);
                    *(v4u*)(rowp + bj * HALF) = w; } }
    }
};
struct EpiRgIn {
    static constexpr bool PERM = true;
    bf16* Y; bf16* XBR; const float* part;
    __device__ __forceinline__ void operator()(const f32x4 (&acc)[2][2][4][2], const Unit& u, int wr, int wc, int fr, int fq) const {
        const bool isy = u.pn < 8; bf16* O = isy ? Y : XBR;
        float rs[2][4]; load_rstd(part, u, wr, fr, rs);
        const int row0 = u.pm * BM + wr * 64 + fr, col0 = (u.pn & 7) * BM + wc * 32 + 8 * fq;
#pragma unroll
        for (int ai = 0; ai < 2; ++ai)
#pragma unroll
            for (int m = 0; m < 4; ++m) { bf16* rowp = O + (size_t)(row0 + ai * HALF + m * 16) * D + col0;
#pragma unroll
                for (int bj = 0; bj < 2; ++bj) { float o[8];
#pragma unroll
                    for (int n = 0; n < 2; ++n)
#pragma unroll
                        for (int j = 0; j < 4; ++j) { float x = acc[ai][bj][m][n][j] * rs[ai][m];
                            if (isy) { const float y2 = 1.5957691216f * (x + 0.044715f * x * x * x); x = x * __builtin_amdgcn_rcpf(1.0f + __expf(-y2)); }
                            o[n * 4 + j] = x; }
                    v4u w; w.x = pk2(o[0], o[1]); w.y = pk2(o[2], o[3]); w.z = pk2(o[4], o[5]); w.w = pk2(o[6], o[7]);
                    *(v4u*)(rowp + bj * HALF) = w; } }
    }
};
struct EpiGates {
    static constexpr bool PERM = true;
    const bf16* XC; const float* ba; const float* bx; const float* lam; bf16* LA; bf16* BB;
    __device__ __forceinline__ void operator()(const f32x4 (&acc)[2][2][4][2], const Unit& u, int wr, int wc, int fr, int fq) const {
        const int row0 = u.pm * BM + wr * 64 + fr, col = u.pn * HALF + wc * 32 + 8 * fq;
        float vba[8], vbx[8], sp[8];
#pragma unroll
        for (int n = 0; n < 2; ++n) { const f32x4 t0 = *(const f32x4*)(ba + col + 4 * n), t1 = *(const f32x4*)(bx + col + 4 * n), t2 = *(const f32x4*)(lam + col + 4 * n);
#pragma unroll
            for (int j = 0; j < 4; ++j) { vba[4 * n + j] = t0[j]; vbx[4 * n + j] = t1[j]; sp[4 * n + j] = t2[j]; } }
#pragma unroll
        for (int ai = 0; ai < 2; ++ai)
#pragma unroll
            for (int m = 0; m < 4; ++m) { const size_t off = (size_t)(row0 + ai * HALF + m * 16) * D + col;
                const v4u xw = *(const v4u*)(XC + off); const float xc[8] = {bflo(xw.x), bfhi(xw.x), bflo(xw.y), bfhi(xw.y), bflo(xw.z), bfhi(xw.z), bflo(xw.w), bfhi(xw.w)};
                float oa[8], ob[8];
#pragma unroll
                for (int n = 0; n < 2; ++n)
#pragma unroll
                    for (int j = 0; j < 4; ++j) { const int q = 4 * n + j; const float r = sigmoidf_(acc[ai][0][m][n][j] + vba[q]), gi = sigmoidf_(acc[ai][1][m][n][j] + vbx[q]);
                        const float la = sp[q] * r, t2 = 2.0f * la; oa[q] = la;
                        const float em = (t2 > -0.01f) ? -t2 * (1.0f + 0.5f * t2 * (1.0f + 0.33333334f * t2)) : 1.0f - __expf(t2);
                        ob[q] = __builtin_amdgcn_sqrtf(fmaxf(em, 0.f)) * (gi * xc[q]); }
                *(v4u*)(LA + off) = (v4u){pk2(oa[0], oa[1]), pk2(oa[2], oa[3]), pk2(oa[4], oa[5]), pk2(oa[6], oa[7])};
                *(v4u*)(BB + off) = (v4u){pk2(ob[0], ob[1]), pk2(ob[2], ob[3]), pk2(ob[4], ob[5]), pk2(ob[6], ob[7])}; asm volatile("" ::: "memory"); }
    }
};
}

#define XB_TMO      128
#define XB_XCNT(j)  (256  + 64 * (j))
#define XB_XSUB(j)  (1280 + 64 * (j))
#define XB_XGEN(j)  (2304 + 64 * (j))
#define XB_TOP      3328
#define XB_TOPGEN   3392
#define XCD_BAR_WORDS 3456
#define XB_SPIN_CAP (1u << 22)
__device__ __forceinline__ unsigned xb_ld(unsigned* p)              { return __hip_atomic_load(p, __ATOMIC_RELAXED, __HIP_MEMORY_SCOPE_AGENT); }
__device__ __forceinline__ unsigned xb_add(unsigned* p, unsigned v) { return __hip_atomic_fetch_add(p, v, __ATOMIC_RELAXED, __HIP_MEMORY_SCOPE_AGENT); }
__device__ __forceinline__ unsigned xb_xcc_id() { return (unsigned)__builtin_amdgcn_s_getreg((3 << 11) | 20) & 0xFu; }
#define XB_SPIN(cond, bar) do { unsigned _sp = 0; while (cond) { __builtin_amdgcn_s_sleep(1); \
    if ((++_sp & 255u) == 0u) { if (xb_ld(&(bar)[XB_TMO])) break; if (_sp > XB_SPIN_CAP) { atomicAdd(&(bar)[XB_TMO], 1u); break; } } } } while (0)
struct XcdBarrier { unsigned* bar; unsigned x; volatile LAS unsigned* st; };
__device__ __forceinline__ XcdBarrier xcd_barrier_post(unsigned* bar, volatile LAS unsigned* st) {
    XcdBarrier b; b.bar = bar; b.x = xb_xcc_id(); b.st = st;
    if (threadIdx.x == 0) (void)xb_add(&bar[XB_XCNT(b.x)], 1u);
    return b;
}
__device__ __forceinline__ void xcd_barrier_complete(unsigned* bar, unsigned x, unsigned& nloc, unsigned& nx) {
    const unsigned G = gridDim.x * gridDim.y * gridDim.z;
    unsigned sum, cnt, mine, sp = 0u;
    for (;;) {
        sum = 0u; cnt = 0u; mine = 0u;
#pragma unroll
        for (unsigned j = 0; j < 16; ++j) { const unsigned c = xb_ld(&bar[XB_XCNT(j)]); sum += c; cnt += (c > 0u) ? 1u : 0u; mine = (j == x) ? c : mine; }
        if (sum == G) break;
        __builtin_amdgcn_s_sleep(1);
        if ((++sp & 255u) == 0u) { if (xb_ld(&bar[XB_TMO])) break; if (sp > XB_SPIN_CAP) { atomicAdd(&bar[XB_TMO], 1u); break; } }
    }
    nloc = mine > 0u ? mine : 1u; nx = cnt > 0u ? cnt : 1u;
}
__device__ __forceinline__ void xcd_barrier(const XcdBarrier& b) {
    asm volatile("s_waitcnt vmcnt(0)" ::: "memory");
    __syncthreads();
    if (threadIdx.x == 0) {
        unsigned* bar = b.bar;
        __builtin_amdgcn_s_waitcnt(0);
        unsigned nloc = b.st[0], nx = b.st[1];
        if (nloc == 0u) { xcd_barrier_complete(bar, b.x, nloc, nx); b.st[0] = nloc; b.st[1] = nx; }
        const unsigned old = xb_add(&bar[XB_XSUB(b.x)], 1u);
        const unsigned gen = old / nloc;
        if (old + 1u == (gen + 1u) * nloc) {
            __builtin_amdgcn_fence(__ATOMIC_RELEASE, "agent");
            asm volatile("s_waitcnt vmcnt(0)" ::: "memory");
            const unsigned og = xb_add(&bar[XB_TOP], 1u);
            const unsigned tg = og / nx;
            if (og + 1u == (tg + 1u) * nx) xb_add(&bar[XB_TOPGEN], 1u);
            else XB_SPIN(xb_ld(&bar[XB_TOPGEN]) == tg, bar);
            __builtin_amdgcn_fence(__ATOMIC_ACQUIRE, "agent");
            xb_add(&bar[XB_XGEN(b.x)], 1u);
            asm volatile("s_waitcnt vmcnt(0)" ::: "memory");
        } else {
            XB_SPIN(xb_ld(&bar[XB_XGEN(b.x)]) == gen, bar);
            __builtin_amdgcn_fence(__ATOMIC_ACQUIRE, "agent");
            asm volatile("s_waitcnt vmcnt(0)" ::: "memory");
        }
    }
    __syncthreads();
}

struct Frame {
    LAS unsigned char* lds;
    int tid, lane, wave, G, blk;
    unsigned char* ws;
    const float* in[25];
    float* out;
};
enum { I_X = 0, I_NORMW, I_FNW, I_MIXIN, I_GCONV, I_ALOG, I_DTB, I_GNW, I_LBL, I_HNW, I_MIXOUT, I_FGU, I_FD, I_RGIN, I_RGCW, I_RGCB, I_RGAW, I_RGAB, I_RGXW, I_RGXB, I_LAM, I_RGOUT, I_ROUTER, I_MGU, I_MD };

struct Job { const float* src; bf16* dst; int ld, K, n0, ncols, drow0, mode, nbatch; long sbs; int dbs; int f8; float scale; const float* rsc; };
__device__ __forceinline__ void conv_item(const Job& jb, LAS float* scr, int item, int lane) {
    const int nblk = jb.ncols / 32, per = (jb.K / 64) * nblk, b = item / per, r = item % per, kb = r / nblk, nb = r % nblk, k0 = 64 * kb, n0l = 32 * nb;
    const float* sp = jb.src + (size_t)b * jb.sbs + (size_t)k0 * jb.ld + jb.n0 + n0l;
#pragma unroll 8
    for (int i = 0; i < 32; ++i) { const int kk = 2 * i + (lane >> 5); scr[kk * 33 + (lane & 31)] = sp[(size_t)kk * jb.ld + (lane & 31)]; }
    LDS_WAIT(); asm volatile("" ::: "memory");
    const int c = lane & 7;
#pragma unroll
    for (int j = 0; j < 4; ++j) { const int n = (lane >> 3) + 8 * j, nl = n0l + n; const LAS float* s = scr + (8 * c) * 33 + n;
        const int drow = jb.drow0 + b * jb.dbs + (jb.mode ? ((nl >> 7) * 256 + (nl & 127)) : nl);
        if (jb.f8) { const float sc = jb.scale; v2u o; o.x = pk4_fp8(s[0 * 33] * sc, s[1 * 33] * sc, s[2 * 33] * sc, s[3 * 33] * sc); o.y = pk4_fp8(s[4 * 33] * sc, s[5 * 33] * sc, s[6 * 33] * sc, s[7 * 33] * sc);
            *(v2u*)((unsigned char*)jb.dst + (size_t)drow * jb.K + k0 + 8 * c) = o; }
        else { v4u o; o.x = pk2(s[0 * 33], s[1 * 33]); o.y = pk2(s[2 * 33], s[3 * 33]); o.z = pk2(s[4 * 33], s[5 * 33]); o.w = pk2(s[6 * 33], s[7 * 33]);
            *(v4u*)(jb.dst + (size_t)drow * jb.K + k0 + 8 * c) = o; } }
    LDS_WAIT(); asm volatile("" ::: "memory");
}
constexpr int NJOBS = 13, MD_LATE = FFNG_F8 ? 1 : 2, FFN_GEMM_WG = 235;
__device__ __forceinline__ Job get_job(const Frame& F, int j) {
    Job b; b.n0 = 0; b.drow0 = 0; b.mode = 0; b.nbatch = 1; b.sbs = 0; b.dbs = 0; b.f8 = 0; b.scale = 1.0f; b.rsc = nullptr;
    unsigned char* ws = F.ws;
    switch (j) {
    case 0:  b.src = F.in[I_MIXIN]; b.dst = (bf16*)(ws + O_WMI); b.ld = MIXLD; b.K = D; b.ncols = 4096; break;
    case 1:  b.src = F.in[I_MIXIN]; b.dst = (bf16*)(ws + O_WMI); b.ld = MIXLD; b.K = D; b.n0 = 4112; b.ncols = 4096; b.drow0 = 4096; break;
    case 2:  b.src = F.in[I_MIXOUT]; b.dst = (bf16*)(ws + O_WMO); b.ld = D; b.K = D; b.ncols = D; break;
    case 3:  b.src = F.in[I_FGU]; b.dst = (bf16*)(ws + O_WFG); b.ld = 2 * FF; b.K = D; b.ncols = FF; b.mode = 1; b.rsc = F.in[I_NORMW] + D; b.f8 = FFNG_F8; b.scale = FFNG_F8 ? (FFND_F8 ? 64.0f * 1.4426950408889634f : 64.0f) : 1.0f; break;
    case 4:  b.src = F.in[I_FGU]; b.dst = (bf16*)(ws + O_WFG); b.ld = 2 * FF; b.K = D; b.n0 = FF; b.ncols = FF; b.drow0 = 128; b.mode = 1; b.rsc = F.in[I_NORMW] + D; b.f8 = FFNG_F8; b.scale = FFNG_F8 ? (FFND_F8 ? 64.0f * 8.0f / 1.4426950408889634f : 64.0f) : 1.0f; break;
    case 5:  b.src = F.in[I_FD]; b.dst = (bf16*)(ws + O_WFD); b.ld = D; b.K = FF; b.ncols = D; b.f8 = FFND_F8; b.scale = FFND_F8 ? 128.0f : 1.0f; break;
    case 6:  b.src = F.in[I_RGIN]; b.dst = (bf16*)(ws + O_WRI); b.ld = 2 * D; b.K = D; b.ncols = 2 * D; b.rsc = F.in[I_NORMW] + 2 * D; break;
    case 7:  b.src = F.in[I_RGAW]; b.dst = (bf16*)(ws + O_WRG); b.ld = 256; b.K = 256; b.ncols = 256; b.mode = 1; b.nbatch = 8; b.sbs = 65536; b.dbs = 512; break;
    case 8:  b.src = F.in[I_RGXW]; b.dst = (bf16*)(ws + O_WRG); b.ld = 256; b.K = 256; b.ncols = 256; b.drow0 = 128; b.mode = 1; b.nbatch = 8; b.sbs = 65536; b.dbs = 512; break;
    case 9:  b.src = F.in[I_RGOUT]; b.dst = (bf16*)(ws + O_WRO); b.ld = D; b.K = D; b.ncols = D; break;
    case 10: b.src = F.in[I_MGU]; b.dst = (bf16*)(ws + O_WMG); b.ld = 2 * FE; b.K = D; b.ncols = FE; b.mode = 1; b.nbatch = 8; b.sbs = (long)D * 2 * FE; b.dbs = 2 * FE; b.f8 = MOE_F8; b.scale = MOE_F8 ? 64.0f * 1.4426950408889634f : 1.0f; break;
    case 11: b.src = F.in[I_MGU]; b.dst = (bf16*)(ws + O_WMG); b.ld = 2 * FE; b.K = D; b.n0 = FE; b.ncols = FE; b.drow0 = 128; b.mode = 1; b.nbatch = 8; b.sbs = (long)D * 2 * FE; b.dbs = 2 * FE; b.f8 = MOE_F8; b.scale = MOE_F8 ? 64.0f * 8.0f / 1.4426950408889634f : 1.0f; break;
    case 12: b.src = F.in[I_MD]; b.dst = (bf16*)(ws + O_WMD); b.ld = D; b.K = FE; b.ncols = D; b.nbatch = 8 - MD_LATE; b.sbs = (long)FE * D; b.dbs = D; b.f8 = MOE_F8; b.scale = MOE_F8 ? 128.0f : 1.0f; break;
    default: b.src = F.in[I_MD] + (size_t)(8 - MD_LATE) * FE * D; b.dst = (bf16*)(ws + O_WMD); b.ld = D; b.K = FE; b.ncols = D; b.nbatch = MD_LATE; b.sbs = (long)FE * D; b.dbs = D; b.drow0 = (8 - MD_LATE) * D; b.f8 = MOE_F8; b.scale = MOE_F8 ? 128.0f : 1.0f; break;
    }
    return b;
}
constexpr int job_tiles(int j) { return j == 0 || j == 1 ? 32 * 16 : j == 2 ? 32 * 8 : j == 3 || j == 4 ? 32 * 22 : j == 5 ? 88 * 8 : j == 6 ? 32 * 16 : j == 7 || j == 8 ? 8 * 4 * 1 : j == 9 ? 32 * 8 : j == 10 || j == 11 ? 8 * 32 * 28 : j == 12 ? (8 - MD_LATE) * 112 * 8 : MD_LATE * 112 * 8; }
constexpr int tiles_cum(int j0, int j) { int s = 0; for (int k = j0; k < j; ++k) s += job_tiles(k); return s; }
template <int J0, int J1>
__device__ __forceinline__ void convert_tiles(const Frame& F, unsigned* qhead) {
    constexpr int total = tiles_cum(J0, J1), TS = 64 * 260;
    LAS float* tile0 = (LAS float*)F.lds; LAS int* tick = (LAS int*)(F.lds + 2 * TS * 4);
    const int tid = F.tid, lane = F.lane, w = F.wave;
    if (tid == 0) { tick[2] = (int)__hip_atomic_fetch_add(qhead, 1u, __ATOMIC_RELAXED, __HIP_MEMORY_SCOPE_AGENT); tick[3] = (int)__hip_atomic_fetch_add(qhead, 1u, __ATOMIC_RELAXED, __HIP_MEMORY_SCOPE_AGENT); }
    SBAR();
    int it = tick[2], it1 = tick[3];
    f32x4 rg[8], rh[8];
#define CT_DECODE(it_, jb_, b_, k0_, nb_) int jj_ = J0; { _Pragma("unroll") for (int k_ = J0 + 1; k_ < J1; ++k_) jj_ += ((it_) >= tiles_cum(J0, k_)) ? 1 : 0; } int cc_ = 0; { _Pragma("unroll") for (int k_ = J0 + 1; k_ < J1; ++k_) cc_ = ((it_) >= tiles_cum(J0, k_)) ? tiles_cum(J0, k_) : cc_; } \
        const Job jb_ = get_job(F, jj_); const int ntn_ = jb_.ncols / 256, per_ = (jb_.K / 64) * ntn_, r0_ = (it_) - cc_, b_ = r0_ / per_, r1_ = r0_ % per_, k0_ = (r1_ / ntn_) * 64, nb_ = r1_ % ntn_;
#define CT_LOAD(it_, R_) do { CT_DECODE(it_, jb, bb, k0, nb) const float* sp = jb.src + (size_t)bb * jb.sbs + (size_t)(k0 + w * 8) * jb.ld + jb.n0 + nb * 256 + 4 * lane; \
        _Pragma("unroll") for (int i = 0; i < 8; ++i) R_[i] = *(const f32x4*)(sp + (size_t)i * jb.ld); } while (0)
    if (it < total) CT_LOAD(it, rg);
    if (it1 < total) CT_LOAD(it1, rh);
    int buf = 0;
    while (it < total) {
        LAS float* tl = tile0 + buf * TS;
#pragma unroll
        for (int i = 0; i < 8; ++i) *(LAS f32x4*)(tl + (w * 8 + i) * 260 + 4 * lane) = rg[i];
        if (tid == 0) tick[buf] = (int)__hip_atomic_fetch_add(qhead, 1u, __ATOMIC_RELAXED, __HIP_MEMORY_SCOPE_AGENT);
        SBAR();
        const int it2 = tick[buf];
#pragma unroll
        for (int i = 0; i < 8; ++i) rg[i] = rh[i];
        if (it2 < total) CT_LOAD(it2, rh);
        {
            CT_DECODE(it, jb, bb, k0, nb)
            const int n = tid >> 1, kh = tid & 1, nl = nb * 256 + n;
            const int drow = jb.drow0 + bb * jb.dbs + (jb.mode ? ((nl >> 7) * 256 + (nl & 127)) : nl);
            float v[32];
#pragma unroll
            for (int j = 0; j < 32; ++j) v[j] = tl[(32 * kh + j) * 260 + n];
            if (jb.rsc) {
#pragma unroll
                for (int j = 0; j < 32; j += 4) { const f32x4 g4 = *(const f32x4*)(jb.rsc + k0 + 32 * kh + j); v[j] *= g4[0]; v[j + 1] *= g4[1]; v[j + 2] *= g4[2]; v[j + 3] *= g4[3]; } }
            if (jb.f8) { const float sc = jb.scale; unsigned o[8];
#pragma unroll
                for (int j = 0; j < 8; ++j) o[j] = pk4_fp8(v[4 * j] * sc, v[4 * j + 1] * sc, v[4 * j + 2] * sc, v[4 * j + 3] * sc);
                v4u* dp = (v4u*)((unsigned char*)jb.dst + (size_t)drow * jb.K + k0 + 32 * kh);
                dp[0] = (v4u){o[0], o[1], o[2], o[3]}; dp[1] = (v4u){o[4], o[5], o[6], o[7]};
            } else { unsigned o[16];
#pragma unroll
                for (int j = 0; j < 16; ++j) o[j] = pk2(v[2 * j], v[2 * j + 1]);
                v4u* dp = (v4u*)(jb.dst + (size_t)drow * jb.K + k0 + 32 * kh);
#pragma unroll
                for (int j = 0; j < 4; ++j) dp[j] = (v4u){o[4 * j], o[4 * j + 1], o[4 * j + 2], o[4 * j + 3]}; }
        }
        it = it1; it1 = it2; buf ^= 1;
    }
    SBAR();
#undef CT_LOAD
#undef CT_DECODE
}
__device__ __forceinline__ void convert_jobs(const Frame& F, int j0, int j1, int gw, int ngw) {
    LAS float* scr = (LAS float*)(F.lds + F.wave * 16384);
    for (int j = j0; j < j1; ++j) { const Job jb = get_job(F, j); const int nitems = jb.nbatch * (jb.K / 64) * (jb.ncols / 32);
        for (int it = gw; it < nitems; it += ngw) conv_item(jb, scr, it, F.lane); }
}

template <bool SRC_BF16 = false>
__device__ __forceinline__ void rms_load(const void* xrow, const float* nw, int lane, f32x4 (&v)[8]) {
    float s = 0.f;
#pragma unroll
    for (int j = 0; j < 8; ++j) { if (SRC_BF16) { const v2u w = ((const v2u*)xrow)[lane + 64 * j]; v[j] = (f32x4){bflo(w.x), bfhi(w.x), bflo(w.y), bfhi(w.y)}; } else v[j] = ((const f32x4*)xrow)[lane + 64 * j]; s += (v[j].x * v[j].x + v[j].y * v[j].y) + (v[j].z * v[j].z + v[j].w * v[j].w); }
    const float rstd = rsqrtf(wave_sum(s) * (1.0f / D) + EPS);
#pragma unroll
    for (int j = 0; j < 8; ++j) { const f32x4 w = ((const f32x4*)nw)[lane + 64 * j]; v[j] = v[j] * rstd * w; }
}
__device__ __forceinline__ void row_store_bf16(bf16* orow, int lane, const f32x4 (&v)[8]) {
#pragma unroll
    for (int j = 0; j < 8; ++j) { v2u w; w.x = pk2(v[j].x, v[j].y); w.y = pk2(v[j].z, v[j].w); ((v2u*)orow)[lane + 64 * j] = w; }
}

template <int N> __device__ __forceinline__ int red_index(int lane) { return N == 16 ? ((lane >> 5) & 1) * 8 + ((lane >> 4) & 1) * 4 + ((lane >> 3) & 1) * 2 + ((lane >> 2) & 1) : ((lane >> 5) & 1) * 4 + ((lane >> 4) & 1) * 2 + ((lane >> 3) & 1); }
template <int N, int X> __device__ __forceinline__ void red_step(float (&a)[N <= 8 ? 8 : 16], int lane) {
    const bool hi = (lane & X) != 0;
#pragma unroll
    for (int i = 0; i < N / 2; ++i) { const float send = hi ? a[i] : a[i + N / 2], keep = hi ? a[i + N / 2] : a[i]; a[i] = keep + __shfl_xor(send, X); }
}
__device__ __forceinline__ float red_multi16(float (&a)[16], int lane) { red_step<16, 32>(a, lane); red_step<8, 16>(reinterpret_cast<float (&)[8]>(a), lane); float b4[8];
#pragma unroll
    for (int i = 0; i < 8; ++i) b4[i] = a[i];
    red_step<4, 8>(b4, lane); red_step<2, 4>(b4, lane); float v = b4[0]; v += __shfl_xor(v, 2); v += __shfl_xor(v, 1); return v; }
__device__ __forceinline__ float red_multi8(float (&a)[8], int lane) { red_step<8, 32>(a, lane); red_step<4, 16>(a, lane); red_step<2, 8>(a, lane); float v = a[0]; v += __shfl_xor(v, 4); v += __shfl_xor(v, 2); v += __shfl_xor(v, 1); return v; }
__device__ __forceinline__ void phase_prologue(const Frame& F) {
    const int gw = F.blk * 8 + F.wave, ngw = F.G * 8;
    convert_tiles<0, 2>(F, (unsigned*)(F.ws + O_CTL) + CW_Q0);
    if (F.blk == 0) for (int i = F.tid; i < D; i += 512) ((float*)(F.ws + O_SPL))[i] = -8.0f * log1pf(__expf(-F.in[I_LAM][i]));
    __syncthreads();
    LAS float* w16 = (LAS float*)F.lds;
    const float* W = F.in[I_MIXIN];
    for (int idx = F.tid; idx < D * 16; idx += 512) { const int c = idx & 15, i = idx >> 4; w16[c * 2052 + i] = W[(size_t)i * MIXLD + 4096 + c]; }
    __syncthreads();
    const float* nw = F.in[I_NORMW];
    bf16* XN = (bf16*)(F.ws + O_XN); float* GB = (float*)(F.ws + O_GB);
    for (int m = gw; m < T; m += ngw) {
        f32x4 v[8]; rms_load(F.in[I_X] + (size_t)m * D, nw, F.lane, v);
        row_store_bf16(XN + (size_t)m * D, F.lane, v);
        float pa[16];
#pragma unroll
        for (int c = 0; c < 16; ++c) pa[c] = 0.f;
#pragma unroll
        for (int j = 0; j < 8; ++j) {
#pragma unroll
            for (int c = 0; c < 16; ++c) { const f32x4 w = *(const LAS f32x4*)(w16 + c * 2052 + 4 * F.lane + 256 * j); pa[c] += (v[j].x * w.x + v[j].y * w.y) + (v[j].z * w.z + v[j].w * w.w); }
            asm volatile("" ::: "memory"); }
        const float mine = red_multi16(pa, F.lane); const int idx = red_index<16>(F.lane);
        if ((F.lane & 3) == 0) { if (idx < 8) GB[(size_t)m * 16 + idx] = sigmoidf_(mine);
            else { const int h = idx - 8; GB[(size_t)m * 16 + idx] = -__expf(F.in[I_ALOG][h]) * softplusf_(mine + F.in[I_DTB][h]); } }
    }
    __syncthreads();
}

__device__ __forceinline__ void phase_rms(const Frame& F, const float* X, const float* nw) {
    const int gw = F.blk * 8 + F.wave, ngw = F.G * 8; bf16* XN = (bf16*)(F.ws + O_XN);
    for (int m = gw; m < T; m += ngw) { f32x4 v[8]; rms_load(X + (size_t)m * D, nw, F.lane, v); row_store_bf16(XN + (size_t)m * D, F.lane, v); }
}

__device__ __forceinline__ void phase_mix_pre(const Frame& F) {
    const int gw = F.blk * 8 + F.wave, ngw = F.G * 8, lane = F.lane;
    const bf16* P = (const bf16*)(F.ws + O_PROJ);
    float* QF = (float*)(F.ws + O_QF); float* KF = (float*)(F.ws + O_KF); float* VF = (float*)(F.ws + O_VF); float* FH = (float*)(F.ws + O_FH); float* QH = (float*)(F.ws + O_QH);
    const float* cw = F.in[I_GCONV];
    const float* lbl = F.in[I_LBL];
    for (int it = gw; it < T * 8; it += ngw) {
        const int t = it >> 3, h = it & 7, s = t & (SEQ - 1), d = h * 128 + 2 * lane;
        float r[3][2];
#pragma unroll
        for (int mat = 0; mat < 3; ++mat) { float a0 = 0.f, a1 = 0.f;
#pragma unroll
            for (int j = 0; j < 4; ++j) { if (s - 3 + j >= 0) { const unsigned w = *(const unsigned*)(P + (size_t)(t - 3 + j) * NPROJ + mat * 1024 + d);
                    const f32x2 c = *(const f32x2*)(cw + j * 3072 + mat * 1024 + d); a0 += c.x * bflo(w); a1 += c.y * bfhi(w); } }
            r[mat][0] = siluf_(a0); r[mat][1] = siluf_(a1); }
        const float qs = wave_sum(r[0][0] * r[0][0] + r[0][1] * r[0][1]), ks = wave_sum(r[1][0] * r[1][0] + r[1][1] * r[1][1]);
        const float qn = rsqrtf(qs + EPS) * 0.08838834764831845f, kn = rsqrtf(ks + EPS);
        const size_t o = (size_t)t * 1024 + d;
        *(f32x2*)(QF + o) = (f32x2){r[0][0] * qn, r[0][1] * qn}; *(f32x2*)(KF + o) = (f32x2){r[1][0] * kn, r[1][1] * kn}; *(f32x2*)(VF + o) = (f32x2){r[2][0], r[2][1]};
        const unsigned wq = *(const unsigned*)(P + (size_t)t * NPROJ + PQ_BQ + d), wf = *(const unsigned*)(P + (size_t)t * NPROJ + PQ_BF + d);
        const f32x2 l0 = *(const f32x2*)(lbl + d), l1 = *(const f32x2*)(lbl + 1024 + d);
        const float lb0 = sigmoidf_(l0.x - l1.x), lb1 = sigmoidf_(l0.y - l1.y);
        *(f32x2*)(FH + o) = (f32x2){lb0 + (1.f - lb0) * sigmoidf_(bflo(wf)), lb1 + (1.f - lb1) * sigmoidf_(bfhi(wf))};
        *(f32x2*)(QH + o) = (f32x2){siluf_(bflo(wq)) * 0.08838834764831845f, siluf_(bfhi(wq)) * 0.08838834764831845f};
    }
}

__device__ __forceinline__ void phase_mix_scan_slow(const Frame& F) {
    if (F.blk >= 32) return;
    const int mixer = F.blk >> 4, b = (F.blk >> 3) & 1, h = F.blk & 7, tid = F.tid;
    if (mixer == 0 && FAST_GDN) return;
    if (mixer == 1 && FAST_HGRN) return;
    LAS float* ks = (LAS float*)F.lds;
    LAS float* qs = ks + 8192; LAS float* vs = qs + 8192; LAS float* ot = vs + 8192;
    LAS float* red1 = ot + 8192; LAS float* red2 = red1 + 512; LAS float* ab = red2 + 512;
    const float* KSRC = (const float*)(F.ws + (mixer ? O_FH : O_KF)); const float* QSRC = (const float*)(F.ws + (mixer ? O_QH : O_QF)); const float* VSRC = (const float*)(F.ws + O_VF);
    const bf16* P = (const bf16*)(F.ws + O_PROJ); const float* GB = (const float*)(F.ws + O_GB);
    bf16* O = (bf16*)(F.ws + O_O);
    const float* nw = mixer ? F.in[I_HNW] : F.in[I_GNW];
    const int e = tid & 127, qd = tid >> 7;
    float S[32];
#pragma unroll
    for (int i = 0; i < 32; ++i) S[i] = 0.f;
    for (int n = 0; n < 64; ++n) {
        const int t0 = b * SEQ + n * 64;
        for (int idx = tid; idx < 64 * 32; idx += 512) { const int r = idx >> 5, c4 = (idx & 31) * 4; const size_t go = (size_t)(t0 + r) * 1024 + h * 128 + c4;
            *(LAS f32x4*)(ks + r * 128 + c4) = *(const f32x4*)(KSRC + go); *(LAS f32x4*)(qs + r * 128 + c4) = *(const f32x4*)(QSRC + go);
            f32x4 vv; if (mixer) { const v2u w = *(const v2u*)(P + (size_t)(t0 + r) * NPROJ + PQ_BI + h * 128 + c4); vv = (f32x4){bflo(w.x), bfhi(w.x), bflo(w.y), bfhi(w.y)}; } else vv = *(const f32x4*)(VSRC + go);
            *(LAS f32x4*)(vs + r * 128 + c4) = vv; }
        if (tid < 64) { ab[tid * 2] = __expf(GB[(size_t)(t0 + tid) * 16 + 8 + h]); ab[tid * 2 + 1] = GB[(size_t)(t0 + tid) * 16 + h]; }
        __syncthreads();
        for (int r = 0; r < 64; ++r) {
            const LAS float* kr = ks + r * 128 + qd * 32; const LAS float* qr = qs + r * 128 + qd * 32; const float ve = vs[r * 128 + e];
            float osum = 0.f;
            if (mixer == 0) {
                const float a = ab[r * 2], bt = ab[r * 2 + 1];
                float p = 0.f;
#pragma unroll
                for (int i = 0; i < 32; ++i) p += kr[i] * S[i];
                red1[qd * 128 + e] = p;
                __syncthreads();
                const float kS = (red1[e] + red1[128 + e]) + (red1[256 + e] + red1[384 + e]);
                const float c1 = bt * (ve - a * kS);
#pragma unroll
                for (int i = 0; i < 32; ++i) { S[i] = a * S[i] + kr[i] * c1; osum += qr[i] * S[i]; }
            } else {
#pragma unroll
                for (int i = 0; i < 32; ++i) { const float f = kr[i]; S[i] = f * S[i] + (1.f - f) * ve; osum += qr[i] * S[i]; }
            }
            red2[qd * 128 + e] = osum;
            __syncthreads();
            if (tid < 128) ot[r * 128 + e] = (red2[e] + red2[128 + e]) + (red2[256 + e] + red2[384 + e]);
        }
        __syncthreads();
        {
            const int r = tid >> 3, c0 = (tid & 7) * 16; float o[16]; float ss = 0.f;
#pragma unroll
            for (int i = 0; i < 16; ++i) { o[i] = ot[r * 128 + c0 + i]; ss += o[i] * o[i]; }
            ss += __shfl_xor(ss, 1); ss += __shfl_xor(ss, 2); ss += __shfl_xor(ss, 4);
            const float rstd = rsqrtf(ss * (1.0f / 128.0f) + EPS);
            const bf16* zp = P + (size_t)(t0 + r) * NPROJ + (mixer ? PQ_BG : PQ_AZ) + h * 128 + c0;
            const v4u z0 = *(const v4u*)zp, z1 = *(const v4u*)(zp + 8);
            const unsigned zw[8] = {z0.x, z0.y, z0.z, z0.w, z1.x, z1.y, z1.z, z1.w};
            unsigned ow[8];
#pragma unroll
            for (int i = 0; i < 8; ++i) { const float za = bflo(zw[i]), zb = bfhi(zw[i]);
                ow[i] = pk2(o[2 * i] * rstd * nw[c0 + 2 * i] * siluf_(za), o[2 * i + 1] * rstd * nw[c0 + 2 * i + 1] * siluf_(zb)); }
            bf16* op = O + (size_t)(t0 + r) * D + mixer * 1024 + h * 128 + c0;
            *(v4u*)op = (v4u){ow[0], ow[1], ow[2], ow[3]}; *(v4u*)(op + 8) = (v4u){ow[4], ow[5], ow[6], ow[7]};
        }
        __syncthreads();
    }
}


constexpr int R_NW = 0, R_QD = 16384, R_QK = 32768, R_KDT = 40960, R_DEC = 57344;
__device__ __forceinline__ int frag_off(int row, int k, int nkb) { const int mt = row >> 4, kb = k >> 5, r = row & 15, k5 = k & 31, g = (k5 >> 2) & 3, j = (k5 >> 4) * 4 + (k5 & 3); return ((mt * nkb + kb) * 64 + g * 16 + r) * 16 + j * 2; }
__device__ __forceinline__ bf16x8 pack8(const f32x4 a, const f32x4 b) { v4u w; w.x = pk2(a[0], a[1]); w.y = pk2(a[2], a[3]); w.z = pk2(b[0], b[1]); w.w = pk2(b[2], b[3]); return __builtin_bit_cast(bf16x8, w); }

__device__ __forceinline__ void store_frag_row16(unsigned char* base, int row, int cb, int nkb, const float (&x)[16]) {
#pragma unroll
    for (int a = 0; a < 4; ++a) { v2u w; w.x = pk2(x[4 * a], x[4 * a + 1]); w.y = pk2(x[4 * a + 2], x[4 * a + 3]); *(v2u*)(base + frag_off(row, cb * 16 + 4 * a, nkb)) = w; }
}

__device__ __forceinline__ void gdn_prep_unit(const Frame& F, int b, int h, int n) {
    const int tid = F.tid, lane = F.lane, wave = F.wave, r = tid >> 3, cb = tid & 7, t0 = b * SEQ + n * 64, seq = b * 8 + h;
    LAS bf16* KB = (LAS bf16*)F.lds;
    LAS bf16* QB = (LAS bf16*)(F.lds + 17408);
    LAS float* LM = (LAS float*)(F.lds + 34816);
    LAS float* RHS = (LAS float*)(F.lds + 52224);
    LAS float* GC = (LAS float*)(F.lds + 117760);
    const bf16* P = (const bf16*)(F.ws + O_PROJ); const float* GB = (const float*)(F.ws + O_GB); const float* cw = F.in[I_GCONV];
    unsigned char* rec = F.ws + O_OPS + ((size_t)seq * 64 + n) * REC_BYTES; float* UT = (float*)(F.ws + O_UT) + ((size_t)seq * 64 + n) * 8192;
    float q[16], k[16], v[16];
    {
        LAS unsigned char* PT = F.lds + 52224;
        LAS float* CW = (LAS float*)(F.lds + 34816);
        for (int p = tid; p < 67 * 48; p += 512) { const int row = p / 48, pc = p - row * 48; v4u w = (v4u){0u, 0u, 0u, 0u};
            if (n * 64 - 3 + row >= 0) w = *(const v4u*)(P + (size_t)(t0 - 3 + row) * NPROJ + (pc >> 4) * 1024 + h * 128 + (pc & 15) * 8);
            *(LAS v4u*)(PT + row * 784 + pc * 16) = w; }
        if (tid < 384) { const int ri = tid >> 5, pc = tid & 31, j = ri / 3, mat = ri - 3 * j; *(LAS f32x4*)(CW + ri * 128 + pc * 4) = *(const f32x4*)(cw + j * 3072 + mat * 1024 + h * 128 + pc * 4); }
        SBAR();
#pragma unroll
        for (int mat = 0; mat < 3; ++mat) { float a[16];
#pragma unroll
            for (int i = 0; i < 16; ++i) a[i] = 0.f;
#pragma unroll
            for (int j = 0; j < 4; ++j) { const LAS unsigned char* pp = PT + (r + j) * 784 + mat * 256 + cb * 32; const v4u w0 = *(const LAS v4u*)pp, w1 = *(const LAS v4u*)(pp + 16);
                    const LAS float* cp = CW + (j * 3 + mat) * 128 + cb * 16; const f32x4 c0 = *(const LAS f32x4*)cp, c1 = *(const LAS f32x4*)(cp + 4), c2 = *(const LAS f32x4*)(cp + 8), c3 = *(const LAS f32x4*)(cp + 12);
                    a[0] += c0.x * bflo(w0.x); a[1] += c0.y * bfhi(w0.x); a[2] += c0.z * bflo(w0.y); a[3] += c0.w * bfhi(w0.y); a[4] += c1.x * bflo(w0.z); a[5] += c1.y * bfhi(w0.z); a[6] += c1.z * bflo(w0.w); a[7] += c1.w * bfhi(w0.w);
                    a[8] += c2.x * bflo(w1.x); a[9] += c2.y * bfhi(w1.x); a[10] += c2.z * bflo(w1.y); a[11] += c2.w * bfhi(w1.y); a[12] += c3.x * bflo(w1.z); a[13] += c3.y * bfhi(w1.z); a[14] += c3.z * bflo(w1.w); a[15] += c3.w * bfhi(w1.w); }
#pragma unroll
        for (int i = 0; i < 16; ++i) { const float y = siluf_(a[i]); if (mat == 0) q[i] = y; else if (mat == 1) k[i] = y; else v[i] = y; }
            asm volatile("" ::: "memory"); }
        float qs = 0.f, ks = 0.f;
#pragma unroll
        for (int i = 0; i < 16; ++i) { qs += q[i] * q[i]; ks += k[i] * k[i]; }
        qs += __shfl_xor(qs, 1); qs += __shfl_xor(qs, 2); qs += __shfl_xor(qs, 4); ks += __shfl_xor(ks, 1); ks += __shfl_xor(ks, 2); ks += __shfl_xor(ks, 4);
        const float qn = rsqrtf(qs + EPS) * 0.08838834764831845f, kn = rsqrtf(ks + EPS);
#pragma unroll
        for (int i = 0; i < 16; ++i) { q[i] *= qn; k[i] *= kn; }
        if (cb == 0) { GC[64 + r] = GB[(size_t)(t0 + r) * 16 + h]; GC[128 + r] = GB[(size_t)(t0 + r) * 16 + 8 + h]; }
        v4u w0, w1; w0.x = pk2(k[0], k[1]); w0.y = pk2(k[2], k[3]); w0.z = pk2(k[4], k[5]); w0.w = pk2(k[6], k[7]); w1.x = pk2(k[8], k[9]); w1.y = pk2(k[10], k[11]); w1.z = pk2(k[12], k[13]); w1.w = pk2(k[14], k[15]);
        *(LAS v4u*)(KB + r * 136 + cb * 16) = w0; *(LAS v4u*)(KB + r * 136 + cb * 16 + 8) = w1;
        w0.x = pk2(q[0], q[1]); w0.y = pk2(q[2], q[3]); w0.z = pk2(q[4], q[5]); w0.w = pk2(q[6], q[7]); w1.x = pk2(q[8], q[9]); w1.y = pk2(q[10], q[11]); w1.z = pk2(q[12], q[13]); w1.w = pk2(q[14], q[15]);
        *(LAS v4u*)(QB + r * 136 + cb * 16) = w0; *(LAS v4u*)(QB + r * 136 + cb * 16 + 8) = w1;
    }
    SBAR();
    if (wave == 0) { float x = GC[128 + lane];
#pragma unroll
        for (int o = 1; o < 64; o <<= 1) { const float y = __shfl_up(x, o); if (lane >= o) x += y; }
        GC[lane] = x; }
    SBAR();
    const float gcr = GC[r], betar = GC[64 + r], egr = __expf(gcr), gclast = GC[63];
    {
        const int tid = fresh_tid(F.tid), lane = tid & 63, wave = __builtin_amdgcn_readfirstlane(tid >> 6), r = tid >> 3, cb = tid & 7; (void)lane; (void)wave; (void)r; (void)cb;
#pragma unroll
        for (int a = 0; a < 4; ++a) { *(LAS f32x4*)(RHS + r * 256 + cb * 16 + 4 * a) = (f32x4){v[4 * a] * betar, v[4 * a + 1] * betar, v[4 * a + 2] * betar, v[4 * a + 3] * betar};
            const float kb_ = betar * egr; *(LAS f32x4*)(RHS + r * 256 + 128 + cb * 16 + 4 * a) = (f32x4){k[4 * a] * kb_, k[4 * a + 1] * kb_, k[4 * a + 2] * kb_, k[4 * a + 3] * kb_}; }
        float qd[16];
#pragma unroll
        for (int i = 0; i < 16; ++i) qd[i] = q[i] * egr;
        store_frag_row16(rec + R_QD, r, cb, 4, qd);
    }
    {
        const int tid = fresh_tid(F.tid), lane = tid & 63, wave = __builtin_amdgcn_readfirstlane(tid >> 6), r = tid >> 3, cb = tid & 7; (void)lane; (void)wave; (void)r; (void)cb;
        const int mat = wave >> 2, mt = wave & 3, fr = lane & 15, g = lane >> 4; const LAS bf16* AB = mat ? QB : KB;
        bf16x8 af[4];
#pragma unroll
        for (int kb = 0; kb < 4; ++kb) af[kb] = *(const LAS bf16x8*)(AB + (mt * 16 + fr) * 136 + kb * 32 + 8 * g);
#pragma unroll
        for (int nt = 0; nt < 4; ++nt) { f32x4 acc = (f32x4){0.f, 0.f, 0.f, 0.f};
            if (nt <= mt) {
#pragma unroll
                for (int kb = 0; kb < 4; ++kb) { const bf16x8 bfr = *(const LAS bf16x8*)(KB + (nt * 16 + fr) * 136 + kb * 32 + 8 * g); acc = __builtin_amdgcn_mfma_f32_16x16x32_bf16(af[kb], bfr, acc, 0, 0, 0); } }
            const int sc = nt * 16 + fr; const float gcs = GC[sc];
#pragma unroll
            for (int i = 0; i < 4; ++i) { const int c = mt * 16 + 4 * g + i; const float dcy = __expf(GC[c] - gcs);
                if (mat == 0) { if (nt <= mt) LM[c * 68 + sc] = (sc < c) ? GC[64 + c] * acc[i] * dcy : 0.f; }
                else *(bf16*)(rec + R_QK + frag_off(c, sc, 2)) = (bf16)f2bf((sc <= c && nt <= mt) ? acc[i] * dcy : 0.f); } }
    }
    SBAR();
    {
        const int tid = fresh_tid(F.tid), lane = tid & 63, wave = __builtin_amdgcn_readfirstlane(tid >> 6), r = tid >> 3, cb = tid & 7; (void)lane; (void)wave; (void)r; (void)cb;
        const int d = tid >> 2, cp = tid & 3;
#pragma unroll
        for (int a = 0; a < 4; ++a) { float y[4];
#pragma unroll
            for (int e = 0; e < 4; ++e) { const int c = 16 * cp + 4 * a + e; y[e] = bf2f(KB[c * 136 + d]) * __expf(gclast - GC[c]); }
            v2u w; w.x = pk2(y[0], y[1]); w.y = pk2(y[2], y[3]); *(v2u*)(rec + R_KDT + frag_off(d, 16 * cp + 4 * a, 2)) = w; }
        if (tid < 128) ((float*)(rec + R_DEC))[tid] = __expf(gclast);
    }
    {
        const int tid = fresh_tid(F.tid), lane = tid & 63, wave = __builtin_amdgcn_readfirstlane(tid >> 6), r = tid >> 3, cb = tid & 7; (void)lane; (void)wave; (void)r; (void)cb;
        const int c = tid >> 1, half = tid & 1;
        float xs[32];
#pragma unroll
        for (int i = 0; i < 32; ++i) xs[i] = 0.f;
        f32x4 lc[8], ln[8]; float rc = RHS[c], rn = 0.f;
#pragma unroll
        for (int i = 0; i < 64; ++i) {
            if (i + 1 < 64) { rn = RHS[(i + 1) * 256 + c];
#pragma unroll
                for (int g2 = 0; g2 < (i + 8) / 8; ++g2) ln[g2] = *(const LAS f32x4*)(LM + (i + 1) * 68 + 8 * g2 + 4 * half); }
            __builtin_amdgcn_sched_barrier(0);
            float a0 = 0.f, a1 = 0.f, a2 = 0.f, a3 = 0.f;
#pragma unroll
            for (int g2 = 0; g2 < (i + 7) / 8; ++g2) { a0 += lc[g2][0] * xs[4 * g2]; a1 += lc[g2][1] * xs[4 * g2 + 1]; a2 += lc[g2][2] * xs[4 * g2 + 2]; a3 += lc[g2][3] * xs[4 * g2 + 3]; }
            float part = (a0 + a1) + (a2 + a3); part += __builtin_bit_cast(float, __builtin_amdgcn_update_dpp(0, __builtin_bit_cast(int, part), 0xB1, 0xF, 0xF, true));
            const float xi = rc - part;
            xs[(i >> 3) * 4 + (i & 3)] = (((i >> 2) & 1) == half) ? xi : xs[(i >> 3) * 4 + (i & 3)];
            if (half == 0) RHS[i * 256 + c] = xi;
            __builtin_amdgcn_sched_barrier(0);
            rc = rn;
#pragma unroll
            for (int g2 = 0; g2 < 8; ++g2) lc[g2] = ln[g2]; }
    }
    SBAR();
    {
        const int tid = fresh_tid(F.tid), lane = tid & 63, wave = __builtin_amdgcn_readfirstlane(tid >> 6), r = tid >> 3, cb = tid & 7; (void)lane; (void)wave; (void)r; (void)cb;
        const int dv = tid >> 2, cq = (tid & 3) * 16;
#pragma unroll
        for (int a = 0; a < 4; ++a) { f32x4 o;
#pragma unroll
            for (int e = 0; e < 4; ++e) o[e] = RHS[(cq + 4 * a + e) * 256 + dv];
            *(f32x4*)(UT + dv * 64 + cq + 4 * a) = o; }
        float nw[16];
#pragma unroll
        for (int a = 0; a < 4; ++a) { const f32x4 t4 = *(const LAS f32x4*)(RHS + r * 256 + 128 + cb * 16 + 4 * a); nw[4 * a] = -t4.x; nw[4 * a + 1] = -t4.y; nw[4 * a + 2] = -t4.z; nw[4 * a + 3] = -t4.w; }
        store_frag_row16(rec + R_NW, r, cb, 4, nw);
    }
    SBAR();
}

__device__ __forceinline__ void hgrn_prep_unit(const Frame& F, int b, int h, int n) {
    const int tid = F.tid, lane = F.lane, wave = F.wave, r = tid >> 3, cb = tid & 7, t0 = b * SEQ + n * 64, seq = 16 + b * 8 + h;
    LAS float* LF = (LAS float*)F.lds;
    LAS bf16* QB = (LAS bf16*)(F.lds + 32768);
    LAS bf16* KB = (LAS bf16*)(F.lds + 50176);
    LAS bf16* KD = (LAS bf16*)(F.lds + 67584);
    LAS float* VT = (LAS float*)(F.lds + 84992);
    const bf16* P = (const bf16*)(F.ws + O_PROJ); const float* lbl = F.in[I_LBL];
    unsigned char* rec = F.ws + O_OPS + ((size_t)seq * 64 + n) * REC_BYTES; float* UT = (float*)(F.ws + O_UT) + ((size_t)seq * 64 + n) * 8192;
    float q[16], kk[16], lf[16];
    {
        const bf16* pq = P + (size_t)(t0 + r) * NPROJ + PQ_BQ + h * 128 + cb * 16; const bf16* pf = P + (size_t)(t0 + r) * NPROJ + PQ_BF + h * 128 + cb * 16; const bf16* pi = P + (size_t)(t0 + r) * NPROJ + PQ_BI + h * 128 + cb * 16;
        const v4u q0 = *(const v4u*)pq, q1 = *(const v4u*)(pq + 8), f0 = *(const v4u*)pf, f1 = *(const v4u*)(pf + 8), i0 = *(const v4u*)pi, i1 = *(const v4u*)(pi + 8);
        const unsigned qw[8] = {q0.x, q0.y, q0.z, q0.w, q1.x, q1.y, q1.z, q1.w}, fw[8] = {f0.x, f0.y, f0.z, f0.w, f1.x, f1.y, f1.z, f1.w}, iw[8] = {i0.x, i0.y, i0.z, i0.w, i1.x, i1.y, i1.z, i1.w};
#pragma unroll
        for (int i = 0; i < 16; ++i) { const int d = h * 128 + cb * 16 + i; const float lb = sigmoidf_(lbl[d] - lbl[1024 + d]);
            const float fl = (i & 1) ? bfhi(fw[i >> 1]) : bflo(fw[i >> 1]), ql = (i & 1) ? bfhi(qw[i >> 1]) : bflo(qw[i >> 1]), vl = (i & 1) ? bfhi(iw[i >> 1]) : bflo(iw[i >> 1]);
            const float fg = lb + (1.f - lb) * sigmoidf_(fl); lf[i] = __logf(fg); kk[i] = 1.f - fg; q[i] = siluf_(ql) * 0.08838834764831845f;
            VT[(cb * 16 + i) * 65 + r] = vl; }
#pragma unroll
        for (int a = 0; a < 4; ++a) *(LAS f32x4*)(LF + r * 128 + cb * 16 + 4 * a) = (f32x4){lf[4 * a], lf[4 * a + 1], lf[4 * a + 2], lf[4 * a + 3]};
    }
    SBAR();
    {
        const int d = tid & 127, qr = tid >> 7; float run = 0.f; float tv[16];
#pragma unroll
        for (int i = 0; i < 16; ++i) tv[i] = LF[(16 * qr + i) * 128 + d];
#pragma unroll
        for (int i = 0; i < 16; ++i) { run += tv[i]; tv[i] = run; }
#pragma unroll
        for (int i = 0; i < 16; ++i) LF[(16 * qr + i) * 128 + d] = tv[i];
    }
    SBAR();
    {
        float bb[16], bref[16], blast[16];
#pragma unroll
        for (int a = 0; a < 4; ++a) { const int co = cb * 16 + 4 * a;
            const f32x4 t15 = *(const LAS f32x4*)(LF + 15 * 128 + co), t31 = *(const LAS f32x4*)(LF + 31 * 128 + co), t47 = *(const LAS f32x4*)(LF + 47 * 128 + co), t63 = *(const LAS f32x4*)(LF + 63 * 128 + co), tr = *(const LAS f32x4*)(LF + r * 128 + co);
            const int qr = r >> 4;
#pragma unroll
            for (int e = 0; e < 4; ++e) { float off = 0.f; if (qr > 0) off += t15[e]; if (qr > 1) off += t31[e]; if (qr > 2) off += t47[e];
                bb[4 * a + e] = tr[e] + off; bref[4 * a + e] = t15[e] + t31[e]; blast[4 * a + e] = (t15[e] + t31[e]) + (t47[e] + t63[e]); } }
        float qt[16], kt[16], kd[16], qd[16];
#pragma unroll
        for (int i = 0; i < 16; ++i) { qt[i] = q[i] * __expf(bb[i] - bref[i]); kt[i] = kk[i] * __expf(bref[i] - bb[i]); kd[i] = kk[i] * __expf(blast[i] - bb[i]); qd[i] = q[i] * __expf(bb[i]); }
        v4u w0, w1;
        w0.x = pk2(qt[0], qt[1]); w0.y = pk2(qt[2], qt[3]); w0.z = pk2(qt[4], qt[5]); w0.w = pk2(qt[6], qt[7]); w1.x = pk2(qt[8], qt[9]); w1.y = pk2(qt[10], qt[11]); w1.z = pk2(qt[12], qt[13]); w1.w = pk2(qt[14], qt[15]);
        *(LAS v4u*)(QB + r * 136 + cb * 16) = w0; *(LAS v4u*)(QB + r * 136 + cb * 16 + 8) = w1;
        w0.x = pk2(kt[0], kt[1]); w0.y = pk2(kt[2], kt[3]); w0.z = pk2(kt[4], kt[5]); w0.w = pk2(kt[6], kt[7]); w1.x = pk2(kt[8], kt[9]); w1.y = pk2(kt[10], kt[11]); w1.z = pk2(kt[12], kt[13]); w1.w = pk2(kt[14], kt[15]);
        *(LAS v4u*)(KB + r * 136 + cb * 16) = w0; *(LAS v4u*)(KB + r * 136 + cb * 16 + 8) = w1;
        w0.x = pk2(kd[0], kd[1]); w0.y = pk2(kd[2], kd[3]); w0.z = pk2(kd[4], kd[5]); w0.w = pk2(kd[6], kd[7]); w1.x = pk2(kd[8], kd[9]); w1.y = pk2(kd[10], kd[11]); w1.z = pk2(kd[12], kd[13]); w1.w = pk2(kd[14], kd[15]);
        *(LAS v4u*)(KD + r * 136 + cb * 16) = w0; *(LAS v4u*)(KD + r * 136 + cb * 16 + 8) = w1;
        store_frag_row16(rec + R_QD, r, cb, 4, qd);
        if (r == 63) {
#pragma unroll
            for (int a = 0; a < 4; ++a) *(f32x4*)((float*)(rec + R_DEC) + cb * 16 + 4 * a) = (f32x4){__expf(blast[4 * a]), __expf(blast[4 * a + 1]), __expf(blast[4 * a + 2]), __expf(blast[4 * a + 3])}; }
    }
    SBAR();
    {
        const int mt = wave >> 1, fr = lane & 15, g = lane >> 4;
        bf16x8 af[4];
#pragma unroll
        for (int kb = 0; kb < 4; ++kb) af[kb] = *(const LAS bf16x8*)(QB + (mt * 16 + fr) * 136 + kb * 32 + 8 * g);
#pragma unroll
        for (int nn = 0; nn < 2; ++nn) { const int nt = 2 * (wave & 1) + nn; f32x4 acc = (f32x4){0.f, 0.f, 0.f, 0.f};
            if (nt <= mt) {
#pragma unroll
                for (int kb = 0; kb < 4; ++kb) { const bf16x8 bfr = *(const LAS bf16x8*)(KB + (nt * 16 + fr) * 136 + kb * 32 + 8 * g); acc = __builtin_amdgcn_mfma_f32_16x16x32_bf16(af[kb], bfr, acc, 0, 0, 0); } }
            const int sc = nt * 16 + fr;
#pragma unroll
            for (int i = 0; i < 4; ++i) { const int c = mt * 16 + 4 * g + i; *(bf16*)(rec + R_QK + frag_off(c, sc, 2)) = (bf16)f2bf((sc <= c && nt <= mt) ? acc[i] : 0.f); } }
        const int d = tid >> 2, cp = tid & 3;
#pragma unroll
        for (int a = 0; a < 4; ++a) { float y[4];
#pragma unroll
            for (int e = 0; e < 4; ++e) y[e] = bf2f(KD[(16 * cp + 4 * a + e) * 136 + d]);
            v2u w; w.x = pk2(y[0], y[1]); w.y = pk2(y[2], y[3]); *(v2u*)(rec + R_KDT + frag_off(d, 16 * cp + 4 * a, 2)) = w;
            f32x4 o;
#pragma unroll
            for (int e = 0; e < 4; ++e) o[e] = VT[d * 65 + 16 * cp + 4 * a + e];
            *(f32x4*)(UT + d * 64 + 16 * cp + 4 * a) = o; }
    }
    SBAR();
}

__device__ __forceinline__ void phase_mix_prep(const Frame& F, int only = 0) {
    { TS_BEGIN(3) if (FAST_GDN && only != 2) for (int rest = F.blk; rest < 1024; rest += F.G) { const int n = rest & 63, h = (rest >> 6) & 7, b = rest >> 9; gdn_prep_unit(F, b, h, n); } TS_END(3) }
    { TS_BEGIN(4) if (FAST_HGRN && only != 1) for (int rest = F.blk; rest < 1024; rest += F.G) { const int n = rest & 63, h = (rest >> 6) & 7, b = rest >> 9; hgrn_prep_unit(F, b, h, n); } TS_END(4) }
}

__device__ __forceinline__ unsigned lds_addr(const volatile LAS void* p) { return (unsigned)(size_t)p; }
__device__ __forceinline__ void glds16_asm(const void* gsrc, unsigned lds_dst) {
    unsigned keep;
    asm volatile("s_mov_b32 %0, m0\n\ts_mov_b32 m0, %2\n\ts_nop 0\n\tglobal_load_lds_dwordx4 %1, off\n\ts_mov_b32 m0, %0" : "=&s"(keep) : "v"(gsrc), "s"(lds_dst) : "memory");
}
template <int mixer>
__device__ __forceinline__ void mix_scan_body(const Frame& F) {
    const int seq = F.blk, b = (seq >> 3) & 1, h = seq & 7, tid = F.tid, lane = F.lane, w = F.wave, n16 = lane & 15, g = lane >> 4;
    LAS unsigned char* buf0 = F.lds; LAS unsigned char* buf1 = F.lds + REC_BYTES; LAS float* OT = (LAS float*)(F.lds + 2 * REC_BYTES);
    const unsigned char* rec = F.ws + O_OPS + (size_t)seq * 64 * REC_BYTES; const float* UTb = (const float*)(F.ws + O_UT) + (size_t)seq * 64 * 8192;
    const bf16* P = (const bf16*)(F.ws + O_PROJ); bf16* O = (bf16*)(F.ws + O_O); const float* nwp = mixer ? F.in[I_HNW] : F.in[I_GNW];
    const int er = tid >> 3, ec0 = (tid & 7) * 16, zcol = (mixer ? PQ_BG : PQ_AZ) + h * 128 + ec0;
    float nw[16];
#pragma unroll
    for (int i = 0; i < 16; ++i) nw[i] = nwp[ec0 + i];
#pragma unroll
    for (int i = 0; i < 16; ++i) asm volatile("" : "+v"(nw[i]));
    constexpr int NP = mixer ? 6 : 8;
    const int kb0 = mixer ? 16 : 0;
    const unsigned l0 = (unsigned)__builtin_amdgcn_readfirstlane((int)lds_addr(buf0)), l1 = (unsigned)__builtin_amdgcn_readfirstlane((int)lds_addr(buf1));
#define SCAN_ISSUE(st_, ldsb_) do { const unsigned char* rs_ = rec + (size_t)(st_) * REC_BYTES; \
        _Pragma("unroll") for (int i_ = 0; i_ < NP; ++i_) { int p_ = kb0 + w + 8 * i_; p_ = p_ > 56 ? 56 : p_; glds16_asm(rs_ + p_ * 1024 + lane * 16, (ldsb_) + (unsigned)p_ * 1024u); } } while (0)
#define SCAN_LOADU(st_, U_) do { const float* up_ = UTb + (size_t)(st_) * 8192 + (16 * w + n16) * 64 + 4 * g; \
        _Pragma("unroll") for (int mt_ = 0; mt_ < 4; ++mt_) asm volatile("global_load_dwordx4 %0, %1, off" : "=v"(U_[mt_]) : "v"(up_ + 16 * mt_) : "memory"); } while (0)
    f32x4 Sacc[8]; bf16x8 Sb[4];
#pragma unroll
    for (int i = 0; i < 8; ++i) Sacc[i] = (f32x4){0.f, 0.f, 0.f, 0.f};
#pragma unroll
    for (int i = 0; i < 4; ++i) Sb[i] = (bf16x8){0, 0, 0, 0, 0, 0, 0, 0};
    f32x4 UA[4], UB[4];
    asm volatile("s_waitcnt vmcnt(0)" ::: "memory");
    SCAN_ISSUE(0, l0); SCAN_LOADU(0, UA);
    asm volatile("s_waitcnt vmcnt(0)" ::: "memory");
#define AFR(base_, idx_) (*(const LAS bf16x8*)(cur + (base_) + (idx_) * 1024 + lane * 16))
#define SCAN_STEP(st, cur, ldsn, Uc, Un) do { \
        asm volatile("s_waitcnt vmcnt(2)" ::: "memory"); SBAR(); \
        asm volatile("" : "+v"(Uc[0]), "+v"(Uc[1]), "+v"(Uc[2]), "+v"(Uc[3])); \
        const int t0 = b * SEQ + (st) * 64; const int stn = (st) + 1 < 64 ? (st) + 1 : 63; \
        v4u z0, z1; { const bf16* zp = P + (size_t)(t0 + er) * NPROJ + zcol; \
            asm volatile("global_load_dwordx4 %0, %1, off" : "=v"(z0) : "v"(zp) : "memory"); asm volatile("global_load_dwordx4 %0, %1, off" : "=v"(z1) : "v"(zp + 8) : "memory"); } \
        SCAN_ISSUE(stn, ldsn); SCAN_LOADU(stn, Un); \
        f32x4 vn[4]; \
        _Pragma("unroll") for (int mt = 0; mt < 4; ++mt) vn[mt] = Uc[mt]; \
        if (mixer == 0) { \
            _Pragma("unroll") for (int hh = 0; hh < 2; ++hh) { bf16x8 af[8]; \
                _Pragma("unroll") for (int i = 0; i < 8; ++i) af[i] = AFR(R_NW, hh * 8 + i); \
                _Pragma("unroll") for (int i = 0; i < 8; ++i) vn[hh * 2 + (i >> 2)] = __builtin_amdgcn_mfma_f32_16x16x32_bf16(af[i], Sb[i & 3], vn[hh * 2 + (i >> 2)], 0, 0, 0); } } \
        bf16x8 Vb[2]; Vb[0] = pack8(vn[0], vn[1]); Vb[1] = pack8(vn[2], vn[3]); \
        f32x4 o[4]; \
        _Pragma("unroll") for (int mt = 0; mt < 4; ++mt) o[mt] = (f32x4){0.f, 0.f, 0.f, 0.f}; \
        _Pragma("unroll") for (int hh = 0; hh < 2; ++hh) { bf16x8 af[8]; \
            _Pragma("unroll") for (int i = 0; i < 8; ++i) af[i] = AFR(R_QD, hh * 8 + i); \
            _Pragma("unroll") for (int i = 0; i < 8; ++i) o[hh * 2 + (i >> 2)] = __builtin_amdgcn_mfma_f32_16x16x32_bf16(af[i], Sb[i & 3], o[hh * 2 + (i >> 2)], 0, 0, 0); } \
        { bf16x8 af[8]; \
            _Pragma("unroll") for (int i = 0; i < 8; ++i) af[i] = AFR(R_QK, i); \
            _Pragma("unroll") for (int i = 0; i < 8; ++i) o[i >> 1] = __builtin_amdgcn_mfma_f32_16x16x32_bf16(af[i], Vb[i & 1], o[i >> 1], 0, 0, 0); } \
        _Pragma("unroll") for (int hh = 0; hh < 2; ++hh) { bf16x8 af[8]; f32x4 dec[4]; \
            _Pragma("unroll") for (int i = 0; i < 8; ++i) af[i] = AFR(R_KDT, hh * 8 + i); \
            _Pragma("unroll") for (int i = 0; i < 4; ++i) dec[i] = *(const LAS f32x4*)(cur + R_DEC + (16 * (hh * 4 + i) + 4 * g) * 4); \
            _Pragma("unroll") for (int i = 0; i < 4; ++i) Sacc[hh * 4 + i] = Sacc[hh * 4 + i] * dec[i]; \
            _Pragma("unroll") for (int i = 0; i < 8; ++i) Sacc[hh * 4 + (i >> 1)] = __builtin_amdgcn_mfma_f32_16x16x32_bf16(af[i], Vb[i & 1], Sacc[hh * 4 + (i >> 1)], 0, 0, 0); } \
        _Pragma("unroll") for (int kb = 0; kb < 4; ++kb) Sb[kb] = pack8(Sacc[2 * kb], Sacc[2 * kb + 1]); \
        _Pragma("unroll") for (int mt = 0; mt < 4; ++mt) _Pragma("unroll") for (int i = 0; i < 4; ++i) OT[(16 * mt + 4 * g + i) * 132 + 16 * w + n16] = o[mt][i]; \
        SBAR(); \
        if (mixer == 0) asm volatile("s_waitcnt vmcnt(12)" ::: "memory"); else asm volatile("s_waitcnt vmcnt(10)" ::: "memory"); asm volatile("" : "+v"(z0), "+v"(z1)); \
        { float ov[16]; float ss = 0.f; \
            _Pragma("unroll") for (int a = 0; a < 4; ++a) { const f32x4 t4 = *(const LAS f32x4*)(OT + er * 132 + ec0 + 4 * a); ov[4 * a] = t4.x; ov[4 * a + 1] = t4.y; ov[4 * a + 2] = t4.z; ov[4 * a + 3] = t4.w; ss += (t4.x * t4.x + t4.y * t4.y) + (t4.z * t4.z + t4.w * t4.w); } \
            ss += __shfl_xor(ss, 1); ss += __shfl_xor(ss, 2); ss += __shfl_xor(ss, 4); \
            const float rstd = rsqrtf(ss * (1.0f / 128.0f) + EPS); \
            const unsigned zw[8] = {z0.x, z0.y, z0.z, z0.w, z1.x, z1.y, z1.z, z1.w}; unsigned ow[8]; \
            _Pragma("unroll") for (int i = 0; i < 8; ++i) ow[i] = pk2(ov[2 * i] * rstd * nw[2 * i] * siluf_(bflo(zw[i])), ov[2 * i + 1] * rstd * nw[2 * i + 1] * siluf_(bfhi(zw[i]))); \
            bf16* op = O + (size_t)(t0 + er) * D + mixer * 1024 + h * 128 + ec0; \
            *(v4u*)op = (v4u){ow[0], ow[1], ow[2], ow[3]}; *(v4u*)(op + 8) = (v4u){ow[4], ow[5], ow[6], ow[7]}; } \
    } while (0)
    for (int st = 0; st < 64; st += 2) {
        { LAS unsigned char* cur = buf0; SCAN_STEP(st, cur, l1, UA, UB); }
        { LAS unsigned char* cur = buf1; SCAN_STEP(st + 1, cur, l0, UB, UA); }
    }
    asm volatile("s_waitcnt vmcnt(0)" ::: "memory"); SBAR();
#undef SCAN_STEP
#undef AFR
#undef SCAN_LOADU
#undef SCAN_ISSUE
}
__device__ __forceinline__ void phase_mix_scan(const Frame& F) {
    if (F.blk >= 32) return;
    if (F.blk < 16) { if (FAST_GDN) mix_scan_body<0>(F); } else { if (FAST_HGRN) mix_scan_body<1>(F); }
}

__device__ __forceinline__ void phase_lru_conv(const Frame& F) {
    const bf16* XBR = (const bf16*)(F.ws + O_XBR); bf16* XC = (bf16*)(F.ws + O_XC);
    const float* cw = F.in[I_RGCW]; const float* cb = F.in[I_RGCB];
    for (int idx = F.blk * 512 + F.tid; idx < (T / 16) * 256; idx += F.G * 512) {
        const int t0 = (idx >> 8) * 16, c0 = (idx & 255) * 8; const bool head = (t0 & (SEQ - 1)) == 0;
        v4u r[19];
#pragma unroll
        for (int j = 0; j < 19; ++j) { if (j < 3 && head) r[j] = (v4u){0u, 0u, 0u, 0u}; else r[j] = *(const v4u*)(XBR + (size_t)(t0 - 3 + j) * D + c0); }
        float k[4][8], bs[8];
        { const f32x4 b0 = *(const f32x4*)(cb + c0), b1 = *(const f32x4*)(cb + c0 + 4); bs[0] = b0.x; bs[1] = b0.y; bs[2] = b0.z; bs[3] = b0.w; bs[4] = b1.x; bs[5] = b1.y; bs[6] = b1.z; bs[7] = b1.w; }
#pragma unroll
        for (int j = 0; j < 4; ++j) { const f32x4 k0 = *(const f32x4*)(cw + j * D + c0), k1 = *(const f32x4*)(cw + j * D + c0 + 4);
            k[j][0] = k0.x; k[j][1] = k0.y; k[j][2] = k0.z; k[j][3] = k0.w; k[j][4] = k1.x; k[j][5] = k1.y; k[j][6] = k1.z; k[j][7] = k1.w; }
#pragma unroll
        for (int i = 0; i < 16; ++i) {
            float a[8];
#pragma unroll
            for (int e = 0; e < 8; ++e) a[e] = bs[e];
#pragma unroll
            for (int j = 0; j < 4; ++j) { const v4u w = r[i + j];
                if (!(head && i + j < 3)) {
                    a[0] += k[j][0] * bflo(w.x); a[1] += k[j][1] * bfhi(w.x); a[2] += k[j][2] * bflo(w.y); a[3] += k[j][3] * bfhi(w.y);
                    a[4] += k[j][4] * bflo(w.z); a[5] += k[j][5] * bfhi(w.z); a[6] += k[j][6] * bflo(w.w); a[7] += k[j][7] * bfhi(w.w); } }
            *(v4u*)(XC + (size_t)(t0 + i) * D + c0) = (v4u){pk2(a[0], a[1]), pk2(a[2], a[3]), pk2(a[4], a[5]), pk2(a[6], a[7])};
        }
    }
}
__device__ __forceinline__ void phase_lru_scan1(const Frame& F) {
    const bf16* LA = (const bf16*)(F.ws + O_AA); const bf16* BB = (const bf16*)(F.ws + O_BB);
    float* SA = (float*)(F.ws + O_SUMA); float* SB = (float*)(F.ws + O_SUMB);
    for (int gid = F.blk * 512 + F.tid; gid < 2 * 32 * D; gid += F.G * 512) {
        const int ch = gid & 2047, chunk = (gid >> 11) & 31, b = gid >> 16; const size_t base = (size_t)(b * SEQ + chunk * 128) * D + ch;
        float hh = 0.f, ls = 0.f;
#pragma unroll 16
        for (int i = 0; i < 128; ++i) { const float la = bf2f(LA[base + (size_t)i * D]), bb = bf2f(BB[base + (size_t)i * D]); hh = __expf(la) * hh + bb; ls += la; }
        SA[gid] = __expf(ls); SB[gid] = hh;
    }
}
__device__ __forceinline__ void phase_lru_scan2(const Frame& F) {
    const bf16* LA = (const bf16*)(F.ws + O_AA); const bf16* BB = (const bf16*)(F.ws + O_BB);
    const float* SA = (const float*)(F.ws + O_SUMA); const float* SB = (const float*)(F.ws + O_SUMB);
    const bf16* Y = (const bf16*)(F.ws + O_Y); bf16* YH = (bf16*)(F.ws + O_YH);
    for (int gid = F.blk * 512 + F.tid; gid < 2 * 32 * D; gid += F.G * 512) {
        const int ch = gid & 2047, chunk = (gid >> 11) & 31, b = gid >> 16; const size_t base = (size_t)(b * SEQ + chunk * 128) * D + ch;
        float hh = 0.f;
        for (int c0 = 0; c0 < chunk; c0 += 16) {
            float sa[16], sb[16];
#pragma unroll
            for (int j = 0; j < 16; ++j) { const bool ok = c0 + j < chunk; const int g2 = (b * 32 + (ok ? c0 + j : 0)) * D + ch; const float xa = SA[g2], xb = SB[g2]; sa[j] = ok ? xa : 1.0f; sb[j] = ok ? xb : 0.0f; }
#pragma unroll
            for (int j = 0; j < 16; ++j) hh = sa[j] * hh + sb[j];
        }
#pragma unroll 16
        for (int i = 0; i < 128; ++i) { const float a = __expf(bf2f(LA[base + (size_t)i * D])), bb = bf2f(BB[base + (size_t)i * D]); hh = a * hh + bb;
            YH[base + (size_t)i * D] = (bf16)f2bf(bf2f(Y[base + (size_t)i * D]) * hh); }
    }
}

__device__ __forceinline__ void phase_route1(const Frame& F) {
    const int gw = F.blk * 8 + F.wave, ngw = F.G * 8, lane = F.lane;
    LAS float* rwt = (LAS float*)F.lds;
    LAS unsigned* cntL = (LAS unsigned*)(F.lds + 8 * 2052 * 4);
    const float* RW = F.in[I_ROUTER];
    const float* X3 = (const float*)(F.ws + O_X3); const float* nw = F.in[I_NORMW] + 3 * D;
    bf16* XN = (bf16*)(F.ws + O_XN); unsigned* TOKE = (unsigned*)(F.ws + O_TOKE); float* TOKG = (float*)(F.ws + O_TOKG);
#if X3_BF16
    v2u raw[4][8];
#pragma unroll
    for (int q = 0; q < 4; ++q) { const int m = gw + q * ngw;
#pragma unroll
        for (int j = 0; j < 8; ++j) { raw[q][j] = (v2u){0u, 0u}; if (m < T) raw[q][j] = ((const v2u*)((const unsigned char*)X3 + (size_t)m * D * 2))[lane + 64 * j]; } }
#endif
    for (int idx = F.tid; idx < D * 8; idx += 512) { const int e = idx & 7, i = idx >> 3; rwt[e * 2052 + i] = RW[idx]; }
    if (F.tid < 8) cntL[F.tid] = 0u;
    __syncthreads();
    auto route_row = [&](int m, const f32x4 (&v)[8]) {
        if (MOE_F8) {
#pragma unroll
            for (int j = 0; j < 8; ++j) ((unsigned*)((unsigned char*)XN + (size_t)m * D))[lane + 64 * j] = pk4_fp8(v[j].x, v[j].y, v[j].z, v[j].w);
        } else row_store_bf16(XN + (size_t)m * D, lane, v);
        float pa[8];
#pragma unroll
        for (int e = 0; e < 8; ++e) pa[e] = 0.f;
#pragma unroll
        for (int j = 0; j < 8; ++j) {
#pragma unroll
            for (int e = 0; e < 8; ++e) { const f32x4 w = *(const LAS f32x4*)(rwt + e * 2052 + 4 * lane + 256 * j); pa[e] += (v[j].x * w.x + v[j].y * w.y) + (v[j].z * w.z + v[j].w * w.w); }
            asm volatile("" ::: "memory"); }
        const float mine = red_multi8(pa, lane);
        float v0 = -3.0e38f, v1 = -3.0e38f; int i0 = 0, i1 = 0;
#pragma unroll
        for (int e = 0; e < 8; ++e) { const float a = __shfl(mine, ((e >> 2) & 1) * 32 + ((e >> 1) & 1) * 16 + (e & 1) * 8);
            if (a > v0) { v1 = v0; i1 = i0; v0 = a; i0 = e; } else if (a > v1) { v1 = a; i1 = e; } }
        if (lane == 0) { const float g0 = 1.0f / (1.0f + __expf(v1 - v0)); TOKE[m] = (unsigned)i0 | ((unsigned)i1 << 8); TOKG[2 * m] = g0; TOKG[2 * m + 1] = 1.0f - g0;
            lds_add(cntL + i0, 1u); lds_add(cntL + i1, 1u); }
    };
#if X3_BF16
#pragma unroll
    for (int q = 0; q < 4; ++q) { const int m = gw + q * ngw;
        if (m < T) { f32x4 v[8]; float s = 0.f;
#pragma unroll
            for (int j = 0; j < 8; ++j) { const v2u w = raw[q][j]; v[j] = (f32x4){bflo(w.x), bfhi(w.x), bflo(w.y), bfhi(w.y)}; s += (v[j].x * v[j].x + v[j].y * v[j].y) + (v[j].z * v[j].z + v[j].w * v[j].w); }
            const float rstd = rsqrtf(wave_sum(s) * (1.0f / D) + EPS);
#pragma unroll
            for (int j = 0; j < 8; ++j) { const f32x4 w = ((const f32x4*)nw)[lane + 64 * j]; v[j] = v[j] * rstd * w; }
            route_row(m, v); } }
    for (int m = gw + 4 * ngw; m < T; m += ngw) {
#else
    for (int m = gw; m < T; m += ngw) {
#endif
        f32x4 v[8]; rms_load<(X3_BF16 != 0)>((const unsigned char*)X3 + (size_t)m * D * (X3_BF16 ? 2 : 4), nw, lane, v);
        route_row(m, v);
    }
    __syncthreads();
    if (F.tid < 8) ((unsigned*)(F.ws + O_WCNT))[F.blk * 8 + F.tid] = cntL[F.tid];
}
__device__ __forceinline__ unsigned moe_unit_entry(int L, int nwg, int nN, const LAS unsigned* eoff) {
    int wgid = L; { const int q = nwg / 8, r = nwg % 8, xcd = wgid % 8, off = wgid / 8; wgid = (xcd < r ? xcd * (q + 1) : r * (q + 1) + (xcd - r) * q) + off; }
    int e = 0;
    for (int k = 1; k < 8; ++k) if (wgid >= (int)(eoff[k] >> 8) * nN) e = k;
    const int r0 = (int)(eoff[e] >> 8), re = (int)(eoff[e + 1] >> 8) - r0, l = wgid - r0 * nN;
    return (unsigned)(r0 + l % re) | ((unsigned)(l / re) << 8) | ((unsigned)e << 16);
}
__device__ __forceinline__ void phase_route2(const Frame& F) {
    LAS unsigned* tot = (LAS unsigned*)F.lds; LAS unsigned* pre = tot + 8; LAS unsigned* eoff = tot + 16; LAS unsigned* basep = tot + 32; LAS unsigned* lpos = tot + 64; LAS unsigned* ltok = tot + 128;
    const unsigned* WCNT = (const unsigned*)(F.ws + O_WCNT); const unsigned* TOKE = (const unsigned*)(F.ws + O_TOKE);
    if (F.tid < 16) tot[F.tid] = 0u;
    if (F.tid < 32) ltok[F.tid] = TOKE[F.blk * 8 + (F.tid & 7) + 2048 * (F.tid >> 3)];
    __syncthreads();
    for (int idx = F.tid; idx < F.G * 8; idx += 512) { const int w = idx >> 3, e = idx & 7; const unsigned v = WCNT[idx]; lds_add(tot + e, v); if (w < F.blk) lds_add(pre + e, v); }
    __syncthreads();
    if (F.tid == 0) {
        unsigned off = 0;
        for (int e = 0; e < 8; ++e) { eoff[e] = off; basep[e] = off + pre[e]; off += (tot[e] + 255u) & ~255u; }
        eoff[8] = off;
        for (int i = 0; i < 32; ++i) { const unsigned te = ltok[i]; const unsigned e0 = te & 255u, e1 = te >> 8;
            lpos[2 * i] = basep[e0]; basep[e0] += 1; lpos[2 * i + 1] = basep[e1]; basep[e1] += 1; }
    }
    __syncthreads();
    if (F.blk == 0 && F.tid < 9) ((unsigned*)(F.ws + O_EOFF))[F.tid] = eoff[F.tid];
    if (F.blk == 1) { const int nwg = (int)(eoff[8] >> 8) * (2 * FE / 256); unsigned* tab = (unsigned*)(F.ws + O_UTAB); for (int L = F.tid; L < nwg; L += 512) tab[L] = moe_unit_entry(L, nwg, 2 * FE / 256, eoff); }
    if (F.tid < 32) { const int m = F.blk * 8 + (F.tid & 7) + 2048 * (F.tid >> 3); ((unsigned*)(F.ws + O_POS))[2 * m] = lpos[2 * F.tid]; ((unsigned*)(F.ws + O_POS))[2 * m + 1] = lpos[2 * F.tid + 1]; }
    const bf16* XN = (const bf16*)(F.ws + O_XN); bf16* HS = (bf16*)(F.ws + O_HS);
    if (MOE_F8) {
        v4u a0[4], a1[4];
#pragma unroll
        for (int k = 0; k < 4; ++k) { const int m = F.blk * 8 + F.wave + 2048 * k; const v4u* s8 = (const v4u*)((const unsigned char*)XN + (size_t)m * D); a0[k] = s8[2 * F.lane]; a1[k] = s8[2 * F.lane + 1]; }
#pragma unroll
        for (int k = 0; k < 4; ++k) { const int li = k * 8 + F.wave;
#pragma unroll
            for (int sl = 0; sl < 2; ++sl) { v4u* dst = (v4u*)((unsigned char*)HS + (size_t)lpos[2 * li + sl] * D); dst[2 * F.lane] = a0[k]; dst[2 * F.lane + 1] = a1[k]; } }
    } else
    for (int k = 0; k < 4; ++k) { const int li = k * 8 + F.wave, m = F.blk * 8 + F.wave + 2048 * k; const v4u* src = (const v4u*)(XN + (size_t)m * D);
        {
        v4u a[4];
#pragma unroll
        for (int j = 0; j < 4; ++j) a[j] = src[F.lane + 64 * j];
#pragma unroll
        for (int sl = 0; sl < 2; ++sl) { v4u* dst = (v4u*)(HS + (size_t)lpos[2 * li + sl] * D);
#pragma unroll
            for (int j = 0; j < 4; ++j) dst[F.lane + 64 * j] = a[j]; } } }
    if (F.blk < 8) {
        const unsigned r0 = eoff[F.blk] + tot[F.blk], r1 = eoff[F.blk + 1]; const unsigned per = MOE_F8 ? 128u : 256u;
        for (unsigned idx = r0 * per + F.tid; idx < r1 * per; idx += 512) ((v4u*)HS)[idx] = (v4u){0u, 0u, 0u, 0u};
    }
    __syncthreads();
}
struct SchedMoe {
    int G, c, nwg; long aT, bT, bE; const LAS unsigned* tab;
    __device__ __forceinline__ bool next(int i, pg8::Unit& u) const {
        const int L = i * G + c; if (L >= nwg) return false;
        const unsigned w = (unsigned)__builtin_amdgcn_readfirstlane((int)tab[i]);
        u.pm = (int)(w & 255u); u.pn = (int)((w >> 8) & 255u); const int e = (int)(w >> 16);
        u.aoff = (unsigned)(u.pm * aT); u.boff = (unsigned)(e * bE + u.pn * bT); u.z = 0; return true;
    }
};
struct SchedMoeDown {
    int G, c, u0, nu, S; unsigned aT, bT, bE, kpart; unsigned eo[9];
    __device__ __forceinline__ bool next(int i, pg8::Unit& u) const {
        int L = i * G + c; if (L >= nu * S) return false;
        if (S == 1 && G == 256) { const int x = c & 7, j = c >> 3; L = (32 * i + 4 * x + (j >> 3)) * 8 + (j & 7); }
        const int uu = u0 + L / S, part = L % S; u.pm = uu >> 3; u.pn = uu & 7; u.z = part;
        int e = 0;
#pragma unroll
        for (int k = 1; k < 8; ++k) e += ((unsigned)(u.pm * 256) >= eo[k]) ? 1 : 0;
        u.aoff = (unsigned)u.pm * aT + (unsigned)part * kpart; u.boff = (unsigned)e * bE + (unsigned)u.pn * bT + (unsigned)part * kpart; return true;
    }
};
__device__ __forceinline__ void moe_down_split(int nrt, int G, int& full, int& rem, int& S) {
    const int U = nrt * 8; full = (U / G) * G; rem = U - full; S = 1; if (rem > 0) { if (rem * 4 <= G) S = 4; else if (rem * 2 <= G) S = 2; }
}
struct SchedGates {
    int G, c;
    __device__ __forceinline__ bool next(int i, pg8::Unit& u) const {
        if (!pg8::std_order(i, G, c, 32, 16, u.pm, u.pn)) return false;
        u.aoff = (unsigned)(((long)u.pm * 256 * D + (u.pn >> 1) * 256) * 2); u.boff = (unsigned)(u.pn * 256 * 256 * 2); u.z = 0; return true;
    }
};
__device__ __forceinline__ f32x4 ldbf4(const bf16* row, int i4) { const v2u w = ((const v2u*)row)[i4]; return (f32x4){bflo(w.x), bfhi(w.x), bflo(w.y), bfhi(w.y)}; }
__device__ __forceinline__ void phase_combine(const Frame& F) {
    const int gw = F.blk * 8 + F.wave, ngw = F.G * 8, lane = F.lane;
    const float* X3 = (const float*)(F.ws + O_X3); const bf16* YM = (const bf16*)(F.ws + O_YM);
    const unsigned* POS = (const unsigned*)(F.ws + O_POS); const float* TOKG = (const float*)(F.ws + O_TOKG); const float* fnw = F.in[I_FNW];
    int full, rem, SP; moe_down_split((int)(__builtin_amdgcn_readfirstlane(((const unsigned*)(F.ws + O_EOFF))[8]) >> 8), F.G, full, rem, SP);
    const unsigned rt_split = (unsigned)(full >> 3); const size_t pstride = (size_t)MOE_ROWS * D;
    for (int m = gw; m < T; m += ngw) {
        const unsigned p0 = POS[2 * m], p1 = POS[2 * m + 1]; const float g0 = TOKG[2 * m], g1 = TOKG[2 * m + 1];
        const int n0 = ((p0 >> 8) >= rt_split) ? SP : 1, n1 = ((p1 >> 8) >= rt_split) ? SP : 1;
        f32x4 v[8]; float s = 0.f;
        if (n0 == 1 && n1 == 1) {
            f32x4 xr[8], y0r[8], y1r[8];
#pragma unroll
            for (int j = 0; j < 8; ++j) { xr[j] = X3_BF16 ? ldbf4((const bf16*)X3 + (size_t)m * D, lane + 64 * j) : ((const f32x4*)(X3 + (size_t)m * D))[lane + 64 * j]; y0r[j] = ldbf4(YM + (size_t)p0 * D, lane + 64 * j); y1r[j] = ldbf4(YM + (size_t)p1 * D, lane + 64 * j); }
#pragma unroll
            for (int j = 0; j < 8; ++j) { v[j] = xr[j] + g0 * y0r[j] + g1 * y1r[j]; s += (v[j].x * v[j].x + v[j].y * v[j].y) + (v[j].z * v[j].z + v[j].w * v[j].w); }
        } else {
#pragma unroll
        for (int j = 0; j < 8; ++j) { const f32x4 x = X3_BF16 ? ldbf4((const bf16*)X3 + (size_t)m * D, lane + 64 * j) : ((const f32x4*)(X3 + (size_t)m * D))[lane + 64 * j]; f32x4 y0 = ldbf4(YM + (size_t)p0 * D, lane + 64 * j), y1 = ldbf4(YM + (size_t)p1 * D, lane + 64 * j);
            for (int p = 1; p < n0; ++p) y0 += ldbf4(YM + p * pstride + (size_t)p0 * D, lane + 64 * j);
            for (int p = 1; p < n1; ++p) y1 += ldbf4(YM + p * pstride + (size_t)p1 * D, lane + 64 * j);
            v[j] = x + g0 * y0 + g1 * y1; s += (v[j].x * v[j].x + v[j].y * v[j].y) + (v[j].z * v[j].z + v[j].w * v[j].w); } }
        const float rstd = rsqrtf(wave_sum(s) * (1.0f / D) + EPS);
#pragma unroll
        for (int j = 0; j < 8; ++j) { const f32x4 w = ((const f32x4*)fnw)[lane + 64 * j]; ((f32x4*)(F.out + (size_t)m * D))[lane + 64 * j] = v[j] * rstd * w; }
    }
}

constexpr int NPHASES = 20;
struct Args { const float* in[25]; float* out; unsigned char* ws; int ph_lo, ph_hi; };
__global__ void __launch_bounds__(512, 2) mk_fwd(Args args) {
    extern __shared__ __attribute__((aligned(16))) unsigned char lds_raw[];
    Frame F;
    F.lds = (LAS unsigned char*)lds_raw;
    F.tid = threadIdx.x; F.lane = F.tid & 63; F.wave = __builtin_amdgcn_readfirstlane(F.tid >> 6); F.G = gridDim.x; F.blk = blockIdx.x;
    F.ws = args.ws; F.out = args.out;
#pragma unroll
    for (int i = 0; i < 25; ++i) F.in[i] = args.in[i];
    volatile LAS unsigned* MISC = (volatile LAS unsigned*)(F.lds + MISC_OFF);
    if (F.tid < 64) MISC[F.tid] = 0u;
    __syncthreads();
    const int lo = args.ph_lo, hi = args.ph_hi;
    XcdBarrier bar; bar.bar = (unsigned*)(F.ws + O_CTL) + CW_BAR; bar.x = 0; bar.st = nullptr;
    if (hi - lo > 1) bar = xcd_barrier_post((unsigned*)(F.ws + O_CTL) + CW_BAR, MISC + 8);
#ifdef ONLY_PHASE
#define IN(k) ((k) == ONLY_PHASE && lo <= (k) && (k) < hi)
#else
#define IN(k) (lo <= (k) && (k) < hi)
#endif
#define SEAM(k) do { if (IN(k) && IN((k) + 1)) xcd_barrier(bar); } while (0)
#ifndef REP_PHASE
#define REP_PHASE -1
#endif
#ifndef REP_COUNT
#define REP_COUNT 2
#endif
#ifndef TIME_MASK
#define TIME_MASK 0u
#endif
    unsigned long long tacc = 0ull, tst = 0ull;
#define PH_BEGIN(k) if ((TIME_MASK >> (k)) & 1u) tst = __builtin_amdgcn_s_memrealtime(); F.tid = fresh_tid((int)threadIdx.x); F.lane = F.tid & 63; if (IN(k)) {     for (int rep_ = 0; rep_ < ((k) == REP_PHASE ? REP_COUNT : 1); ++rep_) { if (rep_) { xcd_barrier(bar); if (F.blk == 0 && F.tid == 0) __hip_atomic_store((unsigned*)(F.ws + O_CTL) + CW_Q, 0u, __ATOMIC_RELAXED, __HIP_MEMORY_SCOPE_AGENT); xcd_barrier(bar); }
#define PH_END(k) } } SEAM(k); if ((TIME_MASK >> (k)) & 1u) tacc += __builtin_amdgcn_s_memrealtime() - tst;
    unsigned char* ws = F.ws;
    bf16* XN = (bf16*)(ws + O_XN);

    PH_BEGIN(0) { phase_prologue(F); } PH_END(0)
    PH_BEGIN(1) {
        pg8::Gemm g{XN, (const bf16*)(ws + O_WMI), D, D, D}; pg8::SchedStd S{T / 256, NPROJ / 256, F.G, F.blk, (long)256 * D * 2, (long)256 * D * 2};
        pg8::EpiBf16 E{(bf16*)(ws + O_PROJ), NPROJ};
        pg8::gemm_phase(F.lds, g, S, E);
    } PH_END(1)
    PH_BEGIN(2) { if (!(FAST_GDN && FAST_HGRN)) phase_mix_pre(F); if (FAST_GDN || FAST_HGRN) phase_mix_prep(F, rep_ ? PREP_ONLY : 0); } PH_END(2)
    PH_BEGIN(3) { if (!(FAST_GDN && FAST_HGRN)) phase_mix_scan_slow(F); { TS_BEGIN(2) if (FAST_GDN || FAST_HGRN) phase_mix_scan(F); TS_END(2) } convert_tiles<2, NJOBS>(F, (unsigned*)(ws + O_CTL) + CW_Q); } PH_END(3)
    PH_BEGIN(4) {
        pg8::Gemm g{(const bf16*)(ws + O_O), (const bf16*)(ws + O_WMO), D, D, D}; pg8::SchedStd S{T / 256, D / 256, F.G, F.blk, (long)256 * D * 2, (long)256 * D * 2};
        pg8::EpiRes<false, true, true, FFNG_F8 != 0> E{F.in[I_X], ws + O_X1, (float*)(ws + O_PART1), (LAS float*)(F.lds + 131072), ws + O_X1F8};
        pg8::gemm_phase(F.lds, g, S, E);
    } PH_END(4)
    PH_BEGIN(6) {
        const int GG = F.G == 256 ? FFN_GEMM_WG : F.G;
        if (F.blk >= GG) { convert_tiles<13, 14>(F, (unsigned*)(ws + O_CTL) + CW_Q2); }
        else {
        constexpr int EBG = FFNG_F8 ? 1 : 2;
        pg8::Gemm g{(const bf16*)(ws + (FFNG_F8 ? O_X1F8 : O_X1)), (const bf16*)(ws + O_WFG), D * EBG / 2, D * EBG / 2, D * EBG / 2}; pg8::SchedStd S{T / 256, 2 * FF / 256, GG, F.blk, (long)256 * D * EBG, (long)256 * D * EBG};
        if constexpr (FFND_F8) { typedef pg8::EpiSwigluF8R<(FFNG_F8 != 0)> EpiT; EpiT E{(unsigned char*)(ws + O_ACT), FF, (const float*)(ws + O_PART1)}; pg8::gemm_phase<EpiT, pg8::SchedStd, FFNG_F8 != 0, 121, 127>(F.lds, g, S, E); }
        else { pg8::EpiSwiglu E{(bf16*)(ws + O_ACT), FF, (const float*)(ws + O_PART1)}; pg8::gemm_phase<pg8::EpiSwiglu, pg8::SchedStd, FFNG_F8 != 0, 121, 127>(F.lds, g, S, E); } }
    } PH_END(6)
    PH_BEGIN(7) {
        pg8::EpiRes<true, true, true> E{ws + O_X1, ws + O_X2, (float*)(ws + O_PART2), (LAS float*)(F.lds + 131072)};
        if constexpr (FFND_F8) { pg8::Gemm g{(const bf16*)(ws + O_ACT), (const bf16*)(ws + O_WFD), FF / 2, FF / 2, FF / 2}; pg8::SchedStd S{T / 256, D / 256, F.G, F.blk, (long)256 * FF, (long)256 * FF};
            pg8::gemm_phase<pg8::EpiRes<true, true, true>, pg8::SchedStd, true, 120, 124>(F.lds, g, S, E); }
        else { pg8::Gemm g{(const bf16*)(ws + O_ACT), (const bf16*)(ws + O_WFD), FF, FF, FF}; pg8::SchedStd S{T / 256, D / 256, F.G, F.blk, (long)256 * FF * 2, (long)256 * FF * 2};
            pg8::gemm_phase(F.lds, g, S, E); }
    } PH_END(7)
    PH_BEGIN(9) {
        pg8::Gemm g{(const bf16*)(ws + O_X2), (const bf16*)(ws + O_WRI), D, D, D}; pg8::SchedStd S{T / 256, 2 * D / 256, F.G, F.blk, (long)256 * D * 2, (long)256 * D * 2};
        pg8::EpiRgIn E{(bf16*)(ws + O_Y), (bf16*)(ws + O_XBR), (const float*)(ws + O_PART2)};
        pg8::gemm_phase(F.lds, g, S, E);
    } PH_END(9)
    PH_BEGIN(10) { phase_lru_conv(F); } PH_END(10)
    PH_BEGIN(11) {
        pg8::Gemm g{(const bf16*)(ws + O_XC), (const bf16*)(ws + O_WRG), D, 256, 256}; SchedGates S{F.G, F.blk};
        pg8::EpiGates E{(const bf16*)(ws + O_XC), F.in[I_RGAB], F.in[I_RGXB], (const float*)(ws + O_SPL), (bf16*)(ws + O_AA), (bf16*)(ws + O_BB)};
        pg8::gemm_phase(F.lds, g, S, E);
    } PH_END(11)
    PH_BEGIN(12) { phase_lru_scan1(F); } PH_END(12)
    PH_BEGIN(13) { phase_lru_scan2(F); } PH_END(13)
    PH_BEGIN(14) {
        pg8::Gemm g{(const bf16*)(ws + O_YH), (const bf16*)(ws + O_WRO), D, D, D}; pg8::SchedStd S{T / 256, D / 256, F.G, F.blk, (long)256 * D * 2, (long)256 * D * 2};
        pg8::EpiRes<true, (X3_BF16 != 0), false> E{ws + O_X2, ws + O_X3, nullptr, (LAS float*)(F.lds + 131072)};
        pg8::gemm_phase(F.lds, g, S, E);
    } PH_END(14)
    PH_BEGIN(15) { phase_route1(F); } PH_END(15)
    PH_BEGIN(16) { phase_route2(F); } PH_END(16)
    PH_BEGIN(17) {
        constexpr int EB = MOE_F8 ? 1 : 2;
        SchedMoe S; S.G = F.G; S.c = F.blk; S.aT = (long)256 * D * EB; S.bT = (long)256 * D * EB; S.bE = (long)2 * FE * D * EB;
        S.nwg = (int)((unsigned)__builtin_amdgcn_readfirstlane(((const unsigned*)(ws + O_EOFF))[8]) >> 8) * (2 * FE / 256);
        { LAS unsigned* lt = (LAS unsigned*)(F.lds + MISC_OFF + 128); if (F.tid < 32) { const long L = (long)F.tid * F.G + F.blk; lt[F.tid] = L < S.nwg ? ((const unsigned*)(ws + O_UTAB))[L] : 0u; } __syncthreads(); S.tab = lt; }
        if constexpr (MOE_F8) { pg8::Gemm g{(const bf16*)(ws + O_HS), (const bf16*)(ws + O_WMG), D / 2, D / 2, D / 2};
            pg8::EpiSwigluF8 E{(unsigned char*)(ws + O_ACTM), FE, 8.0f};
            pg8::gemm_phase<pg8::EpiSwigluF8, SchedMoe, true, 121, 127>(F.lds, g, S, E); }
        else { pg8::Gemm g{(const bf16*)(ws + O_HS), (const bf16*)(ws + O_WMG), D, D, D};
            pg8::EpiSwiglu E{(bf16*)(ws + O_ACTM), FE, nullptr};
            pg8::gemm_phase(F.lds, g, S, E); }
    } PH_END(17)
    PH_BEGIN(18) {
        constexpr int EB = MOE_F8 ? 1 : 2;
        SchedMoeDown S; S.G = F.G; S.c = F.blk; S.aT = 256u * FE * EB; S.bT = 256u * FE * EB; S.bE = (unsigned)D * FE * EB;
        const unsigned* eo = (const unsigned*)(ws + O_EOFF);
#pragma unroll
        for (int k = 0; k < 9; ++k) S.eo[k] = __builtin_amdgcn_readfirstlane(eo[k]);
        int full, rem, SP; moe_down_split((int)(S.eo[8] >> 8), F.G, full, rem, SP);
        pg8::EpiPartBf16 E{(bf16*)(ws + O_YM), D, (size_t)MOE_ROWS * D};
        S.u0 = 0; S.nu = full; S.S = 1; S.kpart = 0;
        if constexpr (MOE_F8) { pg8::Gemm g{(const bf16*)(ws + O_ACTM), (const bf16*)(ws + O_WMD), FE / 2, FE / 2, FE / 2};
            pg8::gemm_phase<pg8::EpiPartBf16, SchedMoeDown, true, 120, 124>(F.lds, g, S, E); }
        else { pg8::Gemm g{(const bf16*)(ws + O_ACTM), (const bf16*)(ws + O_WMD), FE, FE, FE};
            pg8::gemm_phase(F.lds, g, S, E); }
        S.u0 = full; S.nu = rem; S.S = SP; S.kpart = (unsigned)(FE * EB) / (unsigned)SP;
        if constexpr (MOE_F8) { pg8::Gemm g{(const bf16*)(ws + O_ACTM), (const bf16*)(ws + O_WMD), FE / 2, FE / 2, FE / 2 / SP};
            pg8::gemm_phase<pg8::EpiPartBf16, SchedMoeDown, true, 120, 124>(F.lds, g, S, E); }
        else { pg8::Gemm g{(const bf16*)(ws + O_ACTM), (const bf16*)(ws + O_WMD), FE, FE, FE / SP};
            pg8::gemm_phase(F.lds, g, S, E); }
    } PH_END(18)
    PH_BEGIN(19) { phase_combine(F); } } } if ((TIME_MASK >> 19) & 1u) tacc += __builtin_amdgcn_s_memrealtime() - tst;
    if (TIME_SEC != 0 && F.blk == 0 && F.tid == 0) tacc += *(volatile LAS unsigned long long*)(F.lds + TS_LDS_OFF);
    if ((TIME_MASK != 0u || TIME_SEC != 0) && F.blk == 0 && F.tid == 0) { const unsigned long long t0 = __builtin_amdgcn_s_memrealtime(); while (__builtin_amdgcn_s_memrealtime() - t0 < 8ull * tacc) __builtin_amdgcn_s_sleep(8); }
#undef IN
#undef SEAM
}

extern "C" void kernel_launch(void* const* d_in, const int* in_sizes, int n_in, void* d_out, int out_size, void* d_ws, size_t ws_size, hipStream_t stream) {
    static int grid = 0;
    if (grid == 0) {
        if (n_in != 25 || out_size != T * D || ws_size < WS_END) { fprintf(stderr, "kernel_launch: unexpected shapes (n_in %d out %d ws %zu need %zu)\n", n_in, out_size, ws_size, (size_t)WS_END); grid = -1; return; }
        int dev = 0, cus = 0, per_cu = 0;
        if (hipGetDevice(&dev) != hipSuccess || hipDeviceGetAttribute(&cus, hipDeviceAttributeMultiprocessorCount, dev) != hipSuccess) { grid = -1; return; }
        if (hipFuncSetAttribute((const void*)mk_fwd, hipFuncAttributeMaxDynamicSharedMemorySize, LDS_BYTES) != hipSuccess) { fprintf(stderr, "kernel_launch: hipFuncSetAttribute failed\n"); grid = -1; return; }
        if (hipOccupancyMaxActiveBlocksPerMultiprocessor(&per_cu, (const void*)mk_fwd, 512, LDS_BYTES) != hipSuccess || per_cu < 1) fprintf(stderr, "kernel_launch: occupancy query reports %d\n", per_cu);
        (void)hipGetLastError();
        grid = cus > 256 ? 256 : cus;
    }
    if (grid < 0) return;
    (void)hipMemsetAsync((char*)d_ws + O_CTL, 0, 32768, stream);
    Args a{};
    for (int i = 0; i < 25; ++i) a.in[i] = (const float*)d_in[i];
    a.out = (float*)d_out; a.ws = (unsigned char*)d_ws;
#if MK_SPLIT
    for (int p = 0; p < NPHASES; ++p) { a.ph_lo = p; a.ph_hi = p + 1; hipLaunchKernelGGL(mk_fwd, dim3(grid), dim3(512), LDS_BYTES, stream, a); }
#else
    a.ph_lo = 0; a.ph_hi = NPHASES; hipLaunchKernelGGL(mk_fwd, dim3(grid), dim3(512), LDS_BYTES, stream, a);
#endif
}
```

```cpp
#include <hip/hip_runtime.h>
#include <cstdio>
#include <cstdint>

#ifndef MK_SPLIT
#define MK_SPLIT 0
#endif

#ifndef MOE_F8
#define MOE_F8 1
#endif
#define PREP_ONLY 0
#define TIME_MASK 0u
#define TIME_SEC 0
#ifndef FFND_F8
#define FFND_F8 1
#endif
#ifndef X3_BF16
#define X3_BF16 1
#endif
#ifndef FFNG_F8
#define FFNG_F8 1
#endif
#define REP_PHASE -1
#define REP_COUNT 2
#ifndef FAST_GDN
#define FAST_GDN 1
#endif
#ifndef FAST_HGRN
#define FAST_HGRN 1
#endif
#define GAS __attribute__((address_space(1)))
#define LAS __attribute__((address_space(3)))
typedef unsigned short bf16;
typedef unsigned v4u __attribute__((ext_vector_type(4)));
typedef unsigned v2u __attribute__((ext_vector_type(2)));
typedef float f32x4 __attribute__((ext_vector_type(4)));
typedef float f32x2 __attribute__((ext_vector_type(2)));
typedef short bf16x8 __attribute__((ext_vector_type(8)));
#define RLX_AGENT __ATOMIC_RELAXED, __HIP_MEMORY_SCOPE_AGENT
#define LDS_WAIT() asm volatile("s_waitcnt lgkmcnt(0)" ::: "memory")
#define VM_WAIT() asm volatile("s_waitcnt vmcnt(0)" ::: "memory")
#define SBAR() do { asm volatile("s_waitcnt lgkmcnt(0)" ::: "memory"); __builtin_amdgcn_s_barrier(); asm volatile("" ::: "memory"); } while (0)

#define TS_LDS_OFF (155648 - 256 + 64)
#define TS_BEGIN(id) unsigned long long ts_##id = 0ull; if (TIME_SEC == (id) && blockIdx.x == 0 && threadIdx.x == 0) ts_##id = __builtin_amdgcn_s_memrealtime();
#define TS_END(id) if (TIME_SEC == (id) && blockIdx.x == 0 && threadIdx.x == 0) { extern __shared__ __attribute__((aligned(16))) unsigned char lds_raw[]; *(volatile LAS unsigned long long*)((LAS unsigned char*)lds_raw + TS_LDS_OFF) += __builtin_amdgcn_s_memrealtime() - ts_##id; }
typedef __bf16 hwbf16x2 __attribute__((ext_vector_type(2)));
__device__ __forceinline__ unsigned pk2(float lo, float hi) { const f32x2 v = {lo, hi}; return __builtin_bit_cast(unsigned, __builtin_convertvector(v, hwbf16x2)); }
__device__ __forceinline__ unsigned f2bf(float f) { return pk2(f, 0.f) & 0xffffu; }
__device__ __forceinline__ int fresh_tid(int t) { asm volatile("" : "+v"(t)); return t; }
__device__ __forceinline__ float bf2f(unsigned short b) { return __builtin_bit_cast(float, ((unsigned)b) << 16); }
__device__ __forceinline__ float bflo(unsigned w) { return __builtin_bit_cast(float, w << 16); }
__device__ __forceinline__ float bfhi(unsigned w) { return __builtin_bit_cast(float, w & 0xffff0000u); }
__device__ __forceinline__ float clamp448(float x) { return __builtin_amdgcn_fmed3f(x, -448.f, 448.f); }
__device__ __forceinline__ unsigned pk4_fp8(float a, float b, float c, float d) {
    unsigned w = 0; w = __builtin_amdgcn_cvt_pk_fp8_f32(clamp448(a), clamp448(b), w, false); w = __builtin_amdgcn_cvt_pk_fp8_f32(clamp448(c), clamp448(d), w, true); return w; }
__device__ __forceinline__ float sigmoidf_(float x) { return __builtin_amdgcn_rcpf(1.0f + __expf(-x)); }
__device__ __forceinline__ float siluf_(float x) { return x * __builtin_amdgcn_rcpf(1.0f + __expf(-x)); }
__device__ __forceinline__ float softplusf_(float x) { return x > 20.f ? x : log1pf(__expf(x)); }
__device__ __forceinline__ void lds_add(LAS unsigned* p, unsigned v) { (void)__hip_atomic_fetch_add(p, v, __ATOMIC_RELAXED, __HIP_MEMORY_SCOPE_WORKGROUP); }
__device__ __forceinline__ float wave_sum(float v) {
#pragma unroll
    for (int o = 1; o < 64; o <<= 1) v += __shfl_xor(v, o);
    return v;
}

constexpr int T = 8192, D = 2048, SEQ = 4096, NPROJ = 8192, FF = 5632, FE = 7168, NE = 8;
constexpr int MIXLD = 8208;
constexpr int PQ_AQ = 0, PQ_AK = 1024, PQ_AV = 2048, PQ_AZ = 3072, PQ_BQ = 4096, PQ_BF = 5120, PQ_BI = 6144, PQ_BG = 7168;
constexpr float EPS = 1e-6f;
constexpr int MOE_ROWS = 16384 + 8 * 256;

constexpr size_t al256(size_t x) { return (x + 255) & ~(size_t)255; }
constexpr size_t O_CTL = 0, CTL_BYTES = 1u << 20;
constexpr size_t O_WMI = CTL_BYTES;
constexpr size_t O_WMO = O_WMI + (size_t)NPROJ * D * 2;
constexpr size_t O_WFG = O_WMO + (size_t)D * D * 2;
constexpr size_t O_WFD = O_WFG + (size_t)2 * FF * D * 2;
constexpr size_t O_WRI = O_WFD + (size_t)D * FF * 2;
constexpr size_t O_WRG = O_WRI + (size_t)2 * D * D * 2;
constexpr size_t O_WRO = O_WRG + (size_t)16 * 256 * 256 * 2;
constexpr size_t O_WMG = O_WRO + (size_t)D * D * 2;
constexpr size_t O_WMD = O_WMG + (size_t)NE * 2 * FE * D * 2;
constexpr size_t O_XN = O_WMD + (size_t)NE * D * FE * 2;
constexpr size_t O_PROJ = O_XN + (size_t)T * D * 2;
constexpr size_t O_GB = O_PROJ + (size_t)T * NPROJ * 2;
constexpr size_t O_O = O_GB + (size_t)T * 16 * 4;
constexpr size_t O_X1 = O_O + (size_t)T * D * 2;
constexpr size_t O_X2 = O_X1 + (size_t)T * D * 4;
constexpr size_t O_X3 = O_X2 + (size_t)T * D * 4;
constexpr size_t O_ACT = O_X3 + (size_t)T * D * 4;
constexpr size_t O_Y = O_ACT + (size_t)T * FF * 2;
constexpr size_t O_XBR = O_Y + (size_t)T * D * 2;
constexpr size_t O_XC = O_XBR + (size_t)T * D * 2;
constexpr size_t O_AA = O_XC + (size_t)T * D * 2;
constexpr size_t O_BB = O_AA + (size_t)T * D * 4;
constexpr size_t O_YH = O_BB + (size_t)T * D * 4;
constexpr size_t O_SUMA = O_YH + (size_t)T * D * 2;
constexpr size_t O_SUMB = O_SUMA + (size_t)2 * 32 * D * 4;
constexpr size_t O_TOKE = O_SUMB + (size_t)2 * 32 * D * 4;
constexpr size_t O_TOKG = O_TOKE + (size_t)T * 4;
constexpr size_t O_POS = O_TOKG + (size_t)T * 8;
constexpr size_t O_WCNT = O_POS + (size_t)T * 8;
constexpr size_t O_EOFF = O_WCNT + 256 * 8 * 4;
constexpr size_t O_SPL = al256(O_EOFF + 64);
constexpr size_t O_UTAB = O_SPL + 2048 * 4;
constexpr size_t O_X1F8 = al256(O_UTAB + 72 * 56 * 4);
constexpr size_t O_PART1 = O_X1F8 + (size_t)T * D;
constexpr size_t O_PART2 = O_PART1 + (size_t)T * 8 * 4;
constexpr size_t O_HS = O_PART2 + (size_t)T * 8 * 4;
constexpr size_t O_ACTM = O_HS + (size_t)MOE_ROWS * D * 2;
constexpr size_t O_YM = O_ACTM + (size_t)MOE_ROWS * FE * 2;
constexpr size_t O_QF = O_YM + (size_t)4 * MOE_ROWS * D * 4;
constexpr size_t O_KF = O_QF + (size_t)T * 1024 * 4;
constexpr size_t O_VF = O_KF + (size_t)T * 1024 * 4;
constexpr size_t O_FH = O_VF + (size_t)T * 1024 * 4;
constexpr size_t O_QH = O_FH + (size_t)T * 1024 * 4;
constexpr size_t REC_BYTES = 58368;
constexpr size_t O_OPS = al256(O_QH + (size_t)T * 1024 * 4);
constexpr size_t O_UT = O_OPS + (size_t)32 * 64 * REC_BYTES;
constexpr size_t WS_END = O_UT + (size_t)32 * 64 * 8192 * 4;

constexpr int CW_BAR = 4096, CW_Q = 64, CW_Q0 = 128, CW_Q2 = 192;

constexpr int LDS_BYTES = 155648;
constexpr int MISC_OFF = 155648 - 256;

namespace pg8 {
constexpr int BM = 256, BK = 64, HALF = 128, HTB = HALF * BK * 2, STAGE_BYTES = 8 * HTB, NXCD = 8, WGM = 8;
__host__ __device__ __forceinline__ int lds_byte(int r, int c) { const int st = (r >> 4) * 2 + (c >> 5), rr = r & 15, cc = c & 31, ob = rr * 64 + cc * 2; return st * 1024 + (ob ^ (((ob >> 9) & 1) << 5)); }
__host__ __device__ __forceinline__ void stage_rc(int b, int& R, int& C) { const int st = b / 1024, sb = b % 1024, swz = sb ^ (((sb >> 9) & 1) << 5); R = (st >> 1) * 16 + swz / 64; C = (st & 1) * 32 + (swz % 64) / 2; }
__host__ __device__ __forceinline__ int perm32(int rho) { const int n = rho >> 4, i = rho & 15; return 8 * (i >> 2) + 4 * n + (i & 3); }

struct Unit { int pm, pn; unsigned aoff, boff; int z; };
struct Gemm { const bf16* A; const bf16* Bt; int lda, ldb, K; };

__device__ __forceinline__ bool std_order(int i, int G, int c, int nM, int nN, int& pm, int& pn) {
    const int nwg = nM * nN; const long L = (long)i * G + c; if (L >= nwg) return false;
    int wgid = (int)L; { const int q = nwg / NXCD, r = nwg % NXCD, xcd = wgid % NXCD, off = wgid / NXCD; wgid = (xcd < r ? xcd * (q + 1) : r * (q + 1) + (xcd - r) * q) + off; }
    const int nig = WGM * nN, gid = wgid / nig, fm = gid * WGM, gsz = (nM - fm) < WGM ? (nM - fm) : WGM;
    pm = fm + ((wgid % nig) % gsz); pn = (wgid % nig) / gsz; return true;
}
struct SchedStd {
    int nM, nN, G, c; long aT, bT;
    __device__ __forceinline__ bool next(int i, Unit& u) const { if (!std_order(i, G, c, nM, nN, u.pm, u.pn)) return false; u.aoff = (unsigned)(u.pm * aT); u.boff = (unsigned)(u.pn * bT); u.z = 0; return true; }
};

typedef int v4i_t __attribute__((ext_vector_type(4)));
typedef int v8i_t __attribute__((ext_vector_type(8)));
__device__ __forceinline__ v8i_t cat8(const bf16x8 lo, const bf16x8 hi) { const v4i_t a = __builtin_bit_cast(v4i_t, lo), b = __builtin_bit_cast(v4i_t, hi); return __builtin_shufflevector(a, b, 0, 1, 2, 3, 4, 5, 6, 7); }
template <class Epi, class Sched, bool F8 = false, int SW = 127, int SX = 127>
__device__ __forceinline__ void gemm_phase(LAS unsigned char* lds, const Gemm g, const Sched& S, const Epi& E) {
    const int tid = fresh_tid((int)threadIdx.x), wid = __builtin_amdgcn_readfirstlane(tid >> 6), lane = tid & 63, wr = wid >> 2, wc = wid & 3, fr = lane & 15, fq = lane >> 4;
    const int K = g.K, nt = K / BK;
    unsigned voffA[2], voffB[2];
#pragma unroll
    for (int i = 0; i < 2; ++i) { int R, C; stage_rc(tid * 16 + i * 8192, R, C); const int Rb = Epi::PERM ? ((R & ~31) + perm32(R & 31)) : R;
        voffA[i] = (unsigned)(R * g.lda + C) * 2u; voffB[i] = (unsigned)(Rb * g.ldb + C) * 2u; }
    const unsigned kstep = (unsigned)(BK * 2);
    const unsigned hstepA = (unsigned)HALF * g.lda * 2, hstepB = (unsigned)HALF * g.ldb * 2;
    const __amdgpu_buffer_rsrc_t A_rs = __builtin_amdgcn_make_buffer_rsrc((void*)g.A, 0, -1, 0x00020000), B_rs = __builtin_amdgcn_make_buffer_rsrc((void*)g.Bt, 0, -1, 0x00020000);
    const unsigned ldsw = (unsigned)wid * 1024u;
    const int aoff = lds_byte(wr * 64 + fr, fq * 8), boff = lds_byte(wc * 32 + fr, fq * 8);
#define PG8_SA(b, h) (((b) * 2 + (h)) * HTB)
#define PG8_SB(b, h) ((4 + (b) * 2 + (h)) * HTB)
#define PG8_STAGE2(bufoff, rs, soff, voff) do { _Pragma("unroll") for (int _i = 0; _i < 2; ++_i) \
        __builtin_amdgcn_raw_ptr_buffer_load_lds(rs, (LAS void*)(lds + (bufoff) + ldsw + _i * 8192), 16, (int)(voff)[_i], (int)(soff), 0, 0); } while (0)
#define PG8_LDA(dst, b, h) do { _Pragma("unroll") for (int m = 0; m < 4; ++m) dst[m] = __builtin_shufflevector(*(const LAS v4i_t*)(lds + PG8_SA(b, h) + aoff + m * 2048), *(const LAS v4i_t*)(lds + PG8_SA(b, h) + aoff + m * 2048 + 1024), 0, 1, 2, 3, 4, 5, 6, 7); } while (0)
#define PG8_LDB(dst, b, h) do { _Pragma("unroll") for (int n = 0; n < 2; ++n) dst[n] = __builtin_shufflevector(*(const LAS v4i_t*)(lds + PG8_SB(b, h) + boff + n * 2048), *(const LAS v4i_t*)(lds + PG8_SB(b, h) + boff + n * 2048 + 1024), 0, 1, 2, 3, 4, 5, 6, 7); } while (0)
#define PG8_LO(v) __builtin_bit_cast(bf16x8, __builtin_shufflevector(v, v, 0, 1, 2, 3))
#define PG8_HI(v) __builtin_bit_cast(bf16x8, __builtin_shufflevector(v, v, 4, 5, 6, 7))
#define PG8_MMA(ai, bj, At, Bt) do { __builtin_amdgcn_s_setprio(1); _Pragma("unroll") for (int m = 0; m < 4; ++m) _Pragma("unroll") for (int n = 0; n < 2; ++n) { \
        if constexpr (F8) acc[ai][bj][m][n] = __builtin_amdgcn_mfma_scale_f32_16x16x128_f8f6f4(Bt[n], At[m], acc[ai][bj][m][n], 0, 0, 0, SW * 0x01010101, 0, SX * 0x01010101); \
        else { acc[ai][bj][m][n] = __builtin_amdgcn_mfma_f32_16x16x32_bf16(PG8_LO(Bt[n]), PG8_LO(At[m]), acc[ai][bj][m][n], 0, 0, 0); \
               acc[ai][bj][m][n] = __builtin_amdgcn_mfma_f32_16x16x32_bf16(PG8_HI(Bt[n]), PG8_HI(At[m]), acc[ai][bj][m][n], 0, 0, 0); } } __builtin_amdgcn_s_setprio(0); } while (0)
#define PG8_WAIT_V(n) asm volatile("s_waitcnt vmcnt(" #n ")" ::: "memory")
#define PG8_WAIT_L(n) asm volatile("s_waitcnt lgkmcnt(" #n ")" ::: "memory")
#define PG8_BAR __builtin_amdgcn_s_barrier()
#define PG8_SCHED __builtin_amdgcn_sched_barrier(0)
    Unit cur, nxt; int ui = 0;
    if (!S.next(0, cur)) return;
    f32x4 acc[2][2][4][2];
#pragma unroll
    for (int a = 0; a < 2; ++a)
#pragma unroll
        for (int b = 0; b < 2; ++b)
#pragma unroll
            for (int m = 0; m < 4; ++m)
#pragma unroll
                for (int n = 0; n < 2; ++n) acc[a][b][m][n] = (f32x4){0.f, 0.f, 0.f, 0.f};
    v8i_t At[4], B0[2], B1[2];
    unsigned A_c = cur.aoff, B_c = cur.boff;
    { const unsigned B_0 = B_c, B_1 = B_c + hstepB, A_0 = A_c, A_1 = A_c + hstepA;
      PG8_STAGE2(PG8_SB(0, 0), B_rs, B_0, voffB); PG8_STAGE2(PG8_SB(0, 1), B_rs, B_1, voffB); PG8_STAGE2(PG8_SA(0, 0), A_rs, A_0, voffA); PG8_STAGE2(PG8_SA(0, 1), A_rs, A_1, voffA); }
    if (wr == 1) PG8_BAR;
    PG8_WAIT_V(2); PG8_BAR;
    PG8_STAGE2(PG8_SB(1, 0), B_rs, B_c + kstep, voffB); PG8_STAGE2(PG8_SA(1, 0), A_rs, A_c + kstep, voffA); PG8_STAGE2(PG8_SB(1, 1), B_rs, B_c + hstepB + kstep, voffB);
    PG8_WAIT_V(6); PG8_BAR;
    for (;;) {
        const bool has_next = S.next(ui + 1, nxt);
        const unsigned A_n = has_next ? nxt.aoff : A_c, B_n = has_next ? nxt.boff : B_c;
#pragma unroll 1
        for (int t = 0; t < nt; t += 2) {
            const bool last = (t == nt - 2);
            const unsigned a1 = A_c + (unsigned)(t + 1) * kstep;
            const unsigned a2 = last ? A_n : A_c + (unsigned)(t + 2) * kstep, b2 = last ? B_n : B_c + (unsigned)(t + 2) * kstep;
            const unsigned a3 = a2 + kstep, b3 = b2 + kstep;
            PG8_LDB(B0, 0, 0); PG8_LDB(B1, 0, 1); PG8_SCHED; PG8_LDA(At, 0, 0); PG8_STAGE2(PG8_SA(1, 1), A_rs, a1 + hstepA, voffA);
            PG8_WAIT_V(8); PG8_WAIT_L(0); PG8_BAR; PG8_MMA(0, 0, At, B0); PG8_MMA(0, 1, At, B1); PG8_BAR; PG8_SCHED;
            PG8_LDA(At, 0, 1); PG8_STAGE2(PG8_SB(0, 0), B_rs, b2, voffB); PG8_STAGE2(PG8_SB(0, 1), B_rs, b2 + hstepB, voffB); PG8_STAGE2(PG8_SA(0, 0), A_rs, a2, voffA);
            PG8_WAIT_V(8); PG8_WAIT_L(0); PG8_BAR; PG8_MMA(1, 0, At, B0); PG8_MMA(1, 1, At, B1); PG8_BAR; PG8_SCHED;
            PG8_LDB(B0, 1, 0); PG8_LDB(B1, 1, 1); PG8_SCHED; PG8_LDA(At, 1, 0); PG8_STAGE2(PG8_SA(0, 1), A_rs, a2 + hstepA, voffA);
            PG8_WAIT_V(8); PG8_WAIT_L(0); PG8_BAR; PG8_MMA(0, 0, At, B0); PG8_MMA(0, 1, At, B1); PG8_BAR; PG8_SCHED;
            PG8_LDA(At, 1, 1); PG8_STAGE2(PG8_SB(1, 0), B_rs, b3, voffB); PG8_STAGE2(PG8_SB(1, 1), B_rs, b3 + hstepB, voffB); PG8_STAGE2(PG8_SA(1, 0), A_rs, a3, voffA);
            PG8_WAIT_V(8); PG8_WAIT_L(0); PG8_BAR; PG8_MMA(1, 0, At, B0); PG8_MMA(1, 1, At, B1); PG8_BAR; PG8_SCHED;
        }
        { TS_BEGIN(1) if (wr == 0) PG8_BAR;
        { const int tl = fresh_tid((int)threadIdx.x) & 63; E(acc, cur, wr, wc, tl & 15, tl >> 4); } TS_END(1) }
        if (!has_next) break;
#pragma unroll
        for (int a = 0; a < 2; ++a)
#pragma unroll
            for (int b = 0; b < 2; ++b)
#pragma unroll
                for (int m = 0; m < 4; ++m)
#pragma unroll
                    for (int n = 0; n < 2; ++n) acc[a][b][m][n] = (f32x4){0.f, 0.f, 0.f, 0.f};
        cur = nxt; A_c = A_n; B_c = B_n; ++ui;
        if (wr == 1) PG8_BAR;
    }
    PG8_WAIT_V(0);
    PG8_BAR;
#undef PG8_SA
#undef PG8_SB
#undef PG8_STAGE2
#undef PG8_LDA
#undef PG8_LDB
#undef PG8_LO
#undef PG8_HI
#undef PG8_MMA
#undef PG8_WAIT_V
#undef PG8_WAIT_L
#undef PG8_BAR
#undef PG8_SCHED
}

__device__ __forceinline__ void load_rstd(const float* part, const Unit& u, int wr, int fr, float (&rs)[2][4]) {
#pragma unroll
    for (int ai = 0; ai < 2; ++ai)
#pragma unroll
        for (int m = 0; m < 4; ++m) { const float* p = part + (size_t)(u.pm * BM + ai * HALF + wr * 64 + m * 16 + fr) * 8; const f32x4 a = *(const f32x4*)p, b = *(const f32x4*)(p + 4);
            rs[ai][m] = rsqrtf((((a[0] + a[1]) + (a[2] + a[3])) + ((b[0] + b[1]) + (b[2] + b[3]))) * (1.0f / 2048.0f) + 1e-6f); }
}
struct EpiBf16 {
    static constexpr bool PERM = true;
    bf16* O; int ldc;
    __device__ __forceinline__ void operator()(const f32x4 (&acc)[2][2][4][2], const Unit& u, int wr, int wc, int fr, int fq) const {
        const int row0 = u.pm * BM + wr * 64 + fr, col0 = u.pn * BM + wc * 32 + 8 * fq;
#pragma unroll
        for (int ai = 0; ai < 2; ++ai)
#pragma unroll
            for (int m = 0; m < 4; ++m) { bf16* rowp = O + (size_t)(row0 + ai * HALF + m * 16) * ldc + col0;
#pragma unroll
                for (int bj = 0; bj < 2; ++bj) { const f32x4 v0 = acc[ai][bj][m][0], v1 = acc[ai][bj][m][1];
                    v4u w; w.x = pk2(v0[0], v0[1]); w.y = pk2(v0[2], v0[3]); w.z = pk2(v1[0], v1[1]); w.w = pk2(v1[2], v1[3]);
                    *(v4u*)(rowp + bj * HALF) = w; } }
    }
};
struct EpiSwiglu {
    static constexpr bool PERM = true;
    bf16* O; int ldc; const float* part;
    __device__ __forceinline__ void operator()(const f32x4 (&acc)[2][2][4][2], const Unit& u, int wr, int wc, int fr, int fq) const {
        const int row0 = u.pm * BM + wr * 64 + fr, col0 = u.pn * HALF + wc * 32 + 8 * fq;
        float rs[2][4];
        if (part) load_rstd(part, u, wr, fr, rs); else {
#pragma unroll
            for (int i = 0; i < 8; ++i) rs[i >> 2][i & 3] = 1.0f; }
#pragma unroll
        for (int ai = 0; ai < 2; ++ai)
#pragma unroll
            for (int m = 0; m < 4; ++m) { bf16* rowp = O + (size_t)(row0 + ai * HALF + m * 16) * ldc + col0;
                float o[8];
#pragma unroll
                for (int n = 0; n < 2; ++n)
#pragma unroll
                    for (int j = 0; j < 4; ++j) { const float gt = acc[ai][0][m][n][j] * rs[ai][m], up = acc[ai][1][m][n][j] * rs[ai][m]; o[n * 4 + j] = gt * __builtin_amdgcn_rcpf(1.0f + __expf(-gt)) * up; }
                v4u w; w.x = pk2(o[0], o[1]); w.y = pk2(o[2], o[3]); w.z = pk2(o[4], o[5]); w.w = pk2(o[6], o[7]);
                *(v4u*)rowp = w; }
    }
};
template <bool FOLDED>
struct EpiSwigluF8R {
    static constexpr bool PERM = true;
    unsigned char* O; int ldc; const float* part;
    __device__ __forceinline__ void operator()(const f32x4 (&acc)[2][2][4][2], const Unit& u, int wr, int wc, int fr, int fq) const {
        const int row0 = u.pm * BM + wr * 64 + fr, col0 = u.pn * HALF + wc * 32 + 8 * fq;
        float rs[2][4]; load_rstd(part, u, wr, fr, rs);
#pragma unroll
        for (int ai = 0; ai < 2; ++ai)
#pragma unroll
            for (int m = 0; m < 4; ++m) { unsigned char* rowp = O + (size_t)(row0 + ai * HALF + m * 16) * ldc + col0;
                float o[8];
#pragma unroll
                for (int n = 0; n < 2; ++n)
#pragma unroll
                    for (int j = 0; j < 4; ++j) {
                        if constexpr (FOLDED) { const float gt = acc[ai][0][m][n][j] * rs[ai][m], up = acc[ai][1][m][n][j] * rs[ai][m]; o[n * 4 + j] = gt * __builtin_amdgcn_rcpf(1.0f + __builtin_amdgcn_exp2f(-gt)) * up; }
                        else { const float gt = acc[ai][0][m][n][j] * rs[ai][m], up = acc[ai][1][m][n][j] * (rs[ai][m] * 8.0f); o[n * 4 + j] = gt * __builtin_amdgcn_rcpf(1.0f + __expf(-gt)) * up; } }
                v2u w; w.x = pk4_fp8(o[0], o[1], o[2], o[3]); w.y = pk4_fp8(o[4], o[5], o[6], o[7]);
                *(v2u*)rowp = w; }
    }
};
struct EpiSwigluF8 {
    static constexpr bool PERM = true;
    unsigned char* O; int ldc; float scale;
    __device__ __forceinline__ void operator()(const f32x4 (&acc)[2][2][4][2], const Unit& u, int wr, int wc, int fr, int fq) const {
        const int row0 = u.pm * BM + wr * 64 + fr, col0 = u.pn * HALF + wc * 32 + 8 * fq;
#pragma unroll
        for (int ai = 0; ai < 2; ++ai)
#pragma unroll
            for (int m = 0; m < 4; ++m) { unsigned char* rowp = O + (size_t)(row0 + ai * HALF + m * 16) * ldc + col0;
                float o[8];
#pragma unroll
                for (int n = 0; n < 2; ++n)
#pragma unroll
                    for (int j = 0; j < 4; ++j) { const float gt = acc[ai][0][m][n][j], up = acc[ai][1][m][n][j]; o[n * 4 + j] = gt * __builtin_amdgcn_rcpf(1.0f + __builtin_amdgcn_exp2f(-gt)) * up; }
                v2u w; w.x = pk4_fp8(o[0], o[1], o[2], o[3]); w.y = pk4_fp8(o[4], o[5], o[6], o[7]);
                *(v2u*)rowp = w; }
    }
};
template <bool BASE_BF16, bool OUT_BF16, bool STATS, bool OUT_F8 = false>
struct EpiRes {
    static constexpr bool PERM = true;
    const void* base; void* out; float* part; LAS float* tbl; unsigned char* out8 = nullptr;
    __device__ __forceinline__ void operator()(const f32x4 (&acc)[2][2][4][2], const Unit& u, int wr, int wc, int fr, int fq) const {
        const int row0 = u.pm * BM + wr * 64 + fr, col0 = u.pn * BM + wc * 32 + 8 * fq;
#pragma unroll
        for (int ai = 0; ai < 2; ++ai) {
            v4u bw[4][2];
            if (BASE_BF16) {
#pragma unroll
                for (int m = 0; m < 4; ++m)
#pragma unroll
                    for (int bj = 0; bj < 2; ++bj) bw[m][bj] = *(const v4u*)((const bf16*)base + (size_t)(row0 + ai * HALF + m * 16) * D + col0 + bj * HALF);
            }
            f32x4 bf[4][2][2];
            if (!BASE_BF16) {
#pragma unroll
                for (int m = 0; m < 4; ++m)
#pragma unroll
                    for (int bj = 0; bj < 2; ++bj) { const float* bp = (const float*)base + (size_t)(row0 + ai * HALF + m * 16) * D + col0 + bj * HALF; bf[m][bj][0] = *(const f32x4*)bp; bf[m][bj][1] = *(const f32x4*)(bp + 4); }
            }
#pragma unroll
            for (int m = 0; m < 4; ++m) { const size_t off = (size_t)(row0 + ai * HALF + m * 16) * D + col0; float ss = 0.f;
#pragma unroll
                for (int bj = 0; bj < 2; ++bj) { f32x4 v0 = acc[ai][bj][m][0], v1 = acc[ai][bj][m][1];
                    if (BASE_BF16) { const v4u w = bw[m][bj]; v0 += (f32x4){bflo(w.x), bfhi(w.x), bflo(w.y), bfhi(w.y)}; v1 += (f32x4){bflo(w.z), bfhi(w.z), bflo(w.w), bfhi(w.w)}; }
                    else { v0 += bf[m][bj][0]; v1 += bf[m][bj][1]; }
                    if (STATS) ss += ((v0[0] * v0[0] + v0[1] * v0[1]) + (v0[2] * v0[2] + v0[3] * v0[3])) + ((v1[0] * v1[0] + v1[1] * v1[1]) + (v1[2] * v1[2] + v1[3] * v1[3]));
                    if (OUT_F8) { v2u w8; w8.x = pk4_fp8(v0[0], v0[1], v0[2], v0[3]); w8.y = pk4_fp8(v1[0], v1[1], v1[2], v1[3]); *(v2u*)(out8 + off + bj * HALF) = w8; }
                    if (OUT_BF16) { v4u w; w.x = pk2(v0[0], v0[1]); w.y = pk2(v0[2], v0[3]); w.z = pk2(v1[0], v1[1]); w.w = pk2(v1[2], v1[3]); *(v4u*)((bf16*)out + off + bj * HALF) = w; }
                    else { *(f32x4*)((float*)out + off + bj * HALF) = v0; *(f32x4*)((float*)out + off + bj * HALF + 4) = v1; } }
                if (STATS) { ss += __shfl_xor(ss, 16); ss += __shfl_xor(ss, 32); if (fq == 0) tbl[(ai * HALF + wr * 64 + m * 16 + fr) * 4 + wc] = ss; }
                asm volatile("" ::: "memory"); } }
        if (STATS) {
            asm volatile("s_waitcnt lgkmcnt(0)" ::: "memory"); __builtin_amdgcn_s_barrier(); asm volatile("" ::: "memory");
            const int t = threadIdx.x; if (t < 256) { const f32x4 p4 = *(const LAS f32x4*)(tbl + t * 4); part[(size_t)(u.pm * BM + t) * 8 + u.pn] = (p4[0] + p4[1]) + (p4[2] + p4[3]); }
            asm volatile("s_waitcnt lgkmcnt(0)" ::: "memory"); __builtin_amdgcn_s_barrier(); asm volatile("" ::: "memory");
        }
    }
};
struct EpiPartBf16 {
    static constexpr bool PERM = true;
    bf16* out; int ldc; size_t pstride;
    __device__ __forceinline__ void operator()(const f32x4 (&acc)[2][2][4][2], const Unit& u, int wr, int wc, int fr, int fq) const {
        const int row0 = u.pm * BM + wr * 64 + fr, col0 = u.pn * BM + wc * 32 + 8 * fq; bf16* o = out + (size_t)u.z * pstride;
#pragma unroll
        for (int ai = 0; ai < 2; ++ai)
#pragma unroll
            for (int m = 0; m < 4; ++m) { bf16* rowp = o + (size_t)(row0 + ai * HALF + m * 16) * ldc + col0;
#pragma unroll
                for (int bj = 0; bj < 2; ++bj) { const f32x4 v0 = acc[ai][bj][m][0], v1 = acc[ai][bj][m][1];
                    v4u w; w.x = pk2(v0[0], v0[1]); w.y = pk2(v0[2], v0[3]); w.z = pk2(v1[0], v1[1]); w.w = pk2(v1[2], v1[3]);
                    *(v4u*)(rowp + bj * HALF) = w; } }
    }
};
struct EpiRgIn {
    static constexpr bool PERM = true;
    bf16* Y; bf16* XBR; const float* part;
    __device__ __forceinline__ void operator()(const f32x4 (&acc)[2][2][4][2], const Unit& u, int wr, int wc, int fr, int fq) const {
        const bool isy = u.pn < 8; bf16* O = isy ? Y : XBR;
        float rs[2][4]; load_rstd(part, u, wr, fr, rs);
        const int row0 = u.pm * BM + wr * 64 + fr, col0 = (u.pn & 7) * BM + wc * 32 + 8 * fq;
#pragma unroll
        for (int ai = 0; ai < 2; ++ai)
#pragma unroll
            for (int m = 0; m < 4; ++m) { bf16* rowp = O + (size_t)(row0 + ai * HALF + m * 16) * D + col0;
#pragma unroll
                for (int bj = 0; bj < 2; ++bj) { float o[8];
#pragma unroll
                    for (int n = 0; n < 2; ++n)
#pragma unroll
                        for (int j = 0; j < 4; ++j) { float x = acc[ai][bj][m][n][j] * rs[ai][m];
                            if (isy) { const float y2 = 1.5957691216f * (x + 0.044715f * x * x * x); x = x * __builtin_amdgcn_rcpf(1.0f + __expf(-y2)); }
                            o[n * 4 + j] = x; }
                    v4u w; w.x = pk2(o[0], o[1]); w.y = pk2(o[2], o[3]); w.z = pk2(o[4], o[5]); w.w = pk2(o[6], o[7]);
                    *(v4u*)(rowp + bj * HALF) = w; } }
    }
};
struct EpiGates {
    static constexpr bool PERM = true;
    const bf16* XC; const float* ba; const float* bx; const float* lam; bf16* LA; bf16* BB;
    __device__ __forceinline__ void operator()(const f32x4 (&acc)[2][2][4][2], const Unit& u, int wr, int wc, int fr, int fq) const {
        const int row0 = u.pm * BM + wr * 64 + fr, col = u.pn * HALF + wc * 32 + 8 * fq;
        float vba[8], vbx[8], sp[8];
#pragma unroll
        for (int n = 0; n < 2; ++n) { const f32x4 t0 = *(const f32x4*)(ba + col + 4 * n), t1 = *(const f32x4*)(bx + col + 4 * n), t2 = *(const f32x4*)(lam + col + 4 * n);
#pragma unroll
            for (int j = 0; j < 4; ++j) { vba[4 * n + j] = t0[j]; vbx[4 * n + j] = t1[j]; sp[4 * n + j] = t2[j]; } }
#pragma unroll
        for (int ai = 0; ai < 2; ++ai)
#pragma unroll
            for (int m = 0; m < 4; ++m) { const size_t off = (size_t)(row0 + ai * HALF + m * 16) * D + col;
                const v4u xw = *(const v4u*)(XC + off); const float xc[8] = {bflo(xw.x), bfhi(xw.x), bflo(xw.y), bfhi(xw.y), bflo(xw.z), bfhi(xw.z), bflo(xw.w), bfhi(xw.w)};
                float oa[8], ob[8];
#pragma unroll
                for (int n = 0; n < 2; ++n)
#pragma unroll
                    for (int j = 0; j < 4; ++j) { const int q = 4 * n + j; const float r = sigmoidf_(acc[ai][0][m][n][j] + vba[q]), gi = sigmoidf_(acc[ai][1][m][n][j] + vbx[q]);
                        const float la = sp[q] * r, t2 = 2.0f * la; oa[q] = la;
                        const float em = (t2 > -0.01f) ? -t2 * (1.0f + 0.5f * t2 * (1.0f + 0.33333334f * t2)) : 1.0f - __expf(t2);
                        ob[q] = __builtin_amdgcn_sqrtf(fmaxf(em, 0.f)) * (gi * xc[q]); }
                *(v4u*)(LA + off) = (v4u){pk2(oa[0], oa[1]), pk2(oa[2], oa[3]), pk2(oa[4], oa[5]), pk2(oa[6], oa[7])};
                *(v4u*)(BB + off) = (v4u){pk2(ob[0], ob[1]), pk2(ob[2], ob[3]), pk2(ob[4], ob[5]), pk2(ob[6], ob[7])}; asm volatile("" ::: "memory"); }
    }
};
}

#define XB_TMO      128
#define XB_XCNT(j)  (256  + 64 * (j))
#define XB_XSUB(j)  (1280 + 64 * (j))
#define XB_XGEN(j)  (2304 + 64 * (j))
#define XB_TOP      3328
#define XB_TOPGEN   3392
#define XCD_BAR_WORDS 3456
#define XB_SPIN_CAP (1u << 22)
__device__ __forceinline__ unsigned xb_ld(unsigned* p)              { return __hip_atomic_load(p, __ATOMIC_RELAXED, __HIP_MEMORY_SCOPE_AGENT); }
__device__ __forceinline__ unsigned xb_add(unsigned* p, unsigned v) { return __hip_atomic_fetch_add(p, v, __ATOMIC_RELAXED, __HIP_MEMORY_SCOPE_AGENT); }
__device__ __forceinline__ unsigned xb_xcc_id() { return (unsigned)__builtin_amdgcn_s_getreg((3 << 11) | 20) & 0xFu; }
#define XB_SPIN(cond, bar) do { unsigned _sp = 0; while (cond) { __builtin_amdgcn_s_sleep(1); \
    if ((++_sp & 255u) == 0u) { if (xb_ld(&(bar)[XB_TMO])) break; if (_sp > XB_SPIN_CAP) { atomicAdd(&(bar)[XB_TMO], 1u); break; } } } } while (0)
struct XcdBarrier { unsigned* bar; unsigned x; volatile LAS unsigned* st; };
__device__ __forceinline__ XcdBarrier xcd_barrier_post(unsigned* bar, volatile LAS unsigned* st) {
    XcdBarrier b; b.bar = bar; b.x = xb_xcc_id(); b.st = st;
    if (threadIdx.x == 0) (void)xb_add(&bar[XB_XCNT(b.x)], 1u);
    return b;
}
__device__ __forceinline__ void xcd_barrier_complete(unsigned* bar, unsigned x, unsigned& nloc, unsigned& nx) {
    const unsigned G = gridDim.x * gridDim.y * gridDim.z;
    unsigned sum, cnt, mine, sp = 0u;
    for (;;) {
        sum = 0u; cnt = 0u; mine = 0u;
#pragma unroll
        for (unsigned j = 0; j < 16; ++j) { const unsigned c = xb_ld(&bar[XB_XCNT(j)]); sum += c; cnt += (c > 0u) ? 1u : 0u; mine = (j == x) ? c : mine; }
        if (sum == G) break;
        __builtin_amdgcn_s_sleep(1);
        if ((++sp & 255u) == 0u) { if (xb_ld(&bar[XB_TMO])) break; if (sp > XB_SPIN_CAP) { atomicAdd(&bar[XB_TMO], 1u); break; } }
    }
    nloc = mine > 0u ? mine : 1u; nx = cnt > 0u ? cnt : 1u;
}
__device__ __forceinline__ void xcd_barrier(const XcdBarrier& b) {
    asm volatile("s_waitcnt vmcnt(0)" ::: "memory");
    __syncthreads();
    if (threadIdx.x == 0) {
        unsigned* bar = b.bar;
        __builtin_amdgcn_s_waitcnt(0);
        unsigned nloc = b.st[0], nx = b.st[1];
        if (nloc == 0u) { xcd_barrier_complete(bar, b.x, nloc, nx); b.st[0] = nloc; b.st[1] = nx; }
        const unsigned old = xb_add(&bar[XB_XSUB(b.x)], 1u);
        const unsigned gen = old / nloc;
        if (old + 1u == (gen + 1u) * nloc) {
            __builtin_amdgcn_fence(__ATOMIC_RELEASE, "agent");
            asm volatile("s_waitcnt vmcnt(0)" ::: "memory");
            const unsigned og = xb_add(&bar[XB_TOP], 1u);
            const unsigned tg = og / nx;
            if (og + 1u == (tg + 1u) * nx) xb_add(&bar[XB_TOPGEN], 1u);
            else XB_SPIN(xb_ld(&bar[XB_TOPGEN]) == tg, bar);
            __builtin_amdgcn_fence(__ATOMIC_ACQUIRE, "agent");
            xb_add(&bar[XB_XGEN(b.x)], 1u);
            asm volatile("s_waitcnt vmcnt(0)" ::: "memory");
        } else {
            XB_SPIN(xb_ld(&bar[XB_XGEN(b.x)]) == gen, bar);
            __builtin_amdgcn_fence(__ATOMIC_ACQUIRE, "agent");
            asm volatile("s_waitcnt vmcnt(0)" ::: "memory");
        }
    }
    __syncthreads();
}

struct Frame {
    LAS unsigned char* lds;
    int tid, lane, wave, G, blk;
    unsigned char* ws;
    const float* in[25];
    float* out;
};
enum { I_X = 0, I_NORMW, I_FNW, I_MIXIN, I_GCONV, I_ALOG, I_DTB, I_GNW, I_LBL, I_HNW, I_MIXOUT, I_FGU, I_FD, I_RGIN, I_RGCW, I_RGCB, I_RGAW, I_RGAB, I_RGXW, I_RGXB, I_LAM, I_RGOUT, I_ROUTER, I_MGU, I_MD };

struct Job { const float* src; bf16* dst; int ld, K, n0, ncols, drow0, mode, nbatch; long sbs; int dbs; int f8; float scale; const float* rsc; };
__device__ __forceinline__ void conv_item(const Job& jb, LAS float* scr, int item, int lane) {
    const int nblk = jb.ncols / 32, per = (jb.K / 64) * nblk, b = item / per, r = item % per, kb = r / nblk, nb = r % nblk, k0 = 64 * kb, n0l = 32 * nb;
    const float* sp = jb.src + (size_t)b * jb.sbs + (size_t)k0 * jb.ld + jb.n0 + n0l;
#pragma unroll 8
    for (int i = 0; i < 32; ++i) { const int kk = 2 * i + (lane >> 5); scr[kk * 33 + (lane & 31)] = sp[(size_t)kk * jb.ld + (lane & 31)]; }
    LDS_WAIT(); asm volatile("" ::: "memory");
    const int c = lane & 7;
#pragma unroll
    for (int j = 0; j < 4; ++j) { const int n = (lane >> 3) + 8 * j, nl = n0l + n; const LAS float* s = scr + (8 * c) * 33 + n;
        const int drow = jb.drow0 + b * jb.dbs + (jb.mode ? ((nl >> 7) * 256 + (nl & 127)) : nl);
        if (jb.f8) { const float sc = jb.scale; v2u o; o.x = pk4_fp8(s[0 * 33] * sc, s[1 * 33] * sc, s[2 * 33] * sc, s[3 * 33] * sc); o.y = pk4_fp8(s[4 * 33] * sc, s[5 * 33] * sc, s[6 * 33] * sc, s[7 * 33] * sc);
            *(v2u*)((unsigned char*)jb.dst + (size_t)drow * jb.K + k0 + 8 * c) = o; }
        else { v4u o; o.x = pk2(s[0 * 33], s[1 * 33]); o.y = pk2(s[2 * 33], s[3 * 33]); o.z = pk2(s[4 * 33], s[5 * 33]); o.w = pk2(s[6 * 33], s[7 * 33]);
            *(v4u*)(jb.dst + (size_t)drow * jb.K + k0 + 8 * c) = o; } }
    LDS_WAIT(); asm volatile("" ::: "memory");
}
constexpr int NJOBS = 13, MD_LATE = 1, FFN_GEMM_WG = 235;
__device__ __forceinline__ Job get_job(const Frame& F, int j) {
    Job b; b.n0 = 0; b.drow0 = 0; b.mode = 0; b.nbatch = 1; b.sbs = 0; b.dbs = 0; b.f8 = 0; b.scale = 1.0f; b.rsc = nullptr;
    unsigned char* ws = F.ws;
    switch (j) {
    case 0:  b.src = F.in[I_MIXIN]; b.dst = (bf16*)(ws + O_WMI); b.ld = MIXLD; b.K = D; b.ncols = 4096; break;
    case 1:  b.src = F.in[I_MIXIN]; b.dst = (bf16*)(ws + O_WMI); b.ld = MIXLD; b.K = D; b.n0 = 4112; b.ncols = 4096; b.drow0 = 4096; break;
    case 2:  b.src = F.in[I_MIXOUT]; b.dst = (bf16*)(ws + O_WMO); b.ld = D; b.K = D; b.ncols = D; break;
    case 3:  b.src = F.in[I_FGU]; b.dst = (bf16*)(ws + O_WFG); b.ld = 2 * FF; b.K = D; b.ncols = FF; b.mode = 1; b.rsc = F.in[I_NORMW] + D; b.f8 = FFNG_F8; b.scale = FFNG_F8 ? (FFND_F8 ? 64.0f * 1.4426950408889634f : 64.0f) : 1.0f; break;
    case 4:  b.src = F.in[I_FGU]; b.dst = (bf16*)(ws + O_WFG); b.ld = 2 * FF; b.K = D; b.n0 = FF; b.ncols = FF; b.drow0 = 128; b.mode = 1; b.rsc = F.in[I_NORMW] + D; b.f8 = FFNG_F8; b.scale = FFNG_F8 ? (FFND_F8 ? 64.0f * 8.0f / 1.4426950408889634f : 64.0f) : 1.0f; break;
    case 5:  b.src = F.in[I_FD]; b.dst = (bf16*)(ws + O_WFD); b.ld = D; b.K = FF; b.ncols = D; b.f8 = FFND_F8; b.scale = FFND_F8 ? 128.0f : 1.0f; break;
    case 6:  b.src = F.in[I_RGIN]; b.dst = (bf16*)(ws + O_WRI); b.ld = 2 * D; b.K = D; b.ncols = 2 * D; b.rsc = F.in[I_NORMW] + 2 * D; break;
    case 7:  b.src = F.in[I_RGAW]; b.dst = (bf16*)(ws + O_WRG); b.ld = 256; b.K = 256; b.ncols = 256; b.mode = 1; b.nbatch = 8; b.sbs = 65536; b.dbs = 512; break;
    case 8:  b.src = F.in[I_RGXW]; b.dst = (bf16*)(ws + O_WRG); b.ld = 256; b.K = 256; b.ncols = 256; b.drow0 = 128; b.mode = 1; b.nbatch = 8; b.sbs = 65536; b.dbs = 512; break;
    case 9:  b.src = F.in[I_RGOUT]; b.dst = (bf16*)(ws + O_WRO); b.ld = D; b.K = D; b.ncols = D; break;
    case 10: b.src = F.in[I_MGU]; b.dst = (bf16*)(ws + O_WMG); b.ld = 2 * FE; b.K = D; b.ncols = FE; b.mode = 1; b.nbatch = 8; b.sbs = (long)D * 2 * FE; b.dbs = 2 * FE; b.f8 = MOE_F8; b.scale = MOE_F8 ? 64.0f * 1.4426950408889634f : 1.0f; break;
    case 11: b.src = F.in[I_MGU]; b.dst = (bf16*)(ws + O_WMG); b.ld = 2 * FE; b.K = D; b.n0 = FE; b.ncols = FE; b.drow0 = 128; b.mode = 1; b.nbatch = 8; b.sbs = (long)D * 2 * FE; b.dbs = 2 * FE; b.f8 = MOE_F8; b.scale = MOE_F8 ? 64.0f * 8.0f / 1.4426950408889634f : 1.0f; break;
    case 12: b.src = F.in[I_MD]; b.dst = (bf16*)(ws + O_WMD); b.ld = D; b.K = FE; b.ncols = D; b.nbatch = 8 - MD_LATE; b.sbs = (long)FE * D; b.dbs = D; b.f8 = MOE_F8; b.scale = MOE_F8 ? 128.0f : 1.0f; break;
    default: b.src = F.in[I_MD] + (size_t)(8 - MD_LATE) * FE * D; b.dst = (bf16*)(ws + O_WMD); b.ld = D; b.K = FE; b.ncols = D; b.nbatch = MD_LATE; b.sbs = (long)FE * D; b.dbs = D; b.drow0 = (8 - MD_LATE) * D; b.f8 = MOE_F8; b.scale = MOE_F8 ? 128.0f : 1.0f; break;
    }
    return b;
}
constexpr int job_tiles(int j) { return j == 0 || j == 1 ? 32 * 16 : j == 2 ? 32 * 8 : j == 3 || j == 4 ? 32 * 22 : j == 5 ? 88 * 8 : j == 6 ? 32 * 16 : j == 7 || j == 8 ? 8 * 4 * 1 : j == 9 ? 32 * 8 : j == 10 || j == 11 ? 8 * 32 * 28 : j == 12 ? (8 - MD_LATE) * 112 * 8 : MD_LATE * 112 * 8; }
constexpr int tiles_cum(int j0, int j) { int s = 0; for (int k = j0; k < j; ++k) s += job_tiles(k); return s; }
template <int J0, int J1, int STATIC = 0>
__device__ __forceinline__ void convert_tiles(const Frame& F, unsigned* qhead, int first = 0, int stride = 0, int dyn_base = 0) {
    constexpr int total = tiles_cum(J0, J1), TS = 64 * 260;
    LAS float* tile0 = (LAS float*)F.lds; LAS int* tick = (LAS int*)(F.lds + 2 * TS * 4);
    const int tid = F.tid, lane = F.lane, w = F.wave;
    if (STATIC == 0) { if (tid == 0) { tick[2] = dyn_base + (int)__hip_atomic_fetch_add(qhead, 1u, __ATOMIC_RELAXED, __HIP_MEMORY_SCOPE_AGENT); tick[3] = dyn_base + (int)__hip_atomic_fetch_add(qhead, 1u, __ATOMIC_RELAXED, __HIP_MEMORY_SCOPE_AGENT); } }
    SBAR();
    int it = STATIC ? first : tick[2], it1 = STATIC ? first + stride : tick[3];
    f32x4 rg[8], rh[8];
#define CT_DECODE(it_, jb_, b_, k0_, nb_) int jj_ = J0; { _Pragma("unroll") for (int k_ = J0 + 1; k_ < J1; ++k_) jj_ += ((it_) >= tiles_cum(J0, k_)) ? 1 : 0; } int cc_ = 0; { _Pragma("unroll") for (int k_ = J0 + 1; k_ < J1; ++k_) cc_ = ((it_) >= tiles_cum(J0, k_)) ? tiles_cum(J0, k_) : cc_; } \
        const Job jb_ = get_job(F, jj_); const int ntn_ = jb_.ncols / 256, per_ = (jb_.K / 64) * ntn_, r0_ = (it_) - cc_, b_ = r0_ / per_, r1_ = r0_ % per_, k0_ = (r1_ / ntn_) * 64, nb_ = r1_ % ntn_;
#define CT_LOAD(it_, R_) do { CT_DECODE(it_, jb, bb, k0, nb) const float* sp = jb.src + (size_t)bb * jb.sbs + (size_t)(k0 + w * 8) * jb.ld + jb.n0 + nb * 256 + 4 * lane; \
        _Pragma("unroll") for (int i = 0; i < 8; ++i) R_[i] = *(const f32x4*)(sp + (size_t)i * jb.ld); } while (0)
    if (it < total) CT_LOAD(it, rg);
    if (it1 < total) CT_LOAD(it1, rh);
    int buf = 0;
    while (it < total) {
        LAS float* tl = tile0 + buf * TS;
#pragma unroll
        for (int i = 0; i < 8; ++i) *(LAS f32x4*)(tl + (w * 8 + i) * 260 + 4 * lane) = rg[i];
        if (STATIC != 1) { if (tid == 0) tick[buf] = dyn_base + (int)__hip_atomic_fetch_add(qhead, 1u, __ATOMIC_RELAXED, __HIP_MEMORY_SCOPE_AGENT); }
        SBAR();
        const int it2 = STATIC == 1 ? it1 + stride : tick[buf];
#pragma unroll
        for (int i = 0; i < 8; ++i) rg[i] = rh[i];
        if (it2 < total) CT_LOAD(it2, rh);
        {
            CT_DECODE(it, jb, bb, k0, nb)
            const int n = tid >> 1, kh = tid & 1, nl = nb * 256 + n;
            const int drow = jb.drow0 + bb * jb.dbs + (jb.mode ? ((nl >> 7) * 256 + (nl & 127)) : nl);
            float v[32];
#pragma unroll
            for (int j = 0; j < 32; ++j) v[j] = tl[(32 * kh + j) * 260 + n];
            if (jb.rsc) {
#pragma unroll
                for (int j = 0; j < 32; j += 4) { const f32x4 g4 = *(const f32x4*)(jb.rsc + k0 + 32 * kh + j); v[j] *= g4[0]; v[j + 1] *= g4[1]; v[j + 2] *= g4[2]; v[j + 3] *= g4[3]; } }
            if (jb.f8) { const float sc = jb.scale; unsigned o[8];
#pragma unroll
                for (int j = 0; j < 8; ++j) o[j] = pk4_fp8(v[4 * j] * sc, v[4 * j + 1] * sc, v[4 * j + 2] * sc, v[4 * j + 3] * sc);
                v4u* dp = (v4u*)((unsigned char*)jb.dst + (size_t)drow * jb.K + k0 + 32 * kh);
                dp[0] = (v4u){o[0], o[1], o[2], o[3]}; dp[1] = (v4u){o[4], o[5], o[6], o[7]};
            } else { unsigned o[16];
#pragma unroll
                for (int j = 0; j < 16; ++j) o[j] = pk2(v[2 * j], v[2 * j + 1]);
                v4u* dp = (v4u*)(jb.dst + (size_t)drow * jb.K + k0 + 32 * kh);
#pragma unroll
                for (int j = 0; j < 4; ++j) dp[j] = (v4u){o[4 * j], o[4 * j + 1], o[4 * j + 2], o[4 * j + 3]}; }
        }
        it = it1; it1 = it2; buf ^= 1;
    }
    SBAR();
#undef CT_LOAD
#undef CT_DECODE
}
__device__ __forceinline__ void convert_jobs(const Frame& F, int j0, int j1, int gw, int ngw) {
    LAS float* scr = (LAS float*)(F.lds + F.wave * 16384);
    for (int j = j0; j < j1; ++j) { const Job jb = get_job(F, j); const int nitems = jb.nbatch * (jb.K / 64) * (jb.ncols / 32);
        for (int it = gw; it < nitems; it += ngw) conv_item(jb, scr, it, F.lane); }
}

template <bool SRC_BF16 = false>
__device__ __forceinline__ void rms_load(const void* xrow, const float* nw, int lane, f32x4 (&v)[8]) {
    float s = 0.f;
#pragma unroll
    for (int j = 0; j < 8; ++j) { if (SRC_BF16) { const v2u w = ((const v2u*)xrow)[lane + 64 * j]; v[j] = (f32x4){bflo(w.x), bfhi(w.x), bflo(w.y), bfhi(w.y)}; } else v[j] = ((const f32x4*)xrow)[lane + 64 * j]; s += (v[j].x * v[j].x + v[j].y * v[j].y) + (v[j].z * v[j].z + v[j].w * v[j].w); }
    const float rstd = rsqrtf(wave_sum(s) * (1.0f / D) + EPS);
#pragma unroll
    for (int j = 0; j < 8; ++j) { const f32x4 w = ((const f32x4*)nw)[lane + 64 * j]; v[j] = v[j] * rstd * w; }
}
__device__ __forceinline__ void row_store_bf16(bf16* orow, int lane, const f32x4 (&v)[8]) {
#pragma unroll
    for (int j = 0; j < 8; ++j) { v2u w; w.x = pk2(v[j].x, v[j].y); w.y = pk2(v[j].z, v[j].w); ((v2u*)orow)[lane + 64 * j] = w; }
}

template <int N> __device__ __forceinline__ int red_index(int lane) { return N == 16 ? ((lane >> 5) & 1) * 8 + ((lane >> 4) & 1) * 4 + ((lane >> 3) & 1) * 2 + ((lane >> 2) & 1) : ((lane >> 5) & 1) * 4 + ((lane >> 4) & 1) * 2 + ((lane >> 3) & 1); }
template <int N, int X> __device__ __forceinline__ void red_step(float (&a)[N <= 8 ? 8 : 16], int lane) {
    const bool hi = (lane & X) != 0;
#pragma unroll
    for (int i = 0; i < N / 2; ++i) { const float send = hi ? a[i] : a[i + N / 2], keep = hi ? a[i + N / 2] : a[i]; a[i] = keep + __shfl_xor(send, X); }
}
__device__ __forceinline__ float red_multi16(float (&a)[16], int lane) { red_step<16, 32>(a, lane); red_step<8, 16>(reinterpret_cast<float (&)[8]>(a), lane); float b4[8];
#pragma unroll
    for (int i = 0; i < 8; ++i) b4[i] = a[i];
    red_step<4, 8>(b4, lane); red_step<2, 4>(b4, lane); float v = b4[0]; v += __shfl_xor(v, 2); v += __shfl_xor(v, 1); return v; }
__device__ __forceinline__ float red_multi8(float (&a)[8], int lane) { red_step<8, 32>(a, lane); red_step<4, 16>(a, lane); red_step<2, 8>(a, lane); float v = a[0]; v += __shfl_xor(v, 4); v += __shfl_xor(v, 2); v += __shfl_xor(v, 1); return v; }
__device__ __forceinline__ void phase_prologue(const Frame& F) {
    const int gw = F.blk * 8 + F.wave, ngw = F.G * 8;
    convert_tiles<0, 2, 1>(F, (unsigned*)(F.ws + O_CTL) + CW_Q0, F.blk, F.G);
    if (F.blk == 0) for (int i = F.tid; i < D; i += 512) ((float*)(F.ws + O_SPL))[i] = -8.0f * log1pf(__expf(-F.in[I_LAM][i]));
    __syncthreads();
    LAS float* w16 = (LAS float*)F.lds;
    const float* W = F.in[I_MIXIN];
    for (int idx = F.tid; idx < D * 16; idx += 512) { const int c = idx & 15, i = idx >> 4; w16[c * 2052 + i] = W[(size_t)i * MIXLD + 4096 + c]; }
    __syncthreads();
    const float* nw = F.in[I_NORMW];
    bf16* XN = (bf16*)(F.ws + O_XN); float* GB = (float*)(F.ws + O_GB);
    for (int m = gw; m < T; m += ngw) {
        f32x4 v[8]; rms_load(F.in[I_X] + (size_t)m * D, nw, F.lane, v);
        row_store_bf16(XN + (size_t)m * D, F.lane, v);
        float pa[16];
#pragma unroll
        for (int c = 0; c < 16; ++c) pa[c] = 0.f;
#pragma unroll
        for (int j = 0; j < 8; ++j) {
#pragma unroll
            for (int c = 0; c < 16; ++c) { const f32x4 w = *(const LAS f32x4*)(w16 + c * 2052 + 4 * F.lane + 256 * j); pa[c] += (v[j].x * w.x + v[j].y * w.y) + (v[j].z * w.z + v[j].w * w.w); }
            asm volatile("" ::: "memory"); }
        const float mine = red_multi16(pa, F.lane); const int idx = red_index<16>(F.lane);
        if ((F.lane & 3) == 0) { if (idx < 8) GB[(size_t)m * 16 + idx] = sigmoidf_(mine);
            else { const int h = idx - 8; GB[(size_t)m * 16 + idx] = -__expf(F.in[I_ALOG][h]) * softplusf_(mine + F.in[I_DTB][h]); } }
    }
    __syncthreads();
}

__device__ __forceinline__ void phase_rms(const Frame& F, const float* X, const float* nw) {
    const int gw = F.blk * 8 + F.wave, ngw = F.G * 8; bf16* XN = (bf16*)(F.ws + O_XN);
    for (int m = gw; m < T; m += ngw) { f32x4 v[8]; rms_load(X + (size_t)m * D, nw, F.lane, v); row_store_bf16(XN + (size_t)m * D, F.lane, v); }
}

__device__ __forceinline__ void phase_mix_pre(const Frame& F) {
    const int gw = F.blk * 8 + F.wave, ngw = F.G * 8, lane = F.lane;
    const bf16* P = (const bf16*)(F.ws + O_PROJ);
    float* QF = (float*)(F.ws + O_QF); float* KF = (float*)(F.ws + O_KF); float* VF = (float*)(F.ws + O_VF); float* FH = (float*)(F.ws + O_FH); float* QH = (float*)(F.ws + O_QH);
    const float* cw = F.in[I_GCONV];
    const float* lbl = F.in[I_LBL];
    for (int it = gw; it < T * 8; it += ngw) {
        const int t = it >> 3, h = it & 7, s = t & (SEQ - 1), d = h * 128 + 2 * lane;
        float r[3][2];
#pragma unroll
        for (int mat = 0; mat < 3; ++mat) { float a0 = 0.f, a1 = 0.f;
#pragma unroll
            for (int j = 0; j < 4; ++j) { if (s - 3 + j >= 0) { const unsigned w = *(const unsigned*)(P + (size_t)(t - 3 + j) * NPROJ + mat * 1024 + d);
                    const f32x2 c = *(const f32x2*)(cw + j * 3072 + mat * 1024 + d); a0 += c.x * bflo(w); a1 += c.y * bfhi(w); } }
            r[mat][0] = siluf_(a0); r[mat][1] = siluf_(a1); }
        const float qs = wave_sum(r[0][0] * r[0][0] + r[0][1] * r[0][1]), ks = wave_sum(r[1][0] * r[1][0] + r[1][1] * r[1][1]);
        const float qn = rsqrtf(qs + EPS) * 0.08838834764831845f, kn = rsqrtf(ks + EPS);
        const size_t o = (size_t)t * 1024 + d;
        *(f32x2*)(QF + o) = (f32x2){r[0][0] * qn, r[0][1] * qn}; *(f32x2*)(KF + o) = (f32x2){r[1][0] * kn, r[1][1] * kn}; *(f32x2*)(VF + o) = (f32x2){r[2][0], r[2][1]};
        const unsigned wq = *(const unsigned*)(P + (size_t)t * NPROJ + PQ_BQ + d), wf = *(const unsigned*)(P + (size_t)t * NPROJ + PQ_BF + d);
        const f32x2 l0 = *(const f32x2*)(lbl + d), l1 = *(const f32x2*)(lbl + 1024 + d);
        const float lb0 = sigmoidf_(l0.x - l1.x), lb1 = sigmoidf_(l0.y - l1.y);
        *(f32x2*)(FH + o) = (f32x2){lb0 + (1.f - lb0) * sigmoidf_(bflo(wf)), lb1 + (1.f - lb1) * sigmoidf_(bfhi(wf))};
        *(f32x2*)(QH + o) = (f32x2){siluf_(bflo(wq)) * 0.08838834764831845f, siluf_(bfhi(wq)) * 0.08838834764831845f};
    }
}

__device__ __forceinline__ void phase_mix_scan_slow(const Frame& F) {
    if (F.blk >= 32) return;
    const int mixer = F.blk >> 4, b = (F.blk >> 3) & 1, h = F.blk & 7, tid = F.tid;
    if (mixer == 0 && FAST_GDN) return;
    if (mixer == 1 && FAST_HGRN) return;
    LAS float* ks = (LAS float*)F.lds;
    LAS float* qs = ks + 8192; LAS float* vs = qs + 8192; LAS float* ot = vs + 8192;
    LAS float* red1 = ot + 8192; LAS float* red2 = red1 + 512; LAS float* ab = red2 + 512;
    const float* KSRC = (const float*)(F.ws + (mixer ? O_FH : O_KF)); const float* QSRC = (const float*)(F.ws + (mixer ? O_QH : O_QF)); const float* VSRC = (const float*)(F.ws + O_VF);
    const bf16* P = (const bf16*)(F.ws + O_PROJ); const float* GB = (const float*)(F.ws + O_GB);
    bf16* O = (bf16*)(F.ws + O_O);
    const float* nw = mixer ? F.in[I_HNW] : F.in[I_GNW];
    const int e = tid & 127, qd = tid >> 7;
    float S[32];
#pragma unroll
    for (int i = 0; i < 32; ++i) S[i] = 0.f;
    for (int n = 0; n < 64; ++n) {
        const int t0 = b * SEQ + n * 64;
        for (int idx = tid; idx < 64 * 32; idx += 512) { const int r = idx >> 5, c4 = (idx & 31) * 4; const size_t go = (size_t)(t0 + r) * 1024 + h * 128 + c4;
            *(LAS f32x4*)(ks + r * 128 + c4) = *(const f32x4*)(KSRC + go); *(LAS f32x4*)(qs + r * 128 + c4) = *(const f32x4*)(QSRC + go);
            f32x4 vv; if (mixer) { const v2u w = *(const v2u*)(P + (size_t)(t0 + r) * NPROJ + PQ_BI + h * 128 + c4); vv = (f32x4){bflo(w.x), bfhi(w.x), bflo(w.y), bfhi(w.y)}; } else vv = *(const f32x4*)(VSRC + go);
            *(LAS f32x4*)(vs + r * 128 + c4) = vv; }
        if (tid < 64) { ab[tid * 2] = __expf(GB[(size_t)(t0 + tid) * 16 + 8 + h]); ab[tid * 2 + 1] = GB[(size_t)(t0 + tid) * 16 + h]; }
        __syncthreads();
        for (int r = 0; r < 64; ++r) {
            const LAS float* kr = ks + r * 128 + qd * 32; const LAS float* qr = qs + r * 128 + qd * 32; const float ve = vs[r * 128 + e];
            float osum = 0.f;
            if (mixer == 0) {
                const float a = ab[r * 2], bt = ab[r * 2 + 1];
                float p = 0.f;
#pragma unroll
                for (int i = 0; i < 32; ++i) p += kr[i] * S[i];
                red1[qd * 128 + e] = p;
                __syncthreads();
                const float kS = (red1[e] + red1[128 + e]) + (red1[256 + e] + red1[384 + e]);
                const float c1 = bt * (ve - a * kS);
#pragma unroll
                for (int i = 0; i < 32; ++i) { S[i] = a * S[i] + kr[i] * c1; osum += qr[i] * S[i]; }
            } else {
#pragma unroll
                for (int i = 0; i < 32; ++i) { const float f = kr[i]; S[i] = f * S[i] + (1.f - f) * ve; osum += qr[i] * S[i]; }
            }
            red2[qd * 128 + e] = osum;
            __syncthreads();
            if (tid < 128) ot[r * 128 + e] = (red2[e] + red2[128 + e]) + (red2[256 + e] + red2[384 + e]);
        }
        __syncthreads();
        {
            const int r = tid >> 3, c0 = (tid & 7) * 16; float o[16]; float ss = 0.f;
#pragma unroll
            for (int i = 0; i < 16; ++i) { o[i] = ot[r * 128 + c0 + i]; ss += o[i] * o[i]; }
            ss += __shfl_xor(ss, 1); ss += __shfl_xor(ss, 2); ss += __shfl_xor(ss, 4);
            const float rstd = rsqrtf(ss * (1.0f / 128.0f) + EPS);
            const bf16* zp = P + (size_t)(t0 + r) * NPROJ + (mixer ? PQ_BG : PQ_AZ) + h * 128 + c0;
            const v4u z0 = *(const v4u*)zp, z1 = *(const v4u*)(zp + 8);
            const unsigned zw[8] = {z0.x, z0.y, z0.z, z0.w, z1.x, z1.y, z1.z, z1.w};
            unsigned ow[8];
#pragma unroll
            for (int i = 0; i < 8; ++i) { const float za = bflo(zw[i]), zb = bfhi(zw[i]);
                ow[i] = pk2(o[2 * i] * rstd * nw[c0 + 2 * i] * siluf_(za), o[2 * i + 1] * rstd * nw[c0 + 2 * i + 1] * siluf_(zb)); }
            bf16* op = O + (size_t)(t0 + r) * D + mixer * 1024 + h * 128 + c0;
            *(v4u*)op = (v4u){ow[0], ow[1], ow[2], ow[3]}; *(v4u*)(op + 8) = (v4u){ow[4], ow[5], ow[6], ow[7]};
        }
        __syncthreads();
    }
}


constexpr int R_NW = 0, R_QD = 16384, R_QK = 32768, R_KDT = 40960, R_DEC = 57344;
__device__ __forceinline__ int frag_off(int row, int k, int nkb) { const int mt = row >> 4, kb = k >> 5, r = row & 15, k5 = k & 31, g = (k5 >> 2) & 3, j = (k5 >> 4) * 4 + (k5 & 3); return ((mt * nkb + kb) * 64 + g * 16 + r) * 16 + j * 2; }
__device__ __forceinline__ bf16x8 pack8(const f32x4 a, const f32x4 b) { v4u w; w.x = pk2(a[0], a[1]); w.y = pk2(a[2], a[3]); w.z = pk2(b[0], b[1]); w.w = pk2(b[2], b[3]); return __builtin_bit_cast(bf16x8, w); }

__device__ __forceinline__ void store_frag_row16(unsigned char* base, int row, int cb, int nkb, const float (&x)[16]) {
#pragma unroll
    for (int a = 0; a < 4; ++a) { v2u w; w.x = pk2(x[4 * a], x[4 * a + 1]); w.y = pk2(x[4 * a + 2], x[4 * a + 3]); *(v2u*)(base + frag_off(row, cb * 16 + 4 * a, nkb)) = w; }
}

__device__ __forceinline__ void gdn_prep_unit(const Frame& F, int b, int h, int n) {
    const int tid = F.tid, lane = F.lane, wave = F.wave, r = tid >> 3, cb = tid & 7, t0 = b * SEQ + n * 64, seq = b * 8 + h;
    LAS bf16* KB = (LAS bf16*)F.lds;
    LAS bf16* QB = (LAS bf16*)(F.lds + 17408);
    LAS float* LM = (LAS float*)(F.lds + 34816);
    LAS float* RHS = (LAS float*)(F.lds + 52224);
    LAS float* GC = (LAS float*)(F.lds + 117760);
    const bf16* P = (const bf16*)(F.ws + O_PROJ); const float* GB = (const float*)(F.ws + O_GB); const float* cw = F.in[I_GCONV];
    unsigned char* rec = F.ws + O_OPS + ((size_t)seq * 64 + n) * REC_BYTES; float* UT = (float*)(F.ws + O_UT) + ((size_t)seq * 64 + n) * 8192;
    float q[16], k[16], v[16];
    {
        LAS unsigned char* PT = F.lds + 52224;
        LAS float* CW = (LAS float*)(F.lds + 34816);
        for (int p = tid; p < 67 * 48; p += 512) { const int row = p / 48, pc = p - row * 48; v4u w = (v4u){0u, 0u, 0u, 0u};
            if (n * 64 - 3 + row >= 0) w = *(const v4u*)(P + (size_t)(t0 - 3 + row) * NPROJ + (pc >> 4) * 1024 + h * 128 + (pc & 15) * 8);
            *(LAS v4u*)(PT + row * 784 + pc * 16) = w; }
        if (tid < 384) { const int ri = tid >> 5, pc = tid & 31, j = ri / 3, mat = ri - 3 * j; *(LAS f32x4*)(CW + ri * 128 + pc * 4) = *(const f32x4*)(cw + j * 3072 + mat * 1024 + h * 128 + pc * 4); }
        SBAR();
#pragma unroll
        for (int mat = 0; mat < 3; ++mat) { float a[16];
#pragma unroll
            for (int i = 0; i < 16; ++i) a[i] = 0.f;
#pragma unroll
            for (int j = 0; j < 4; ++j) { const LAS unsigned char* pp = PT + (r + j) * 784 + mat * 256 + cb * 32; const v4u w0 = *(const LAS v4u*)pp, w1 = *(const LAS v4u*)(pp + 16);
                    const LAS float* cp = CW + (j * 3 + mat) * 128 + cb * 16; const f32x4 c0 = *(const LAS f32x4*)cp, c1 = *(const LAS f32x4*)(cp + 4), c2 = *(const LAS f32x4*)(cp + 8), c3 = *(const LAS f32x4*)(cp + 12);
                    a[0] += c0.x * bflo(w0.x); a[1] += c0.y * bfhi(w0.x); a[2] += c0.z * bflo(w0.y); a[3] += c0.w * bfhi(w0.y); a[4] += c1.x * bflo(w0.z); a[5] += c1.y * bfhi(w0.z); a[6] += c1.z * bflo(w0.w); a[7] += c1.w * bfhi(w0.w);
                    a[8] += c2.x * bflo(w1.x); a[9] += c2.y * bfhi(w1.x); a[10] += c2.z * bflo(w1.y); a[11] += c2.w * bfhi(w1.y); a[12] += c3.x * bflo(w1.z); a[13] += c3.y * bfhi(w1.z); a[14] += c3.z * bflo(w1.w); a[15] += c3.w * bfhi(w1.w); }
#pragma unroll
        for (int i = 0; i < 16; ++i) { const float y = siluf_(a[i]); if (mat == 0) q[i] = y; else if (mat == 1) k[i] = y; else v[i] = y; }
            asm volatile("" ::: "memory"); }
        float qs = 0.f, ks = 0.f;
#pragma unroll
        for (int i = 0; i < 16; ++i) { qs += q[i] * q[i]; ks += k[i] * k[i]; }
        qs += __shfl_xor(qs, 1); qs += __shfl_xor(qs, 2); qs += __shfl_xor(qs, 4); ks += __shfl_xor(ks, 1); ks += __shfl_xor(ks, 2); ks += __shfl_xor(ks, 4);
        const float qn = rsqrtf(qs + EPS) * 0.08838834764831845f, kn = rsqrtf(ks + EPS);
#pragma unroll
        for (int i = 0; i < 16; ++i) { q[i] *= qn; k[i] *= kn; }
        if (cb == 0) { GC[64 + r] = GB[(size_t)(t0 + r) * 16 + h]; GC[128 + r] = GB[(size_t)(t0 + r) * 16 + 8 + h]; }
        v4u w0, w1; w0.x = pk2(k[0], k[1]); w0.y = pk2(k[2], k[3]); w0.z = pk2(k[4], k[5]); w0.w = pk2(k[6], k[7]); w1.x = pk2(k[8], k[9]); w1.y = pk2(k[10], k[11]); w1.z = pk2(k[12], k[13]); w1.w = pk2(k[14], k[15]);
        *(LAS v4u*)(KB + r * 136 + cb * 16) = w0; *(LAS v4u*)(KB + r * 136 + cb * 16 + 8) = w1;
        w0.x = pk2(q[0], q[1]); w0.y = pk2(q[2], q[3]); w0.z = pk2(q[4], q[5]); w0.w = pk2(q[6], q[7]); w1.x = pk2(q[8], q[9]); w1.y = pk2(q[10], q[11]); w1.z = pk2(q[12], q[13]); w1.w = pk2(q[14], q[15]);
        *(LAS v4u*)(QB + r * 136 + cb * 16) = w0; *(LAS v4u*)(QB + r * 136 + cb * 16 + 8) = w1;
    }
    SBAR();
    if (wave == 0) { float x = GC[128 + lane];
#pragma unroll
        for (int o = 1; o < 64; o <<= 1) { const float y = __shfl_up(x, o); if (lane >= o) x += y; }
        GC[lane] = x; }
    SBAR();
    const float gcr = GC[r], betar = GC[64 + r], egr = __expf(gcr), gclast = GC[63];
    {
        const int tid = fresh_tid(F.tid), lane = tid & 63, wave = __builtin_amdgcn_readfirstlane(tid >> 6), r = tid >> 3, cb = tid & 7; (void)lane; (void)wave; (void)r; (void)cb;
#pragma unroll
        for (int a = 0; a < 4; ++a) { *(LAS f32x4*)(RHS + r * 256 + cb * 16 + 4 * a) = (f32x4){v[4 * a] * betar, v[4 * a + 1] * betar, v[4 * a + 2] * betar, v[4 * a + 3] * betar};
            const float kb_ = betar * egr; *(LAS f32x4*)(RHS + r * 256 + 128 + cb * 16 + 4 * a) = (f32x4){k[4 * a] * kb_, k[4 * a + 1] * kb_, k[4 * a + 2] * kb_, k[4 * a + 3] * kb_}; }
        float qd[16];
#pragma unroll
        for (int i = 0; i < 16; ++i) qd[i] = q[i] * egr;
        store_frag_row16(rec + R_QD, r, cb, 4, qd);
    }
    {
        const int tid = fresh_tid(F.tid), lane = tid & 63, wave = __builtin_amdgcn_readfirstlane(tid >> 6), r = tid >> 3, cb = tid & 7; (void)lane; (void)wave; (void)r; (void)cb;
        const int mat = wave >> 2, mt = wave & 3, fr = lane & 15, g = lane >> 4; const LAS bf16* AB = mat ? QB : KB;
        bf16x8 af[4];
#pragma unroll
        for (int kb = 0; kb < 4; ++kb) af[kb] = *(const LAS bf16x8*)(AB + (mt * 16 + fr) * 136 + kb * 32 + 8 * g);
#pragma unroll
        for (int nt = 0; nt < 4; ++nt) { f32x4 acc = (f32x4){0.f, 0.f, 0.f, 0.f};
            if (nt <= mt) {
#pragma unroll
                for (int kb = 0; kb < 4; ++kb) { const bf16x8 bfr = *(const LAS bf16x8*)(KB + (nt * 16 + fr) * 136 + kb * 32 + 8 * g); acc = __builtin_amdgcn_mfma_f32_16x16x32_bf16(af[kb], bfr, acc, 0, 0, 0); } }
            const int sc = nt * 16 + fr; const float gcs = GC[sc];
#pragma unroll
            for (int i = 0; i < 4; ++i) { const int c = mt * 16 + 4 * g + i; const float dcy = __expf(GC[c] - gcs);
                if (mat == 0) { if (nt <= mt) LM[c * 68 + sc] = (sc < c) ? GC[64 + c] * acc[i] * dcy : 0.f; }
                else *(bf16*)(rec + R_QK + frag_off(c, sc, 2)) = (bf16)f2bf((sc <= c && nt <= mt) ? acc[i] * dcy : 0.f); } }
    }
    SBAR();
    {
        const int tid = fresh_tid(F.tid), lane = tid & 63, wave = __builtin_amdgcn_readfirstlane(tid >> 6), r = tid >> 3, cb = tid & 7; (void)lane; (void)wave; (void)r; (void)cb;
        const int d = tid >> 2, cp = tid & 3;
#pragma unroll
        for (int a = 0; a < 4; ++a) { float y[4];
#pragma unroll
            for (int e = 0; e < 4; ++e) { const int c = 16 * cp + 4 * a + e; y[e] = bf2f(KB[c * 136 + d]) * __expf(gclast - GC[c]); }
            v2u w; w.x = pk2(y[0], y[1]); w.y = pk2(y[2], y[3]); *(v2u*)(rec + R_KDT + frag_off(d, 16 * cp + 4 * a, 2)) = w; }
        if (tid < 128) ((float*)(rec + R_DEC))[tid] = __expf(gclast);
    }
    {
        const int tid = fresh_tid(F.tid), lane = tid & 63, wave = __builtin_amdgcn_readfirstlane(tid >> 6), r = tid >> 3, cb = tid & 7; (void)lane; (void)wave; (void)r; (void)cb;
        const int c = tid >> 1, half = tid & 1;
        float xs[32];
#pragma unroll
        for (int i = 0; i < 32; ++i) xs[i] = 0.f;
        f32x4 lc[8], ln[8]; float rc = RHS[c], rn = 0.f;
#pragma unroll
        for (int i = 0; i < 64; ++i) {
            if (i + 1 < 64) { rn = RHS[(i + 1) * 256 + c];
#pragma unroll
                for (int g2 = 0; g2 < (i + 8) / 8; ++g2) ln[g2] = *(const LAS f32x4*)(LM + (i + 1) * 68 + 8 * g2 + 4 * half); }
            __builtin_amdgcn_sched_barrier(0);
            float a0 = 0.f, a1 = 0.f, a2 = 0.f, a3 = 0.f;
#pragma unroll
            for (int g2 = 0; g2 < (i + 7) / 8; ++g2) { a0 += lc[g2][0] * xs[4 * g2]; a1 += lc[g2][1] * xs[4 * g2 + 1]; a2 += lc[g2][2] * xs[4 * g2 + 2]; a3 += lc[g2][3] * xs[4 * g2 + 3]; }
            float part = (a0 + a1) + (a2 + a3); part += __builtin_bit_cast(float, __builtin_amdgcn_update_dpp(0, __builtin_bit_cast(int, part), 0xB1, 0xF, 0xF, true));
            const float xi = rc - part;
            xs[(i >> 3) * 4 + (i & 3)] = (((i >> 2) & 1) == half) ? xi : xs[(i >> 3) * 4 + (i & 3)];
            if (half == 0) RHS[i * 256 + c] = xi;
            __builtin_amdgcn_sched_barrier(0);
            rc = rn;
#pragma unroll
            for (int g2 = 0; g2 < 8; ++g2) lc[g2] = ln[g2]; }
    }
    SBAR();
    {
        const int tid = fresh_tid(F.tid), lane = tid & 63, wave = __builtin_amdgcn_readfirstlane(tid >> 6), r = tid >> 3, cb = tid & 7; (void)lane; (void)wave; (void)r; (void)cb;
        const int dv = tid >> 2, cq = (tid & 3) * 16;
#pragma unroll
        for (int a = 0; a < 4; ++a) { f32x4 o;
#pragma unroll
            for (int e = 0; e < 4; ++e) o[e] = RHS[(cq + 4 * a + e) * 256 + dv];
            *(f32x4*)(UT + dv * 64 + cq + 4 * a) = o; }
        float nw[16];
#pragma unroll
        for (int a = 0; a < 4; ++a) { const f32x4 t4 = *(const LAS f32x4*)(RHS + r * 256 + 128 + cb * 16 + 4 * a); nw[4 * a] = -t4.x; nw[4 * a + 1] = -t4.y; nw[4 * a + 2] = -t4.z; nw[4 * a + 3] = -t4.w; }
        store_frag_row16(rec + R_NW, r, cb, 4, nw);
    }
    SBAR();
}

__device__ __forceinline__ void hgrn_prep_unit(const Frame& F, int b, int h, int n) {
    const int tid = F.tid, lane = F.lane, wave = F.wave, r = tid >> 3, cb = tid & 7, t0 = b * SEQ + n * 64, seq = 16 + b * 8 + h;
    LAS float* LF = (LAS float*)F.lds;
    LAS bf16* QB = (LAS bf16*)(F.lds + 32768);
    LAS bf16* KB = (LAS bf16*)(F.lds + 50176);
    LAS bf16* KD = (LAS bf16*)(F.lds + 67584);
    LAS float* VT = (LAS float*)(F.lds + 84992);
    const bf16* P = (const bf16*)(F.ws + O_PROJ); const float* lbl = F.in[I_LBL];
    unsigned char* rec = F.ws + O_OPS + ((size_t)seq * 64 + n) * REC_BYTES; float* UT = (float*)(F.ws + O_UT) + ((size_t)seq * 64 + n) * 8192;
    float q[16], kk[16], lf[16];
    {
        const bf16* pq = P + (size_t)(t0 + r) * NPROJ + PQ_BQ + h * 128 + cb * 16; const bf16* pf = P + (size_t)(t0 + r) * NPROJ + PQ_BF + h * 128 + cb * 16; const bf16* pi = P + (size_t)(t0 + r) * NPROJ + PQ_BI + h * 128 + cb * 16;
        const v4u q0 = *(const v4u*)pq, q1 = *(const v4u*)(pq + 8), f0 = *(const v4u*)pf, f1 = *(const v4u*)(pf + 8), i0 = *(const v4u*)pi, i1 = *(const v4u*)(pi + 8);
        const unsigned qw[8] = {q0.x, q0.y, q0.z, q0.w, q1.x, q1.y, q1.z, q1.w}, fw[8] = {f0.x, f0.y, f0.z, f0.w, f1.x, f1.y, f1.z, f1.w}, iw[8] = {i0.x, i0.y, i0.z, i0.w, i1.x, i1.y, i1.z, i1.w};
#pragma unroll
        for (int i = 0; i < 16; ++i) { const int d = h * 128 + cb * 16 + i; const float lb = sigmoidf_(lbl[d] - lbl[1024 + d]);
            const float fl = (i & 1) ? bfhi(fw[i >> 1]) : bflo(fw[i >> 1]), ql = (i & 1) ? bfhi(qw[i >> 1]) : bflo(qw[i >> 1]), vl = (i & 1) ? bfhi(iw[i >> 1]) : bflo(iw[i >> 1]);
            const float fg = lb + (1.f - lb) * sigmoidf_(fl); lf[i] = __logf(fg); kk[i] = 1.f - fg; q[i] = siluf_(ql) * 0.08838834764831845f;
            VT[(cb * 16 + i) * 65 + r] = vl; }
#pragma unroll
        for (int a = 0; a < 4; ++a) *(LAS f32x4*)(LF + r * 128 + cb * 16 + 4 * a) = (f32x4){lf[4 * a], lf[4 * a + 1], lf[4 * a + 2], lf[4 * a + 3]};
    }
    SBAR();
    {
        const int d = tid & 127, qr = tid >> 7; float run = 0.f; float tv[16];
#pragma unroll
        for (int i = 0; i < 16; ++i) tv[i] = LF[(16 * qr + i) * 128 + d];
#pragma unroll
        for (int i = 0; i < 16; ++i) { run += tv[i]; tv[i] = run; }
#pragma unroll
        for (int i = 0; i < 16; ++i) LF[(16 * qr + i) * 128 + d] = tv[i];
    }
    SBAR();
    {
        float bb[16], bref[16], blast[16];
#pragma unroll
        for (int a = 0; a < 4; ++a) { const int co = cb * 16 + 4 * a;
            const f32x4 t15 = *(const LAS f32x4*)(LF + 15 * 128 + co), t31 = *(const LAS f32x4*)(LF + 31 * 128 + co), t47 = *(const LAS f32x4*)(LF + 47 * 128 + co), t63 = *(const LAS f32x4*)(LF + 63 * 128 + co), tr = *(const LAS f32x4*)(LF + r * 128 + co);
            const int qr = r >> 4;
#pragma unroll
            for (int e = 0; e < 4; ++e) { float off = 0.f; if (qr > 0) off += t15[e]; if (qr > 1) off += t31[e]; if (qr > 2) off += t47[e];
                bb[4 * a + e] = tr[e] + off; bref[4 * a + e] = t15[e] + t31[e]; blast[4 * a + e] = (t15[e] + t31[e]) + (t47[e] + t63[e]); } }
        float qt[16], kt[16], kd[16], qd[16];
#pragma unroll
        for (int i = 0; i < 16; ++i) { qt[i] = q[i] * __expf(bb[i] - bref[i]); kt[i] = kk[i] * __expf(bref[i] - bb[i]); kd[i] = kk[i] * __expf(blast[i] - bb[i]); qd[i] = q[i] * __expf(bb[i]); }
        v4u w0, w1;
        w0.x = pk2(qt[0], qt[1]); w0.y = pk2(qt[2], qt[3]); w0.z = pk2(qt[4], qt[5]); w0.w = pk2(qt[6], qt[7]); w1.x = pk2(qt[8], qt[9]); w1.y = pk2(qt[10], qt[11]); w1.z = pk2(qt[12], qt[13]); w1.w = pk2(qt[14], qt[15]);
        *(LAS v4u*)(QB + r * 136 + cb * 16) = w0; *(LAS v4u*)(QB + r * 136 + cb * 16 + 8) = w1;
        w0.x = pk2(kt[0], kt[1]); w0.y = pk2(kt[2], kt[3]); w0.z = pk2(kt[4], kt[5]); w0.w = pk2(kt[6], kt[7]); w1.x = pk2(kt[8], kt[9]); w1.y = pk2(kt[10], kt[11]); w1.z = pk2(kt[12], kt[13]); w1.w = pk2(kt[14], kt[15]);
        *(LAS v4u*)(KB + r * 136 + cb * 16) = w0; *(LAS v4u*)(KB + r * 136 + cb * 16 + 8) = w1;
        w0.x = pk2(kd[0], kd[1]); w0.y = pk2(kd[2], kd[3]); w0.z = pk2(kd[4], kd[5]); w0.w = pk2(kd[6], kd[7]); w1.x = pk2(kd[8], kd[9]); w1.y = pk2(kd[10], kd[11]); w1.z = pk2(kd[12], kd[13]); w1.w = pk2(kd[14], kd[15]);
        *(LAS v4u*)(KD + r * 136 + cb * 16) = w0; *(LAS v4u*)(KD + r * 136 + cb * 16 + 8) = w1;
        store_frag_row16(rec + R_QD, r, cb, 4, qd);
        if (r == 63) {
#pragma unroll
            for (int a = 0; a < 4; ++a) *(f32x4*)((float*)(rec + R_DEC) + cb * 16 + 4 * a) = (f32x4){__expf(blast[4 * a]), __expf(blast[4 * a + 1]), __expf(blast[4 * a + 2]), __expf(blast[4 * a + 3])}; }
    }
    SBAR();
    {
        const int mt = wave >> 1, fr = lane & 15, g = lane >> 4;
        bf16x8 af[4];
#pragma unroll
        for (int kb = 0; kb < 4; ++kb) af[kb] = *(const LAS bf16x8*)(QB + (mt * 16 + fr) * 136 + kb * 32 + 8 * g);
#pragma unroll
        for (int nn = 0; nn < 2; ++nn) { const int nt = 2 * (wave & 1) + nn; f32x4 acc = (f32x4){0.f, 0.f, 0.f, 0.f};
            if (nt <= mt) {
#pragma unroll
                for (int kb = 0; kb < 4; ++kb) { const bf16x8 bfr = *(const LAS bf16x8*)(KB + (nt * 16 + fr) * 136 + kb * 32 + 8 * g); acc = __builtin_amdgcn_mfma_f32_16x16x32_bf16(af[kb], bfr, acc, 0, 0, 0); } }
            const int sc = nt * 16 + fr;
#pragma unroll
            for (int i = 0; i < 4; ++i) { const int c = mt * 16 + 4 * g + i; *(bf16*)(rec + R_QK + frag_off(c, sc, 2)) = (bf16)f2bf((sc <= c && nt <= mt) ? acc[i] : 0.f); } }
        const int d = tid >> 2, cp = tid & 3;
#pragma unroll
        for (int a = 0; a < 4; ++a) { float y[4];
#pragma unroll
            for (int e = 0; e < 4; ++e) y[e] = bf2f(KD[(16 * cp + 4 * a + e) * 136 + d]);
            v2u w; w.x = pk2(y[0], y[1]); w.y = pk2(y[2], y[3]); *(v2u*)(rec + R_KDT + frag_off(d, 16 * cp + 4 * a, 2)) = w;
            f32x4 o;
#pragma unroll
            for (int e = 0; e < 4; ++e) o[e] = VT[d * 65 + 16 * cp + 4 * a + e];
            *(f32x4*)(UT + d * 64 + 16 * cp + 4 * a) = o; }
    }
    SBAR();
}

__device__ __forceinline__ void phase_mix_prep(const Frame& F, int only = 0) {
    { TS_BEGIN(3) if (FAST_GDN && only != 2) for (int rest = F.blk; rest < 1024; rest += F.G) { const int n = rest & 63, h = (rest >> 6) & 7, b = rest >> 9; gdn_prep_unit(F, b, h, n); } TS_END(3) }
    { TS_BEGIN(4) if (FAST_HGRN && only != 1) for (int rest = F.blk; rest < 1024; rest += F.G) { const int n = rest & 63, h = (rest >> 6) & 7, b = rest >> 9; hgrn_prep_unit(F, b, h, n); } TS_END(4) }
}

__device__ __forceinline__ unsigned lds_addr(const volatile LAS void* p) { return (unsigned)(size_t)p; }
__device__ __forceinline__ void glds16_asm(const void* gsrc, unsigned lds_dst) {
    unsigned keep;
    asm volatile("s_mov_b32 %0, m0\n\ts_mov_b32 m0, %2\n\ts_nop 0\n\tglobal_load_lds_dwordx4 %1, off\n\ts_mov_b32 m0, %0" : "=&s"(keep) : "v"(gsrc), "s"(lds_dst) : "memory");
}
template <int mixer>
__device__ __forceinline__ void mix_scan_body(const Frame& F) {
    const int seq = F.blk, b = (seq >> 3) & 1, h = seq & 7, tid = F.tid, lane = F.lane, w = F.wave, n16 = lane & 15, g = lane >> 4;
    LAS unsigned char* buf0 = F.lds; LAS unsigned char* buf1 = F.lds + REC_BYTES; LAS float* OT = (LAS float*)(F.lds + 2 * REC_BYTES);
    const unsigned char* rec = F.ws + O_OPS + (size_t)seq * 64 * REC_BYTES; const float* UTb = (const float*)(F.ws + O_UT) + (size_t)seq * 64 * 8192;
    const bf16* P = (const bf16*)(F.ws + O_PROJ); bf16* O = (bf16*)(F.ws + O_O); const float* nwp = mixer ? F.in[I_HNW] : F.in[I_GNW];
    const int er = tid >> 3, ec0 = (tid & 7) * 16, zcol = (mixer ? PQ_BG : PQ_AZ) + h * 128 + ec0;
    float nw[16];
#pragma unroll
    for (int i = 0; i < 16; ++i) nw[i] = nwp[ec0 + i];
#pragma unroll
    for (int i = 0; i < 16; ++i) asm volatile("" : "+v"(nw[i]));
    constexpr int NP = mixer ? 6 : 8;
    const int kb0 = mixer ? 16 : 0;
    const unsigned l0 = (unsigned)__builtin_amdgcn_readfirstlane((int)lds_addr(buf0)), l1 = (unsigned)__builtin_amdgcn_readfirstlane((int)lds_addr(buf1));
#define SCAN_ISSUE(st_, ldsb_) do { const unsigned char* rs_ = rec + (size_t)(st_) * REC_BYTES; \
        _Pragma("unroll") for (int i_ = 0; i_ < NP; ++i_) { int p_ = kb0 + w + 8 * i_; p_ = p_ > 56 ? 56 : p_; glds16_asm(rs_ + p_ * 1024 + lane * 16, (ldsb_) + (unsigned)p_ * 1024u); } } while (0)
#define SCAN_LOADU(st_, U_) do { const float* up_ = UTb + (size_t)(st_) * 8192 + (16 * w + n16) * 64 + 4 * g; \
        _Pragma("unroll") for (int mt_ = 0; mt_ < 4; ++mt_) asm volatile("global_load_dwordx4 %0, %1, off" : "=v"(U_[mt_]) : "v"(up_ + 16 * mt_) : "memory"); } while (0)
    f32x4 Sacc[8]; bf16x8 Sb[4];
#pragma unroll
    for (int i = 0; i < 8; ++i) Sacc[i] = (f32x4){0.f, 0.f, 0.f, 0.f};
#pragma unroll
    for (int i = 0; i < 4; ++i) Sb[i] = (bf16x8){0, 0, 0, 0, 0, 0, 0, 0};
    f32x4 UA[4], UB[4];
    asm volatile("s_waitcnt vmcnt(0)" ::: "memory");
    SCAN_ISSUE(0, l0); SCAN_LOADU(0, UA);
    asm volatile("s_waitcnt vmcnt(0)" ::: "memory");
#define AFR(base_, idx_) (*(const LAS bf16x8*)(cur + (base_) + (idx_) * 1024 + lane * 16))
#define SCAN_STEP(st, cur, ldsn, Uc, Un) do { \
        asm volatile("s_waitcnt vmcnt(2)" ::: "memory"); SBAR(); \
        asm volatile("" : "+v"(Uc[0]), "+v"(Uc[1]), "+v"(Uc[2]), "+v"(Uc[3])); \
        const int t0 = b * SEQ + (st) * 64; const int stn = (st) + 1 < 64 ? (st) + 1 : 63; \
        v4u z0, z1; { const bf16* zp = P + (size_t)(t0 + er) * NPROJ + zcol; \
            asm volatile("global_load_dwordx4 %0, %1, off" : "=v"(z0) : "v"(zp) : "memory"); asm volatile("global_load_dwordx4 %0, %1, off" : "=v"(z1) : "v"(zp + 8) : "memory"); } \
        SCAN_ISSUE(stn, ldsn); SCAN_LOADU(stn, Un); \
        f32x4 vn[4]; \
        _Pragma("unroll") for (int mt = 0; mt < 4; ++mt) vn[mt] = Uc[mt]; \
        if (mixer == 0) { \
            _Pragma("unroll") for (int hh = 0; hh < 2; ++hh) { bf16x8 af[8]; \
                _Pragma("unroll") for (int i = 0; i < 8; ++i) af[i] = AFR(R_NW, hh * 8 + i); \
                _Pragma("unroll") for (int i = 0; i < 8; ++i) vn[hh * 2 + (i >> 2)] = __builtin_amdgcn_mfma_f32_16x16x32_bf16(af[i], Sb[i & 3], vn[hh * 2 + (i >> 2)], 0, 0, 0); } } \
        bf16x8 Vb[2]; Vb[0] = pack8(vn[0], vn[1]); Vb[1] = pack8(vn[2], vn[3]); \
        f32x4 o[4]; \
        _Pragma("unroll") for (int mt = 0; mt < 4; ++mt) o[mt] = (f32x4){0.f, 0.f, 0.f, 0.f}; \
        _Pragma("unroll") for (int hh = 0; hh < 2; ++hh) { bf16x8 af[8]; \
            _Pragma("unroll") for (int i = 0; i < 8; ++i) af[i] = AFR(R_QD, hh * 8 + i); \
            _Pragma("unroll") for (int i = 0; i < 8; ++i) o[hh * 2 + (i >> 2)] = __builtin_amdgcn_mfma_f32_16x16x32_bf16(af[i], Sb[i & 3], o[hh * 2 + (i >> 2)], 0, 0, 0); } \
        { bf16x8 af[8]; \
            _Pragma("unroll") for (int i = 0; i < 8; ++i) af[i] = AFR(R_QK, i); \
            _Pragma("unroll") for (int i = 0; i < 8; ++i) o[i >> 1] = __builtin_amdgcn_mfma_f32_16x16x32_bf16(af[i], Vb[i & 1], o[i >> 1], 0, 0, 0); } \
        _Pragma("unroll") for (int hh = 0; hh < 2; ++hh) { bf16x8 af[8]; f32x4 dec[4]; \
            _Pragma("unroll") for (int i = 0; i < 8; ++i) af[i] = AFR(R_KDT, hh * 8 + i); \
            _Pragma("unroll") for (int i = 0; i < 4; ++i) dec[i] = *(const LAS f32x4*)(cur + R_DEC + (16 * (hh * 4 + i) + 4 * g) * 4); \
            _Pragma("unroll") for (int i = 0; i < 4; ++i) Sacc[hh * 4 + i] = Sacc[hh * 4 + i] * dec[i]; \
            _Pragma("unroll") for (int i = 0; i < 8; ++i) Sacc[hh * 4 + (i >> 1)] = __builtin_amdgcn_mfma_f32_16x16x32_bf16(af[i], Vb[i & 1], Sacc[hh * 4 + (i >> 1)], 0, 0, 0); } \
        _Pragma("unroll") for (int kb = 0; kb < 4; ++kb) Sb[kb] = pack8(Sacc[2 * kb], Sacc[2 * kb + 1]); \
        _Pragma("unroll") for (int mt = 0; mt < 4; ++mt) _Pragma("unroll") for (int i = 0; i < 4; ++i) OT[(16 * mt + 4 * g + i) * 132 + 16 * w + n16] = o[mt][i]; \
        SBAR(); \
        if (mixer == 0) asm volatile("s_waitcnt vmcnt(12)" ::: "memory"); else asm volatile("s_waitcnt vmcnt(10)" ::: "memory"); asm volatile("" : "+v"(z0), "+v"(z1)); \
        { float ov[16]; float ss = 0.f; \
            _Pragma("unroll") for (int a = 0; a < 4; ++a) { const f32x4 t4 = *(const LAS f32x4*)(OT + er * 132 + ec0 + 4 * a); ov[4 * a] = t4.x; ov[4 * a + 1] = t4.y; ov[4 * a + 2] = t4.z; ov[4 * a + 3] = t4.w; ss += (t4.x * t4.x + t4.y * t4.y) + (t4.z * t4.z + t4.w * t4.w); } \
            ss += __shfl_xor(ss, 1); ss += __shfl_xor(ss, 2); ss += __shfl_xor(ss, 4); \
            const float rstd = rsqrtf(ss * (1.0f / 128.0f) + EPS); \
            const unsigned zw[8] = {z0.x, z0.y, z0.z, z0.w, z1.x, z1.y, z1.z, z1.w}; unsigned ow[8]; \
            _Pragma("unroll") for (int i = 0; i < 8; ++i) ow[i] = pk2(ov[2 * i] * rstd * nw[2 * i] * siluf_(bflo(zw[i])), ov[2 * i + 1] * rstd * nw[2 * i + 1] * siluf_(bfhi(zw[i]))); \
            bf16* op = O + (size_t)(t0 + er) * D + mixer * 1024 + h * 128 + ec0; \
            *(v4u*)op = (v4u){ow[0], ow[1], ow[2], ow[3]}; *(v4u*)(op + 8) = (v4u){ow[4], ow[5], ow[6], ow[7]}; } \
    } while (0)
    for (int st = 0; st < 64; st += 2) {
        { LAS unsigned char* cur = buf0; SCAN_STEP(st, cur, l1, UA, UB); }
        { LAS unsigned char* cur = buf1; SCAN_STEP(st + 1, cur, l0, UB, UA); }
    }
    asm volatile("s_waitcnt vmcnt(0)" ::: "memory"); SBAR();
#undef SCAN_STEP
#undef AFR
#undef SCAN_LOADU
#undef SCAN_ISSUE
}
__device__ __forceinline__ void phase_mix_scan(const Frame& F) {
    if (F.blk >= 32) return;
    if (F.blk < 16) { if (FAST_GDN) mix_scan_body<0>(F); } else { if (FAST_HGRN) mix_scan_body<1>(F); }
}

__device__ __forceinline__ void phase_lru_conv(const Frame& F) {
    const bf16* XBR = (const bf16*)(F.ws + O_XBR); bf16* XC = (bf16*)(F.ws + O_XC);
    const float* cw = F.in[I_RGCW]; const float* cb = F.in[I_RGCB];
    for (int idx = F.blk * 512 + F.tid; idx < (T / 16) * 256; idx += F.G * 512) {
        const int t0 = (idx >> 8) * 16, c0 = (idx & 255) * 8; const bool head = (t0 & (SEQ - 1)) == 0;
        v4u r[19];
#pragma unroll
        for (int j = 0; j < 19; ++j) { if (j < 3 && head) r[j] = (v4u){0u, 0u, 0u, 0u}; else r[j] = *(const v4u*)(XBR + (size_t)(t0 - 3 + j) * D + c0); }
        float k[4][8], bs[8];
        { const f32x4 b0 = *(const f32x4*)(cb + c0), b1 = *(const f32x4*)(cb + c0 + 4); bs[0] = b0.x; bs[1] = b0.y; bs[2] = b0.z; bs[3] = b0.w; bs[4] = b1.x; bs[5] = b1.y; bs[6] = b1.z; bs[7] = b1.w; }
#pragma unroll
        for (int j = 0; j < 4; ++j) { const f32x4 k0 = *(const f32x4*)(cw + j * D + c0), k1 = *(const f32x4*)(cw + j * D + c0 + 4);
            k[j][0] = k0.x; k[j][1] = k0.y; k[j][2] = k0.z; k[j][3] = k0.w; k[j][4] = k1.x; k[j][5] = k1.y; k[j][6] = k1.z; k[j][7] = k1.w; }
#pragma unroll
        for (int i = 0; i < 16; ++i) {
            float a[8];
#pragma unroll
            for (int e = 0; e < 8; ++e) a[e] = bs[e];
#pragma unroll
            for (int j = 0; j < 4; ++j) { const v4u w = r[i + j];
                if (!(head && i + j < 3)) {
                    a[0] += k[j][0] * bflo(w.x); a[1] += k[j][1] * bfhi(w.x); a[2] += k[j][2] * bflo(w.y); a[3] += k[j][3] * bfhi(w.y);
                    a[4] += k[j][4] * bflo(w.z); a[5] += k[j][5] * bfhi(w.z); a[6] += k[j][6] * bflo(w.w); a[7] += k[j][7] * bfhi(w.w); } }
            *(v4u*)(XC + (size_t)(t0 + i) * D + c0) = (v4u){pk2(a[0], a[1]), pk2(a[2], a[3]), pk2(a[4], a[5]), pk2(a[6], a[7])};
        }
    }
}
__device__ __forceinline__ void phase_lru_scan1(const Frame& F) {
    const bf16* LA = (const bf16*)(F.ws + O_AA); const bf16* BB = (const bf16*)(F.ws + O_BB);
    float* SA = (float*)(F.ws + O_SUMA); float* SB = (float*)(F.ws + O_SUMB);
    for (int gid = F.blk * 512 + F.tid; gid < 2 * 32 * D; gid += F.G * 512) {
        const int ch = gid & 2047, chunk = (gid >> 11) & 31, b = gid >> 16; const size_t base = (size_t)(b * SEQ + chunk * 128) * D + ch;
        float hh = 0.f, ls = 0.f;
#pragma unroll 16
        for (int i = 0; i < 128; ++i) { const float la = bf2f(LA[base + (size_t)i * D]), bb = bf2f(BB[base + (size_t)i * D]); hh = __expf(la) * hh + bb; ls += la; }
        SA[gid] = __expf(ls); SB[gid] = hh;
    }
}
__device__ __forceinline__ void phase_lru_scan2(const Frame& F) {
    const bf16* LA = (const bf16*)(F.ws + O_AA); const bf16* BB = (const bf16*)(F.ws + O_BB);
    const float* SA = (const float*)(F.ws + O_SUMA); const float* SB = (const float*)(F.ws + O_SUMB);
    const bf16* Y = (const bf16*)(F.ws + O_Y); bf16* YH = (bf16*)(F.ws + O_YH);
    for (int gid = F.blk * 512 + F.tid; gid < 2 * 32 * D; gid += F.G * 512) {
        const int ch = gid & 2047, chunk = (gid >> 11) & 31, b = gid >> 16; const size_t base = (size_t)(b * SEQ + chunk * 128) * D + ch;
        float hh = 0.f;
        for (int c0 = 0; c0 < chunk; c0 += 16) {
            float sa[16], sb[16];
#pragma unroll
            for (int j = 0; j < 16; ++j) { const bool ok = c0 + j < chunk; const int g2 = (b * 32 + (ok ? c0 + j : 0)) * D + ch; const float xa = SA[g2], xb = SB[g2]; sa[j] = ok ? xa : 1.0f; sb[j] = ok ? xb : 0.0f; }
#pragma unroll
            for (int j = 0; j < 16; ++j) hh = sa[j] * hh + sb[j];
        }
#pragma unroll 16
        for (int i = 0; i < 128; ++i) { const float a = __expf(bf2f(LA[base + (size_t)i * D])), bb = bf2f(BB[base + (size_t)i * D]); hh = a * hh + bb;
            YH[base + (size_t)i * D] = (bf16)f2bf(bf2f(Y[base + (size_t)i * D]) * hh); }
    }
}

__device__ __forceinline__ void phase_route1(const Frame& F) {
    const int gw = F.blk * 8 + F.wave, ngw = F.G * 8, lane = F.lane;
    LAS float* rwt = (LAS float*)F.lds;
    LAS unsigned* cntL = (LAS unsigned*)(F.lds + 8 * 2052 * 4);
    const float* RW = F.in[I_ROUTER];
    const float* X3 = (const float*)(F.ws + O_X3); const float* nw = F.in[I_NORMW] + 3 * D;
    bf16* XN = (bf16*)(F.ws + O_XN); unsigned* TOKE = (unsigned*)(F.ws + O_TOKE); float* TOKG = (float*)(F.ws + O_TOKG);
#if X3_BF16
    v2u raw[4][8];
#pragma unroll
    for (int q = 0; q < 4; ++q) { const int m = gw + q * ngw;
#pragma unroll
        for (int j = 0; j < 8; ++j) { raw[q][j] = (v2u){0u, 0u}; if (m < T) raw[q][j] = ((const v2u*)((const unsigned char*)X3 + (size_t)m * D * 2))[lane + 64 * j]; } }
#endif
    for (int idx = F.tid; idx < D * 8; idx += 512) { const int e = idx & 7, i = idx >> 3; rwt[e * 2052 + i] = RW[idx]; }
    if (F.tid < 8) cntL[F.tid] = 0u;
    __syncthreads();
    auto route_row = [&](int m, const f32x4 (&v)[8]) {
        if (MOE_F8) {
#pragma unroll
            for (int j = 0; j < 8; ++j) ((unsigned*)((unsigned char*)XN + (size_t)m * D))[lane + 64 * j] = pk4_fp8(v[j].x, v[j].y, v[j].z, v[j].w);
        } else row_store_bf16(XN + (size_t)m * D, lane, v);
        float pa[8];
#pragma unroll
        for (int e = 0; e < 8; ++e) pa[e] = 0.f;
#pragma unroll
        for (int j = 0; j < 8; ++j) {
#pragma unroll
            for (int e = 0; e < 8; ++e) { const f32x4 w = *(const LAS f32x4*)(rwt + e * 2052 + 4 * lane + 256 * j); pa[e] += (v[j].x * w.x + v[j].y * w.y) + (v[j].z * w.z + v[j].w * w.w); }
            asm volatile("" ::: "memory"); }
        const float mine = red_multi8(pa, lane);
        float v0 = -3.0e38f, v1 = -3.0e38f; int i0 = 0, i1 = 0;
#pragma unroll
        for (int e = 0; e < 8; ++e) { const float a = __shfl(mine, ((e >> 2) & 1) * 32 + ((e >> 1) & 1) * 16 + (e & 1) * 8);
            if (a > v0) { v1 = v0; i1 = i0; v0 = a; i0 = e; } else if (a > v1) { v1 = a; i1 = e; } }
        if (lane == 0) { const float g0 = 1.0f / (1.0f + __expf(v1 - v0)); TOKE[m] = (unsigned)i0 | ((unsigned)i1 << 8); TOKG[2 * m] = g0; TOKG[2 * m + 1] = 1.0f - g0;
            lds_add(cntL + i0, 1u); lds_add(cntL + i1, 1u); }
    };
#if X3_BF16
#pragma unroll
    for (int q = 0; q < 4; ++q) { const int m = gw + q * ngw;
        if (m < T) { f32x4 v[8]; float s = 0.f;
#pragma unroll
            for (int j = 0; j < 8; ++j) { const v2u w = raw[q][j]; v[j] = (f32x4){bflo(w.x), bfhi(w.x), bflo(w.y), bfhi(w.y)}; s += (v[j].x * v[j].x + v[j].y * v[j].y) + (v[j].z * v[j].z + v[j].w * v[j].w); }
            const float rstd = rsqrtf(wave_sum(s) * (1.0f / D) + EPS);
#pragma unroll
            for (int j = 0; j < 8; ++j) { const f32x4 w = ((const f32x4*)nw)[lane + 64 * j]; v[j] = v[j] * rstd * w; }
            route_row(m, v); } }
    for (int m = gw + 4 * ngw; m < T; m += ngw) {
#else
    for (int m = gw; m < T; m += ngw) {
#endif
        f32x4 v[8]; rms_load<(X3_BF16 != 0)>((const unsigned char*)X3 + (size_t)m * D * (X3_BF16 ? 2 : 4), nw, lane, v);
        route_row(m, v);
    }
    __syncthreads();
    if (F.tid < 8) ((unsigned*)(F.ws + O_WCNT))[F.blk * 8 + F.tid] = cntL[F.tid];
}
__device__ __forceinline__ unsigned moe_unit_entry(int L, int nwg, int nN, const LAS unsigned* eoff) {
    int wgid = L; { const int q = nwg / 8, r = nwg % 8, xcd = wgid % 8, off = wgid / 8; wgid = (xcd < r ? xcd * (q + 1) : r * (q + 1) + (xcd - r) * q) + off; }
    int e = 0;
    for (int k = 1; k < 8; ++k) if (wgid >= (int)(eoff[k] >> 8) * nN) e = k;
    const int r0 = (int)(eoff[e] >> 8), re = (int)(eoff[e + 1] >> 8) - r0, l = wgid - r0 * nN;
    return (unsigned)(r0 + l % re) | ((unsigned)(l / re) << 8) | ((unsigned)e << 16);
}
__device__ __forceinline__ void phase_route2(const Frame& F) {
    LAS unsigned* tot = (LAS unsigned*)F.lds; LAS unsigned* pre = tot + 8; LAS unsigned* eoff = tot + 16; LAS unsigned* basep = tot + 32; LAS unsigned* lpos = tot + 64; LAS unsigned* ltok = tot + 128;
    const unsigned* WCNT = (const unsigned*)(F.ws + O_WCNT); const unsigned* TOKE = (const unsigned*)(F.ws + O_TOKE);
    if (F.tid < 16) tot[F.tid] = 0u;
    if (F.tid < 32) ltok[F.tid] = TOKE[F.blk * 8 + (F.tid & 7) + 2048 * (F.tid >> 3)];
    __syncthreads();
    for (int idx = F.tid; idx < F.G * 8; idx += 512) { const int w = idx >> 3, e = idx & 7; const unsigned v = WCNT[idx]; lds_add(tot + e, v); if (w < F.blk) lds_add(pre + e, v); }
    __syncthreads();
    if (F.tid == 0) {
        unsigned off = 0;
        for (int e = 0; e < 8; ++e) { eoff[e] = off; basep[e] = off + pre[e]; off += (tot[e] + 255u) & ~255u; }
        eoff[8] = off;
        for (int i = 0; i < 32; ++i) { const unsigned te = ltok[i]; const unsigned e0 = te & 255u, e1 = te >> 8;
            lpos[2 * i] = basep[e0]; basep[e0] += 1; lpos[2 * i + 1] = basep[e1]; basep[e1] += 1; }
    }
    __syncthreads();
    if (F.blk == 0 && F.tid < 9) ((unsigned*)(F.ws + O_EOFF))[F.tid] = eoff[F.tid];
    if (F.blk == 1) { const int nwg = (int)(eoff[8] >> 8) * (2 * FE / 256); unsigned* tab = (unsigned*)(F.ws + O_UTAB); for (int L = F.tid; L < nwg; L += 512) tab[L] = moe_unit_entry(L, nwg, 2 * FE / 256, eoff); }
    if (F.tid < 32) { const int m = F.blk * 8 + (F.tid & 7) + 2048 * (F.tid >> 3); ((unsigned*)(F.ws + O_POS))[2 * m] = lpos[2 * F.tid]; ((unsigned*)(F.ws + O_POS))[2 * m + 1] = lpos[2 * F.tid + 1]; }
    const bf16* XN = (const bf16*)(F.ws + O_XN); bf16* HS = (bf16*)(F.ws + O_HS);
    if (MOE_F8) {
        v4u a0[4], a1[4];
#pragma unroll
        for (int k = 0; k < 4; ++k) { const int m = F.blk * 8 + F.wave + 2048 * k; const v4u* s8 = (const v4u*)((const unsigned char*)XN + (size_t)m * D); a0[k] = s8[2 * F.lane]; a1[k] = s8[2 * F.lane + 1]; }
#pragma unroll
        for (int k = 0; k < 4; ++k) { const int li = k * 8 + F.wave;
#pragma unroll
            for (int sl = 0; sl < 2; ++sl) { v4u* dst = (v4u*)((unsigned char*)HS + (size_t)lpos[2 * li + sl] * D); dst[2 * F.lane] = a0[k]; dst[2 * F.lane + 1] = a1[k]; } }
    } else
    for (int k = 0; k < 4; ++k) { const int li = k * 8 + F.wave, m = F.blk * 8 + F.wave + 2048 * k; const v4u* src = (const v4u*)(XN + (size_t)m * D);
        {
        v4u a[4];
#pragma unroll
        for (int j = 0; j < 4; ++j) a[j] = src[F.lane + 64 * j];
#pragma unroll
        for (int sl = 0; sl < 2; ++sl) { v4u* dst = (v4u*)(HS + (size_t)lpos[2 * li + sl] * D);
#pragma unroll
            for (int j = 0; j < 4; ++j) dst[F.lane + 64 * j] = a[j]; } } }
    if (F.blk < 8) {
        const unsigned r0 = eoff[F.blk] + tot[F.blk], r1 = eoff[F.blk + 1]; const unsigned per = MOE_F8 ? 128u : 256u;
        for (unsigned idx = r0 * per + F.tid; idx < r1 * per; idx += 512) ((v4u*)HS)[idx] = (v4u){0u, 0u, 0u, 0u};
    }
    __syncthreads();
}
struct SchedMoe {
    int G, c, nwg; long aT, bT, bE; const LAS unsigned* tab;
    __device__ __forceinline__ bool next(int i, pg8::Unit& u) const {
        const int L = i * G + c; if (L >= nwg) return false;
        const unsigned w = (unsigned)__builtin_amdgcn_readfirstlane((int)tab[i]);
        u.pm = (int)(w & 255u); u.pn = (int)((w >> 8) & 255u); const int e = (int)(w >> 16);
        u.aoff = (unsigned)(u.pm * aT); u.boff = (unsigned)(e * bE + u.pn * bT); u.z = 0; return true;
    }
};
struct SchedMoeDown {
    int G, c, u0, nu, S; unsigned aT, bT, bE, kpart; unsigned eo[9];
    __device__ __forceinline__ bool next(int i, pg8::Unit& u) const {
        int L = i * G + c; if (L >= nu * S) return false;
        if (S == 1 && G == 256) { const int x = c & 7, j = c >> 3; L = (32 * i + 4 * x + (j >> 3)) * 8 + (j & 7); }
        const int uu = u0 + L / S, part = L % S; u.pm = uu >> 3; u.pn = uu & 7; u.z = part;
        int e = 0;
#pragma unroll
        for (int k = 1; k < 8; ++k) e += ((unsigned)(u.pm * 256) >= eo[k]) ? 1 : 0;
        u.aoff = (unsigned)u.pm * aT + (unsigned)part * kpart; u.boff = (unsigned)e * bE + (unsigned)u.pn * bT + (unsigned)part * kpart; return true;
    }
};
__device__ __forceinline__ void moe_down_split(int nrt, int G, int& full, int& rem, int& S) {
    const int U = nrt * 8; full = (U / G) * G; rem = U - full; S = 1; if (rem > 0) { if (rem * 7 <= G) S = 7; else if (rem * 4 <= G) S = 4; else if (rem * 2 <= G) S = 2; }
}
struct SchedGates {
    int G, c;
    __device__ __forceinline__ bool next(int i, pg8::Unit& u) const {
        if (!pg8::std_order(i, G, c, 32, 16, u.pm, u.pn)) return false;
        u.aoff = (unsigned)(((long)u.pm * 256 * D + (u.pn >> 1) * 256) * 2); u.boff = (unsigned)(u.pn * 256 * 256 * 2); u.z = 0; return true;
    }
};
__device__ __forceinline__ f32x4 ldbf4(const bf16* row, int i4) { const v2u w = ((const v2u*)row)[i4]; return (f32x4){bflo(w.x), bfhi(w.x), bflo(w.y), bfhi(w.y)}; }
__device__ __forceinline__ void phase_combine(const Frame& F) {
    const int gw = F.blk * 8 + F.wave, ngw = F.G * 8, lane = F.lane;
    const float* X3 = (const float*)(F.ws + O_X3); const bf16* YM = (const bf16*)(F.ws + O_YM);
    const unsigned* POS = (const unsigned*)(F.ws + O_POS); const float* TOKG = (const float*)(F.ws + O_TOKG); const float* fnw = F.in[I_FNW];
    int full, rem, SP; moe_down_split((int)(__builtin_amdgcn_readfirstlane(((const unsigned*)(F.ws + O_EOFF))[8]) >> 8), F.G, full, rem, SP);
    const unsigned rt_split = (unsigned)(full >> 3); const size_t pstride = (size_t)MOE_ROWS * D;
    for (int m = gw; m < T; m += ngw) {
        const unsigned p0 = POS[2 * m], p1 = POS[2 * m + 1]; const float g0 = TOKG[2 * m], g1 = TOKG[2 * m + 1];
        const int n0 = ((p0 >> 8) >= rt_split) ? SP : 1, n1 = ((p1 >> 8) >= rt_split) ? SP : 1;
        f32x4 v[8]; float s = 0.f;
        {
            f32x4 xr[8], y0r[8], y1r[8];
#pragma unroll
            for (int j = 0; j < 8; ++j) { xr[j] = X3_BF16 ? ldbf4((const bf16*)X3 + (size_t)m * D, lane + 64 * j) : ((const f32x4*)(X3 + (size_t)m * D))[lane + 64 * j]; y0r[j] = ldbf4(YM + (size_t)p0 * D, lane + 64 * j); y1r[j] = ldbf4(YM + (size_t)p1 * D, lane + 64 * j); }
            for (int p = 1; p < n0; ++p) {
#pragma unroll
                for (int j = 0; j < 8; ++j) y0r[j] += ldbf4(YM + p * pstride + (size_t)p0 * D, lane + 64 * j); }
            for (int p = 1; p < n1; ++p) {
#pragma unroll
                for (int j = 0; j < 8; ++j) y1r[j] += ldbf4(YM + p * pstride + (size_t)p1 * D, lane + 64 * j); }
#pragma unroll
            for (int j = 0; j < 8; ++j) { v[j] = xr[j] + g0 * y0r[j] + g1 * y1r[j]; s += (v[j].x * v[j].x + v[j].y * v[j].y) + (v[j].z * v[j].z + v[j].w * v[j].w); }
        }
        const float rstd = rsqrtf(wave_sum(s) * (1.0f / D) + EPS);
#pragma unroll
        for (int j = 0; j < 8; ++j) { const f32x4 w = ((const f32x4*)fnw)[lane + 64 * j]; ((f32x4*)(F.out + (size_t)m * D))[lane + 64 * j] = v[j] * rstd * w; }
    }
}

constexpr int NPHASES = 20;
struct Args { const float* in[25]; float* out; unsigned char* ws; int ph_lo, ph_hi; };
__global__ void __launch_bounds__(512, 2) mk_fwd(Args args) {
    extern __shared__ __attribute__((aligned(16))) unsigned char lds_raw[];
    Frame F;
    F.lds = (LAS unsigned char*)lds_raw;
    F.tid = threadIdx.x; F.lane = F.tid & 63; F.wave = __builtin_amdgcn_readfirstlane(F.tid >> 6); F.G = gridDim.x; F.blk = blockIdx.x;
    F.ws = args.ws; F.out = args.out;
#pragma unroll
    for (int i = 0; i < 25; ++i) F.in[i] = args.in[i];
    volatile LAS unsigned* MISC = (volatile LAS unsigned*)(F.lds + MISC_OFF);
    if (F.tid < 64) MISC[F.tid] = 0u;
    __syncthreads();
    const int lo = args.ph_lo, hi = args.ph_hi;
    XcdBarrier bar; bar.bar = (unsigned*)(F.ws + O_CTL) + CW_BAR; bar.x = 0; bar.st = nullptr;
    if (hi - lo > 1) bar = xcd_barrier_post((unsigned*)(F.ws + O_CTL) + CW_BAR, MISC + 8);
#ifdef ONLY_PHASE
#define IN(k) ((k) == ONLY_PHASE && lo <= (k) && (k) < hi)
#else
#define IN(k) (lo <= (k) && (k) < hi)
#endif
#define SEAM(k) do { if (IN(k) && IN((k) + 1)) xcd_barrier(bar); } while (0)
#ifndef REP_PHASE
#define REP_PHASE -1
#endif
#ifndef REP_COUNT
#define REP_COUNT 2
#endif
#ifndef TIME_MASK
#define TIME_MASK 0u
#endif
    unsigned long long tacc = 0ull, tst = 0ull;
#define PH_BEGIN(k) if ((TIME_MASK >> (k)) & 1u) tst = __builtin_amdgcn_s_memrealtime(); F.tid = fresh_tid((int)threadIdx.x); F.lane = F.tid & 63; if (IN(k)) {     for (int rep_ = 0; rep_ < ((k) == REP_PHASE ? REP_COUNT : 1); ++rep_) { if (rep_) { xcd_barrier(bar); if (F.blk == 0 && F.tid == 0) __hip_atomic_store((unsigned*)(F.ws + O_CTL) + CW_Q, 0u, __ATOMIC_RELAXED, __HIP_MEMORY_SCOPE_AGENT); xcd_barrier(bar); }
#define PH_END(k) } } SEAM(k); if ((TIME_MASK >> (k)) & 1u) tacc += __builtin_amdgcn_s_memrealtime() - tst;
    unsigned char* ws = F.ws;
    bf16* XN = (bf16*)(ws + O_XN);

    PH_BEGIN(0) { phase_prologue(F); } PH_END(0)
    PH_BEGIN(1) {
        pg8::Gemm g{XN, (const bf16*)(ws + O_WMI), D, D, D}; pg8::SchedStd S{T / 256, NPROJ / 256, F.G, F.blk, (long)256 * D * 2, (long)256 * D * 2};
        pg8::EpiBf16 E{(bf16*)(ws + O_PROJ), NPROJ};
        pg8::gemm_phase(F.lds, g, S, E);
    } PH_END(1)
    PH_BEGIN(2) { if (!(FAST_GDN && FAST_HGRN)) phase_mix_pre(F); if (FAST_GDN || FAST_HGRN) phase_mix_prep(F, rep_ ? PREP_ONLY : 0); } PH_END(2)
    PH_BEGIN(3) { if (!(FAST_GDN && FAST_HGRN)) phase_mix_scan_slow(F); { TS_BEGIN(2) if (FAST_GDN || FAST_HGRN) phase_mix_scan(F); TS_END(2) } { const int nconv = F.G > 32 ? F.G - 32 : 0;
        if (F.blk >= 32) convert_tiles<2, NJOBS, 2>(F, (unsigned*)(ws + O_CTL) + CW_Q, F.blk - 32, nconv, 2 * nconv); else convert_tiles<2, NJOBS, 0>(F, (unsigned*)(ws + O_CTL) + CW_Q, 0, 0, 2 * nconv); } } PH_END(3)
    PH_BEGIN(4) {
        pg8::Gemm g{(const bf16*)(ws + O_O), (const bf16*)(ws + O_WMO), D, D, D}; pg8::SchedStd S{T / 256, D / 256, F.G, F.blk, (long)256 * D * 2, (long)256 * D * 2};
        pg8::EpiRes<false, true, true, FFNG_F8 != 0> E{F.in[I_X], ws + O_X1, (float*)(ws + O_PART1), (LAS float*)(F.lds + 131072), ws + O_X1F8};
        pg8::gemm_phase(F.lds, g, S, E);
    } PH_END(4)
    PH_BEGIN(6) {
        const int GG = F.G == 256 ? FFN_GEMM_WG : F.G;
        if (F.blk >= GG) { convert_tiles<13, 14, 1>(F, (unsigned*)(ws + O_CTL) + CW_Q2, F.blk - GG, F.G - GG); }
        else {
        constexpr int EBG = FFNG_F8 ? 1 : 2;
        pg8::Gemm g{(const bf16*)(ws + (FFNG_F8 ? O_X1F8 : O_X1)), (const bf16*)(ws + O_WFG), D * EBG / 2, D * EBG / 2, D * EBG / 2}; pg8::SchedStd S{T / 256, 2 * FF / 256, GG, F.blk, (long)256 * D * EBG, (long)256 * D * EBG};
        if constexpr (FFND_F8) { typedef pg8::EpiSwigluF8R<(FFNG_F8 != 0)> EpiT; EpiT E{(unsigned char*)(ws + O_ACT), FF, (const float*)(ws + O_PART1)}; pg8::gemm_phase<EpiT, pg8::SchedStd, FFNG_F8 != 0, 121, 127>(F.lds, g, S, E); }
        else { pg8::EpiSwiglu E{(bf16*)(ws + O_ACT), FF, (const float*)(ws + O_PART1)}; pg8::gemm_phase<pg8::EpiSwiglu, pg8::SchedStd, FFNG_F8 != 0, 121, 127>(F.lds, g, S, E); } }
    } PH_END(6)
    PH_BEGIN(7) {
        pg8::EpiRes<true, true, true> E{ws + O_X1, ws + O_X2, (float*)(ws + O_PART2), (LAS float*)(F.lds + 131072)};
        if constexpr (FFND_F8) { pg8::Gemm g{(const bf16*)(ws + O_ACT), (const bf16*)(ws + O_WFD), FF / 2, FF / 2, FF / 2}; pg8::SchedStd S{T / 256, D / 256, F.G, F.blk, (long)256 * FF, (long)256 * FF};
            pg8::gemm_phase<pg8::EpiRes<true, true, true>, pg8::SchedStd, true, 120, 124>(F.lds, g, S, E); }
        else { pg8::Gemm g{(const bf16*)(ws + O_ACT), (const bf16*)(ws + O_WFD), FF, FF, FF}; pg8::SchedStd S{T / 256, D / 256, F.G, F.blk, (long)256 * FF * 2, (long)256 * FF * 2};
            pg8::gemm_phase(F.lds, g, S, E); }
    } PH_END(7)
    PH_BEGIN(9) {
        pg8::Gemm g{(const bf16*)(ws + O_X2), (const bf16*)(ws + O_WRI), D, D, D}; pg8::SchedStd S{T / 256, 2 * D / 256, F.G, F.blk, (long)256 * D * 2, (long)256 * D * 2};
        pg8::EpiRgIn E{(bf16*)(ws + O_Y), (bf16*)(ws + O_XBR), (const float*)(ws + O_PART2)};
        pg8::gemm_phase(F.lds, g, S, E);
    } PH_END(9)
    PH_BEGIN(10) { phase_lru_conv(F); } PH_END(10)
    PH_BEGIN(11) {
        pg8::Gemm g{(const bf16*)(ws + O_XC), (const bf16*)(ws + O_WRG), D, 256, 256}; SchedGates S{F.G, F.blk};
        pg8::EpiGates E{(const bf16*)(ws + O_XC), F.in[I_RGAB], F.in[I_RGXB], (const float*)(ws + O_SPL), (bf16*)(ws + O_AA), (bf16*)(ws + O_BB)};
        pg8::gemm_phase(F.lds, g, S, E);
    } PH_END(11)
    PH_BEGIN(12) { phase_lru_scan1(F); } PH_END(12)
    PH_BEGIN(13) { phase_lru_scan2(F); } PH_END(13)
    PH_BEGIN(14) {
        pg8::Gemm g{(const bf16*)(ws + O_YH), (const bf16*)(ws + O_WRO), D, D, D}; pg8::SchedStd S{T / 256, D / 256, F.G, F.blk, (long)256 * D * 2, (long)256 * D * 2};
        pg8::EpiRes<true, (X3_BF16 != 0), false> E{ws + O_X2, ws + O_X3, nullptr, (LAS float*)(F.lds + 131072)};
        pg8::gemm_phase(F.lds, g, S, E);
    } PH_END(14)
    PH_BEGIN(15) { phase_route1(F); } PH_END(15)
    PH_BEGIN(16) { phase_route2(F); } PH_END(16)
    PH_BEGIN(17) {
        constexpr int EB = MOE_F8 ? 1 : 2;
        SchedMoe S; S.G = F.G; S.c = F.blk; S.aT = (long)256 * D * EB; S.bT = (long)256 * D * EB; S.bE = (long)2 * FE * D * EB;
        S.nwg = (int)((unsigned)__builtin_amdgcn_readfirstlane(((const unsigned*)(ws + O_EOFF))[8]) >> 8) * (2 * FE / 256);
        { LAS unsigned* lt = (LAS unsigned*)(F.lds + MISC_OFF + 128); if (F.tid < 32) { const long L = (long)F.tid * F.G + F.blk; lt[F.tid] = L < S.nwg ? ((const unsigned*)(ws + O_UTAB))[L] : 0u; } __syncthreads(); S.tab = lt; }
        if constexpr (MOE_F8) { pg8::Gemm g{(const bf16*)(ws + O_HS), (const bf16*)(ws + O_WMG), D / 2, D / 2, D / 2};
            pg8::EpiSwigluF8 E{(unsigned char*)(ws + O_ACTM), FE, 8.0f};
            pg8::gemm_phase<pg8::EpiSwigluF8, SchedMoe, true, 121, 127>(F.lds, g, S, E); }
        else { pg8::Gemm g{(const bf16*)(ws + O_HS), (const bf16*)(ws + O_WMG), D, D, D};
            pg8::EpiSwiglu E{(bf16*)(ws + O_ACTM), FE, nullptr};
            pg8::gemm_phase(F.lds, g, S, E); }
    } PH_END(17)
    PH_BEGIN(18) {
        constexpr int EB = MOE_F8 ? 1 : 2;
        SchedMoeDown S; S.G = F.G; S.c = F.blk; S.aT = 256u * FE * EB; S.bT = 256u * FE * EB; S.bE = (unsigned)D * FE * EB;
        const unsigned* eo = (const unsigned*)(ws + O_EOFF);
#pragma unroll
        for (int k = 0; k < 9; ++k) S.eo[k] = __builtin_amdgcn_readfirstlane(eo[k]);
        int full, rem, SP; moe_down_split((int)(S.eo[8] >> 8), F.G, full, rem, SP);
        pg8::EpiPartBf16 E{(bf16*)(ws + O_YM), D, (size_t)MOE_ROWS * D};
        S.u0 = 0; S.nu = full; S.S = 1; S.kpart = 0;
        if constexpr (MOE_F8) { pg8::Gemm g{(const bf16*)(ws + O_ACTM), (const bf16*)(ws + O_WMD), FE / 2, FE / 2, FE / 2};
            pg8::gemm_phase<pg8::EpiPartBf16, SchedMoeDown, true, 120, 124>(F.lds, g, S, E); }
        else { pg8::Gemm g{(const bf16*)(ws + O_ACTM), (const bf16*)(ws + O_WMD), FE, FE, FE};
            pg8::gemm_phase(F.lds, g, S, E); }
        S.u0 = full; S.nu = rem; S.S = SP; S.kpart = (unsigned)(FE * EB) / (unsigned)SP;
        if constexpr (MOE_F8) { pg8::Gemm g{(const bf16*)(ws + O_ACTM), (const bf16*)(ws + O_WMD), FE / 2, FE / 2, FE / 2 / SP};
            pg8::gemm_phase<pg8::EpiPartBf16, SchedMoeDown, true, 120, 124>(F.lds, g, S, E); }
        else { pg8::Gemm g{(const bf16*)(ws + O_ACTM), (const bf16*)(ws + O_WMD), FE, FE, FE / SP};
            pg8::gemm_phase(F.lds, g, S, E); }
    } PH_END(18)
    PH_BEGIN(19) { phase_combine(F); } } } if ((TIME_MASK >> 19) & 1u) tacc += __builtin_amdgcn_s_memrealtime() - tst;
    if (TIME_SEC != 0 && F.blk == 0 && F.tid == 0) tacc += *(volatile LAS unsigned long long*)(F.lds + TS_LDS_OFF);
    if ((TIME_MASK != 0u || TIME_SEC != 0) && F.blk == 0 && F.tid == 0) { const unsigned long long t0 = __builtin_amdgcn_s_memrealtime(); while (__builtin_amdgcn_s_memrealtime() - t0 < 8ull * tacc) __builtin_amdgcn_s_sleep(8); }
#undef IN
#undef SEAM
}

extern "C" void kernel_launch(void* const* d_in, const int* in_sizes, int n_in, void* d_out, int out_size, void* d_ws, size_t ws_size, hipStream_t stream) {
    static int grid = 0;
    if (grid == 0) {
        if (n_in != 25 || out_size != T * D || ws_size < WS_END) { fprintf(stderr, "kernel_launch: unexpected shapes (n_in %d out %d ws %zu need %zu)\n", n_in, out_size, ws_size, (size_t)WS_END); grid = -1; return; }
        int dev = 0, cus = 0, per_cu = 0;
        if (hipGetDevice(&dev) != hipSuccess || hipDeviceGetAttribute(&cus, hipDeviceAttributeMultiprocessorCount, dev) != hipSuccess) { grid = -1; return; }
        if (hipFuncSetAttribute((const void*)mk_fwd, hipFuncAttributeMaxDynamicSharedMemorySize, LDS_BYTES) != hipSuccess) { fprintf(stderr, "kernel_launch: hipFuncSetAttribute failed\n"); grid = -1; return; }
        if (hipOccupancyMaxActiveBlocksPerMultiprocessor(&per_cu, (const void*)mk_fwd, 512, LDS_BYTES) != hipSuccess || per_cu < 1) fprintf(stderr, "kernel_launch: occupancy query reports %d\n", per_cu);
        (void)hipGetLastError();
        grid = cus > 256 ? 256 : cus;
    }
    if (grid < 0) return;
    (void)hipMemsetAsync((char*)d_ws + O_CTL, 0, 32768, stream);
    Args a{};
    for (int i = 0; i < 25; ++i) a.in[i] = (const float*)d_in[i];
    a.out = (float*)d_out; a.ws = (unsigned char*)d_ws;
#if MK_SPLIT
    for (int p = 0; p < NPHASES; ++p) { a.ph_lo = p; a.ph_hi = p + 1; hipLaunchKernelGGL(mk_fwd, dim3(grid), dim3(512), LDS_BYTES, stream, a); }
#else
    a.ph_lo = 0; a.ph_hi = NPHASES; hipLaunchKernelGGL(mk_fwd, dim3(grid), dim3(512), LDS_BYTES, stream, a);
#endif
}
```
